# Optimizing an MI355X kernel written in HIP

```python
import jax
import jax.numpy as jnp
from jax import lax
import numpy as np

D_MODEL = 2048
BATCH = 8
SEQ = 2048
DEPTH = 1

HEAD_DIM = 128
ROPE_THETA = 10000.0
NORM_EPS = 1e-6
Q_BLOCK = 128
NEG_INF = -1e30
TINY = 1e-30

NSA_HEADS = 8
NSA_KV_GROUPS = 2
NSA_HPG = NSA_HEADS // NSA_KV_GROUPS
CMP_BLOCK = 32
CMP_STRIDE = 16
CMP_HIDDEN = 256
SEL_BLOCK = 64
SEL_TOPK = 16
SEL_Q_CHUNK = 32
FORCED_SCORE = 1e4
WINDOW = 512

FOX_HEADS = 8

PEER_HEADS = 8
PEER_N_KEYS = 128
PEER_N_EXPERTS = PEER_N_KEYS * PEER_N_KEYS
PEER_KEY_DIM = 256
PEER_HALF = PEER_KEY_DIM // 2
PEER_TOPK = 16
PEER_TOKEN_CHUNK = 128

NSA_Q_W = NSA_HEADS * HEAD_DIM
NSA_KV_W = NSA_KV_GROUPS * HEAD_DIM
NSA_GATE_W = 3 * NSA_HEADS
FOX_W = FOX_HEADS * HEAD_DIM
IN_WIDTHS = (NSA_Q_W, NSA_KV_W, NSA_KV_W, NSA_KV_W, NSA_KV_W, NSA_KV_W, NSA_KV_W, NSA_GATE_W, FOX_W, FOX_W, FOX_W, FOX_HEADS, D_MODEL, D_MODEL)
IN_TOTAL = sum(IN_WIDTHS)

kernel_name = 'nsa_fox_peer_hybrid_block'


def rms_norm(x, g):
    xf = x.astype(jnp.float32)
    y = xf * lax.rsqrt(jnp.mean(xf * xf, axis=-1, keepdims=True) + NORM_EPS)
    return (y * g.astype(jnp.float32)).astype(x.dtype)


def rope_cos_sin(pos):
    inv_freq = ROPE_THETA ** (-jnp.arange(0, HEAD_DIM, 2, dtype=jnp.float32) / HEAD_DIM)
    ang = pos.astype(jnp.float32)[:, None] * inv_freq[None, :]
    return jnp.cos(ang), jnp.sin(ang)


def apply_rope(x, cos, sin):
    half = HEAD_DIM // 2
    xf = x.astype(jnp.float32)
    x1, x2 = xf[..., :half], xf[..., half:]
    c, s = cos[None, :, None, :], sin[None, :, None, :]
    return jnp.concatenate([x1 * c - x2 * s, x2 * c + x1 * s], axis=-1).astype(x.dtype)


def masked_softmax(s, mask):
    s = jnp.where(mask, s.astype(jnp.float32), NEG_INF)
    m = jnp.max(s, axis=-1, keepdims=True)
    e = jnp.where(mask, jnp.exp(s - m), 0.0)
    return e / jnp.maximum(jnp.sum(e, axis=-1, keepdims=True), TINY)


def compress(tok, pos_emb, w1, w2):
    B, S, G, D = tok.shape
    n_chunks = S // CMP_STRIDE
    ratio = CMP_BLOCK // CMP_STRIDE
    n_blk = n_chunks - ratio + 1
    chunks = tok.reshape(B, n_chunks, CMP_STRIDE, G, D)
    blocks = jnp.concatenate([chunks[:, m:m + n_blk] for m in range(ratio)], axis=2)
    blocks = blocks + pos_emb[None, None, :, None, :]
    flat = blocks.transpose(0, 1, 3, 2, 4).reshape(B, n_blk, G, CMP_BLOCK * D)
    return jax.nn.gelu(flat @ w1) @ w2


def nsa_compressed(q, kc, vc):
    S, Nc = q.shape[1], kc.shape[1]
    s = jnp.einsum('bsghd,bngd->bghsn', q, kc) * (HEAD_DIM ** -0.5)
    t = jnp.arange(S)
    end = jnp.arange(Nc) * CMP_STRIDE + CMP_BLOCK - 1
    p = masked_softmax(s, end[None, :] <= t[:, None])
    o = jnp.einsum('bghsn,bngd->bsghd', p.astype(vc.dtype), vc)
    return o, p


def select_blocks(p_cmp):
    S, Nc = p_cmp.shape[3], p_cmp.shape[4]
    Ns = S // SEL_BLOCK
    c_start = np.arange(Nc) * CMP_STRIDE
    s_start = np.arange(Ns) * SEL_BLOCK
    overlap = (c_start[:, None] < s_start[None, :] + SEL_BLOCK) & (s_start[None, :] < c_start[:, None] + CMP_BLOCK)
    imp = jnp.einsum('bghsn,nj->bgsj', p_cmp, jnp.asarray(overlap, jnp.float32))
    t = jnp.arange(S)
    cur = t // SEL_BLOCK
    j = jnp.arange(Ns)
    forced = (j[None, :] == 0) | (j[None, :] == cur[:, None]) | (j[None, :] == cur[:, None] - 1)
    future = j[None, :] * SEL_BLOCK > t[:, None]
    score = jnp.where(forced, FORCED_SCORE, imp)
    score = jnp.where(future, NEG_INF, score)
    _, idx = lax.top_k(score, min(SEL_TOPK, Ns))
    return idx


def nsa_selected(q, k, v, idx):
    B, S, G, Hg, D = q.shape
    Ns = S // SEL_BLOCK
    n = idx.shape[-1]
    kb = k.reshape(B, Ns, SEL_BLOCK, G, D).transpose(0, 3, 1, 2, 4)
    vb = v.reshape(B, Ns, SEL_BLOCK, G, D).transpose(0, 3, 1, 2, 4)
    C = SEL_Q_CHUNK
    nC = S // C
    qc = q.reshape(B, nC, C, G, Hg, D).transpose(1, 0, 2, 3, 4, 5)
    ic = idx.reshape(B, G, nC, C, n).transpose(2, 0, 1, 3, 4)
    gather = jax.vmap(jax.vmap(lambda tab, ix: tab[ix]))
    scale = HEAD_DIM ** -0.5

    def chunk(args):
        qi, ii, c0 = args
        kg = gather(kb, ii)
        vg = gather(vb, ii)
        s = jnp.einsum('bcghd,bgcnkd->bghcnk', qi, kg) * scale
        tq = c0 + jnp.arange(C)
        kpos = ii[..., None] * SEL_BLOCK + jnp.arange(SEL_BLOCK)
        mask = (kpos <= tq[None, None, :, None, None]).reshape(B, G, 1, C, n * SEL_BLOCK)
        p = masked_softmax(s.reshape(B, G, Hg, C, n * SEL_BLOCK), mask).reshape(B, G, Hg, C, n, SEL_BLOCK)
        return jnp.einsum('bghcnk,bgcnkd->bcghd', p.astype(vg.dtype), vg)

    o = lax.map(chunk, (qc, ic, jnp.arange(nC) * C))
    return o.transpose(1, 0, 2, 3, 4, 5).reshape(B, S, G, Hg, D)


def nsa_window(q, k, v):
    B, S, G, Hg, D = q.shape
    nQ = S // Q_BLOCK
    L = Q_BLOCK + WINDOW
    kp = jnp.pad(k, ((0, 0), (WINDOW, 0), (0, 0), (0, 0)))
    vp = jnp.pad(v, ((0, 0), (WINDOW, 0), (0, 0), (0, 0)))
    qb = q.reshape(B, nQ, Q_BLOCK, G, Hg, D).transpose(1, 0, 2, 3, 4, 5)
    scale = HEAD_DIM ** -0.5

    def blk(args):
        qi, i = args
        start = i * Q_BLOCK
        ki = lax.dynamic_slice_in_dim(kp, start, L, axis=1)
        vi = lax.dynamic_slice_in_dim(vp, start, L, axis=1)
        s = jnp.einsum('bqghd,bkgd->bghqk', qi, ki) * scale
        tq = start + jnp.arange(Q_BLOCK)
        spos = start - WINDOW + jnp.arange(L)
        diff = tq[:, None] - spos[None, :]
        mask = (spos[None, :] >= 0) & (diff >= 0) & (diff < WINDOW)
        p = masked_softmax(s, mask)
        return jnp.einsum('bghqk,bkgd->bqghd', p.astype(vi.dtype), vi)

    o = lax.map(blk, (qb, jnp.arange(nQ)))
    return o.transpose(1, 0, 2, 3, 4, 5).reshape(B, S, G, Hg, D)


def fox_attention(q, k, v, log_f):
    B, S, H, D = q.shape
    nQ = S // Q_BLOCK
    c = lax.cumsum(log_f, axis=1).transpose(0, 2, 1)
    qb = q.reshape(B, nQ, Q_BLOCK, H, D).transpose(1, 0, 2, 3, 4)
    cb = c.reshape(B, H, nQ, Q_BLOCK).transpose(2, 0, 1, 3)
    scale = D ** -0.5
    kpos = jnp.arange(S)

    def blk(args):
        qi, ci, i = args
        s = jnp.einsum('bqhd,bkhd->bhqk', qi, k).astype(jnp.float32) * scale + ci[..., None] - c[:, :, None, :]
        tq = i * Q_BLOCK + jnp.arange(Q_BLOCK)
        p = masked_softmax(s, kpos[None, :] <= tq[:, None])
        return jnp.einsum('bhqk,bkhd->bqhd', p.astype(v.dtype), v)

    o = lax.map(blk, (qb, cb, jnp.arange(nQ)))
    return o.transpose(1, 0, 2, 3, 4).reshape(B, S, H, D)


def peer(x, w_query, sub_keys_1, sub_keys_2, expert_down, expert_up):
    B, S, D = x.shape
    T = B * S
    xt = x.reshape(T, D)
    q = (xt @ w_query).reshape(T, PEER_HEADS, PEER_KEY_DIM)
    s1 = jnp.einsum('thd,hkd->thk', q[..., :PEER_HALF], sub_keys_1).astype(jnp.float32)
    s2 = jnp.einsum('thd,hkd->thk', q[..., PEER_HALF:], sub_keys_2).astype(jnp.float32)
    v1, i1 = lax.top_k(s1, PEER_TOPK)
    v2, i2 = lax.top_k(s2, PEER_TOPK)
    cand = (v1[..., :, None] + v2[..., None, :]).reshape(T, PEER_HEADS, PEER_TOPK * PEER_TOPK)
    cand_idx = (i1[..., :, None] * PEER_N_KEYS + i2[..., None, :]).reshape(T, PEER_HEADS, PEER_TOPK * PEER_TOPK)
    top_s, pos = lax.top_k(cand, PEER_TOPK)
    eidx = jnp.take_along_axis(cand_idx, pos, axis=-1)
    g = jax.nn.softmax(top_s, axis=-1)
    C = PEER_TOKEN_CHUNK
    nC = T // C
    HK = PEER_HEADS * PEER_TOPK

    def chunk(args):
        xi, ei, gi = args
        u = expert_down[ei]
        a = jax.nn.gelu(jnp.einsum('cd,ced->ce', xi, u)).astype(jnp.float32)
        w = (a * gi).astype(xi.dtype)
        return jnp.einsum('ce,ced->cd', w, expert_up[ei])

    out = lax.map(chunk, (xt.reshape(nC, C, D), eidx.reshape(nC, C, HK), g.reshape(nC, C, HK)))
    return out.reshape(B, S, D)


def setup_inputs(seed: int = 0) -> dict:
    key = jax.random.key(seed)
    ks = jax.random.split(key, 24)
    f32 = jnp.float32

    def nrm(k, shape, scale):
        return jax.random.normal(k, shape, f32) * scale

    return {
        'x': nrm(ks[0], (BATCH, SEQ, D_MODEL), 1.0),
        'norm_mix_gain': 1.0 + nrm(ks[1], (DEPTH, D_MODEL), 0.05),
        'w_in': nrm(ks[2], (DEPTH, D_MODEL, IN_TOTAL), D_MODEL ** -0.5),
        'nsa_gate_bias': nrm(ks[3], (DEPTH, NSA_GATE_W), 0.1),
        'fox_forget_bias': 3.0 + nrm(ks[4], (DEPTH, FOX_HEADS), 0.5),
        'merge_gate_bias': nrm(ks[5], (DEPTH, 2 * D_MODEL), 0.1),
        'k_cmp_pos': nrm(ks[6], (DEPTH, CMP_BLOCK, HEAD_DIM), 0.1),
        'k_cmp_w1': nrm(ks[7], (DEPTH, CMP_BLOCK * HEAD_DIM, CMP_HIDDEN), (CMP_BLOCK * HEAD_DIM) ** -0.5),
        'k_cmp_w2': nrm(ks[8], (DEPTH, CMP_HIDDEN, HEAD_DIM), CMP_HIDDEN ** -0.5),
        'v_cmp_pos': nrm(ks[9], (DEPTH, CMP_BLOCK, HEAD_DIM), 0.1),
        'v_cmp_w1': nrm(ks[10], (DEPTH, CMP_BLOCK * HEAD_DIM, CMP_HIDDEN), (CMP_BLOCK * HEAD_DIM) ** -0.5),
        'v_cmp_w2': nrm(ks[11], (DEPTH, CMP_HIDDEN, HEAD_DIM), CMP_HIDDEN ** -0.5),
        'w_up_nsa': nrm(ks[12], (DEPTH, NSA_Q_W, D_MODEL), NSA_Q_W ** -0.5),
        'w_up_fox': nrm(ks[13], (DEPTH, FOX_W, D_MODEL), FOX_W ** -0.5),
        'w_out': nrm(ks[14], (DEPTH, D_MODEL, D_MODEL), D_MODEL ** -0.5),
        'norm_ffn_gain': 1.0 + nrm(ks[15], (DEPTH, D_MODEL), 0.05),
        'peer_w_query': nrm(ks[16], (DEPTH, D_MODEL, PEER_HEADS * PEER_KEY_DIM), D_MODEL ** -0.5),
        'peer_sub_keys_1': nrm(ks[17], (DEPTH, PEER_HEADS, PEER_N_KEYS, PEER_HALF), PEER_HALF ** -0.5),
        'peer_sub_keys_2': nrm(ks[18], (DEPTH, PEER_HEADS, PEER_N_KEYS, PEER_HALF), PEER_HALF ** -0.5),
        'peer_expert_down': nrm(ks[19], (DEPTH, PEER_N_EXPERTS, D_MODEL), D_MODEL ** -0.5),
        'peer_expert_up': nrm(ks[20], (DEPTH, PEER_N_EXPERTS, D_MODEL), 0.5),
        'norm_final_gain': 1.0 + nrm(ks[21], (D_MODEL,), 0.05),
    }


def reference(x, norm_mix_gain, w_in, nsa_gate_bias, fox_forget_bias, merge_gate_bias, k_cmp_pos, k_cmp_w1, k_cmp_w2, v_cmp_pos, v_cmp_w1, v_cmp_w2, w_up_nsa, w_up_fox, w_out, norm_ffn_gain, peer_w_query, peer_sub_keys_1, peer_sub_keys_2, peer_expert_down, peer_expert_up, norm_final_gain):
    B, S, _ = x.shape
    cos_t, sin_t = rope_cos_sin(jnp.arange(S))
    n_cmp = S // CMP_STRIDE - CMP_BLOCK // CMP_STRIDE + 1
    cos_c, sin_c = rope_cos_sin(jnp.arange(n_cmp) * CMP_STRIDE + CMP_BLOCK - 1)
    split_at = np.cumsum(np.array(IN_WIDTHS))[:-1].tolist()

    def grp(a):
        return a.reshape(B, S, NSA_KV_GROUPS, HEAD_DIM)

    for l in range(DEPTH):
        h = rms_norm(x, norm_mix_gain[l])
        proj = jnp.einsum('bsd,de->bse', h, w_in[l])
        (q_n, k_c, v_c, k_s, v_s, k_w, v_w, g_n, q_f, k_f, v_f, f_f, g_a, g_b) = jnp.split(proj, split_at, axis=-1)

        q_n = apply_rope(q_n.reshape(B, S, NSA_HEADS, HEAD_DIM), cos_t, sin_t).reshape(B, S, NSA_KV_GROUPS, NSA_HPG, HEAD_DIM)
        kc = apply_rope(compress(grp(k_c), k_cmp_pos[l], k_cmp_w1[l], k_cmp_w2[l]), cos_c, sin_c)
        vc = compress(grp(v_c), v_cmp_pos[l], v_cmp_w1[l], v_cmp_w2[l])
        o_cmp, p_cmp = nsa_compressed(q_n, kc, vc)
        idx = select_blocks(p_cmp)
        o_sel = nsa_selected(q_n, apply_rope(grp(k_s), cos_t, sin_t), grp(v_s), idx)
        o_win = nsa_window(q_n, apply_rope(grp(k_w), cos_t, sin_t), grp(v_w))
        gates = jax.nn.sigmoid(g_n + nsa_gate_bias[l]).reshape(B, S, NSA_KV_GROUPS, NSA_HPG, 3)
        o_nsa = (gates[..., 0:1] * o_cmp + gates[..., 1:2] * o_sel + gates[..., 2:3] * o_win).reshape(B, S, NSA_Q_W)

        log_f = jax.nn.log_sigmoid((f_f + fox_forget_bias[l]).astype(jnp.float32))
        o_fox = fox_attention(q_f.reshape(B, S, FOX_HEADS, HEAD_DIM), k_f.reshape(B, S, FOX_HEADS, HEAD_DIM), v_f.reshape(B, S, FOX_HEADS, HEAD_DIM), log_f).reshape(B, S, FOX_W)

        merged = (jax.nn.sigmoid(g_a + merge_gate_bias[l, :D_MODEL]) * (o_nsa @ w_up_nsa[l])
                  + jax.nn.sigmoid(g_b + merge_gate_bias[l, D_MODEL:]) * (o_fox @ w_up_fox[l]))
        x = x + merged @ w_out[l]

        x = x + peer(rms_norm(x, norm_ffn_gain[l]), peer_w_query[l], peer_sub_keys_1[l], peer_sub_keys_2[l], peer_expert_down[l], peer_expert_up[l])
    return rms_norm(x, norm_final_gain)
```

```cpp
#include <hip/hip_runtime.h>
#include <hip/hip_cooperative_groups.h>
#include <cstdio>
#include <cstdint>
namespace cg = cooperative_groups;

#define LAS __attribute__((address_space(3)))
typedef unsigned short bf16_t;
typedef short bf16x8 __attribute__((ext_vector_type(8)));
typedef short s16x4 __attribute__((ext_vector_type(4)));
typedef float f32x2 __attribute__((ext_vector_type(2)));
typedef float f32x4 __attribute__((ext_vector_type(4)));
typedef float f32x16 __attribute__((ext_vector_type(16)));
typedef unsigned u32x2 __attribute__((ext_vector_type(2)));
typedef unsigned u32x4 __attribute__((ext_vector_type(4)));
typedef __bf16 bf16x2v __attribute__((ext_vector_type(2)));

constexpr int T_TOK = 16384, DM = 2048, NB = 8, SEQ = 2048;
constexpr int NWIN = 9984;
constexpr float NORM_EPS = 1e-6f;
constexpr float LOG2E = 1.4426950408889634f;
constexpr float ATT_SCALE = 0.08838834764831845f;

constexpr float SC_X = 16.f, SC_WIN = 1024.f, SC_O = 16.f, SC_WUP = 512.f, SC_M = 64.f, SC_WOUT = 1024.f;
constexpr size_t MiB = 1ull << 20;
constexpr size_t OFF_ED = 0, OFF_EU = 64 * MiB, OFF_XB = 128 * MiB  , OFF_WINT = 192 * MiB  ;
constexpr size_t OFF_WUPT = 232 * MiB, OFF_WOUTT = 240 * MiB, OFF_WQT = 248 * MiB, OFF_W1T = 256 * MiB, OFF_MISC = 260 * MiB;
constexpr size_t OFF_QN = 268 * MiB, OFF_KV6 = 300 * MiB, OFF_QKVF = 350 * MiB  ;
constexpr size_t OFF_KCVC = 446 * MiB, OFF_SEL = 447 * MiB, OFF_SSQ2 = 448 * MiB, OFF_EIDX = 452 * MiB, OFF_GSM = 460 * MiB, WS_END = 468 * MiB;
constexpr size_t M_ROPE = 0  , M_K12 = 1 * MiB  , M_B1P = M_K12 + 512 * 1024  ;
constexpr size_t M_B1 = M_B1P + 128 * 1024  , M_SSQ1 = M_B1P + 160 * 1024  , M_GN = 2 * MiB  , M_LOGF = 4 * MiB  , M_CFOX = M_LOGF + 512 * 1024;
constexpr size_t M_CTL = 5 * MiB  ;
constexpr size_t OFF_ESCL = OFF_MISC + 6 * MiB;

struct Params {
    const float* in[22];
    float* out;
    unsigned char* ws;
};

__device__ __forceinline__ unsigned cvtpk(float lo, float hi) { unsigned r; asm volatile("v_cvt_pk_bf16_f32 %0, %1, %2" : "=v"(r) : "v"(lo), "v"(hi)); return r; }
__device__ __forceinline__ unsigned pack_fp8x4(float a, float b, float c, float d) {
    a = fminf(fmaxf(a, -448.f), 448.f); b = fminf(fmaxf(b, -448.f), 448.f); c = fminf(fmaxf(c, -448.f), 448.f); d = fminf(fmaxf(d, -448.f), 448.f);
    int pk = 0; pk = __builtin_amdgcn_cvt_pk_fp8_f32(a, b, pk, false); pk = __builtin_amdgcn_cvt_pk_fp8_f32(c, d, pk, true); return (unsigned)pk; }
__device__ __forceinline__ unsigned pack_i8x4(float a, float b, float c, float d) {
    const int ia = (int)__builtin_rintf(a), ib = (int)__builtin_rintf(b), ic = (int)__builtin_rintf(c), id = (int)__builtin_rintf(d);
    return ((unsigned)ia & 0xffu) | (((unsigned)ib & 0xffu) << 8) | (((unsigned)ic & 0xffu) << 16) | ((unsigned)id << 24); }
__device__ __forceinline__ float bf_lo(unsigned u) { return __uint_as_float(u << 16); }
__device__ __forceinline__ float bf_hi(unsigned u) { return __uint_as_float(u & 0xffff0000u); }
__device__ __forceinline__ float sigmoidf_(float x) { return __builtin_amdgcn_rcpf(1.0f + __builtin_amdgcn_exp2f(-LOG2E * x)); }
__device__ __forceinline__ float gelu_tanh(float x) { const float u = 0.7978845608028654f * (x + 0.044715f * x * x * x); const float e = __builtin_amdgcn_exp2f(2.0f * LOG2E * u); const float t = 1.0f - 2.0f * __builtin_amdgcn_rcpf(e + 1.0f); return 0.5f * x * (1.0f + t); }
__device__ __forceinline__ int tid_opaque() { int t = threadIdx.x; asm volatile("" : "+v"(t)); return t; }
template <int CTRL> __device__ __forceinline__ float dppx(float v) { return __uint_as_float((unsigned)__builtin_amdgcn_update_dpp(0, (int)__float_as_uint(v), CTRL, 0xf, 0xf, true)); }
constexpr int DPP_XOR1 = 0xB1  , DPP_XOR2 = 0x4E  , DPP_HMIRROR = 0x141  , DPP_MIRROR = 0x140  ;
__device__ __forceinline__ float swap16_sum(float v) { auto r = __builtin_amdgcn_permlane16_swap(__float_as_uint(v), __float_as_uint(v), false, false); return __uint_as_float(r[0]) + __uint_as_float(r[1]); }
__device__ __forceinline__ float swap32_sum(float v) { auto r = __builtin_amdgcn_permlane32_swap(__float_as_uint(v), __float_as_uint(v), false, false); return __uint_as_float(r[0]) + __uint_as_float(r[1]); }
__device__ __forceinline__ float swap16_max(float v) { auto r = __builtin_amdgcn_permlane16_swap(__float_as_uint(v), __float_as_uint(v), false, false); return fmaxf(__uint_as_float(r[0]), __uint_as_float(r[1])); }
__device__ __forceinline__ float swap32_max(float v) { auto r = __builtin_amdgcn_permlane32_swap(__float_as_uint(v), __float_as_uint(v), false, false); return fmaxf(__uint_as_float(r[0]), __uint_as_float(r[1])); }
__device__ __forceinline__ float xor32(float v, int hi) { auto r = __builtin_amdgcn_permlane32_swap(__float_as_uint(v), __float_as_uint(v), false, false); return __uint_as_float(hi ? r[0] : r[1]); }
__device__ __forceinline__ float wave_sum(float v) {
    v += dppx<DPP_XOR1>(v); v += dppx<DPP_XOR2>(v); v += dppx<DPP_HMIRROR>(v); v += dppx<DPP_MIRROR>(v);
    return swap32_sum(swap16_sum(v));
}
__device__ __forceinline__ float wave_max(float v) {
    v = fmaxf(v, dppx<DPP_XOR1>(v)); v = fmaxf(v, dppx<DPP_XOR2>(v)); v = fmaxf(v, dppx<DPP_HMIRROR>(v)); v = fmaxf(v, dppx<DPP_MIRROR>(v));
    return swap32_max(swap16_max(v));
}
__device__ __forceinline__ float butterfly16(float (&dd)[16], int lane) {
#define BF_STEP(S, N, CTRL) do { const bool up = (lane & (S)) != 0; _Pragma("unroll") for (int i = 0; i < (N); ++i) { const float send = up ? dd[i] : dd[i + (N)]; const float keep = up ? dd[i + (N)] : dd[i]; dd[i] = keep + dppx<CTRL>(send); } } while (0)
    BF_STEP(8, 8, DPP_MIRROR); BF_STEP(4, 4, DPP_HMIRROR); BF_STEP(2, 2, DPP_XOR2); BF_STEP(1, 1, DPP_XOR1);
#undef BF_STEP
    return swap32_sum(swap16_sum(dd[0]));
}
#define CE_DESC(a, b) do { const float _x = fmaxf(a, b), _y = fminf(a, b); a = _x; b = _y; } while (0)
template <int N> __device__ __forceinline__ void bitonic_sort_desc(float (&v)[N]) {
#pragma unroll
    for (int k = 2; k <= N; k <<= 1)
#pragma unroll
        for (int j = k >> 1; j > 0; j >>= 1)
#pragma unroll
            for (int i = 0; i < N; ++i) { const int l = i ^ j; if (l > i) { if ((i & k) == 0) { CE_DESC(v[i], v[l]); } else { CE_DESC(v[l], v[i]); } } }
}
__device__ __forceinline__ void merge_top16(float (&a)[16], const float (&b)[16]) {
#pragma unroll
    for (int i = 0; i < 16; ++i) a[i] = fmaxf(a[i], b[15 - i]);
#pragma unroll
    for (int j = 8; j > 0; j >>= 1)
#pragma unroll
        for (int i = 0; i < 16; ++i) { const int l = i ^ j; if (l > i) CE_DESC(a[i], a[l]); }
}

__device__ __forceinline__ int win_src_col(int n) {
    const int tile = n >> 8, w = n & 255;
    if (tile < 4) { const int p = w & 127, hd = tile * 2 + (w >> 7), q = p >> 3, e = p & 7; const int d = e < 4 ? 4 * q + e : 64 + 4 * q + (e - 4); return hd * 128 + d; }
    if (tile < 10) { const int idx = tile - 4, g = w >> 7, p = w & 127; int d = p; if (idx == 2 || idx == 4) { const int q = p >> 3, e = p & 7; d = e < 4 ? 4 * q + e : 64 + 4 * q + (e - 4); } return 1024 + idx * 256 + g * 128 + d; }
    if (tile < 22) return 2584 + (n - 2560);
    if (tile < 38) { const int j = tile - 22; return w < 128 ? 5664 + 128 * j + w : 7712 + 128 * j + (w - 128); }
    if (w < 24) return 2560 + w;
    if (w < 32) return 5656 + (w - 24);
    return -1;
}
template <int MAPKIND, bool OUT8>
__device__ __forceinline__ void transpose_tile_w(const float* __restrict__ src, int ld_src, const float* __restrict__ gain, void* __restrict__ dstv, int ld_dst, int k0, int n0, float* tl, int lane, float scale) {
    const int sc = MAPKIND == 1 ? win_src_col(n0 + lane) : n0 + lane;
    const float* sp = src + (size_t)k0 * ld_src + (sc >= 0 ? sc : 0);
#pragma unroll 1
    for (int kb = 0; kb < 64; kb += 32) {
        float v[32];
#pragma unroll
        for (int i = 0; i < 32; ++i) v[i] = sp[(size_t)(kb + i) * ld_src];
#pragma unroll
        for (int i = 0; i < 32; ++i) { float x = sc >= 0 ? v[i] * scale : 0.f; if (gain) x *= gain[k0 + kb + i]; tl[(kb + i) * 65 + lane] = x; }
    }
    asm volatile("s_waitcnt lgkmcnt(0)" ::: "memory"); __builtin_amdgcn_wave_barrier();
    if constexpr (OUT8) {
        unsigned char* dst = (unsigned char*)dstv; const int kq = (lane & 3) * 16, rq = lane >> 2;
#pragma unroll
        for (int r = 0; r < 4; ++r) { const int n2 = r * 16 + rq; u32x4 w;
#pragma unroll
            for (int q = 0; q < 4; ++q) w[q] = pack_fp8x4(tl[(kq + 4 * q + 0) * 65 + n2], tl[(kq + 4 * q + 1) * 65 + n2], tl[(kq + 4 * q + 2) * 65 + n2], tl[(kq + 4 * q + 3) * 65 + n2]);
            *(u32x4*)(dst + (size_t)(n0 + n2) * ld_dst + k0 + kq) = w; }
    } else {
        bf16_t* dst = (bf16_t*)dstv; const int kq = (lane & 15) * 4, rq = lane >> 4;
#pragma unroll 4
        for (int r = 0; r < 16; ++r) { const int n2 = r * 4 + rq;
            u32x2 w; w.x = cvtpk(tl[(kq + 0) * 65 + n2], tl[(kq + 1) * 65 + n2]); w.y = cvtpk(tl[(kq + 2) * 65 + n2], tl[(kq + 3) * 65 + n2]);
            *(u32x2*)(dst + (size_t)(n0 + n2) * ld_dst + k0 + kq) = w; }
    }
    asm volatile("s_waitcnt lgkmcnt(0)" ::: "memory"); __builtin_amdgcn_wave_barrier();
}
template <int MAPKIND, bool OUT8>
__device__ __forceinline__ void transpose_job(const float* src, int ld_src, int K, const float* gain, void* dst, int ld_dst, int N_dst, float* tl, int& jb, int gw, int nw, int lane, float scale) {
    const int nkt = K / 64, nnt = N_dst / 64, total = nkt * nnt;
    for (int j = (gw + nw - (jb % nw)) % nw; j < total; j += nw) {
        const int nt = j % nnt, kt = j / nnt;
        transpose_tile_w<MAPKIND, OUT8>(src, ld_src, gain, dst, ld_dst, kt * 64, nt * 64, tl, lane, scale);
    }
    jb += total;
}

__device__ __forceinline__ void convert_expert_rows(const Params& p, int r0, int r1, int lane) {
    const float* g2 = p.in[15];
    unsigned char* E8 = p.ws + OFF_ED; float* scl = (float*)(p.ws + OFF_ESCL);
    f32x4 v[2][2][4]; float mx[2] = {0.f, 0.f};
#pragma unroll
    for (int u = 0; u < 2; ++u) { const int r = u ? r1 : r0; const int which = r >> 14, e = r & 16383; const float* src = p.in[19 + which] + (size_t)e * 2048;
#pragma unroll
        for (int j = 0; j < 2; ++j)
#pragma unroll
            for (int q = 0; q < 4; ++q) v[u][j][q] = *(const f32x4*)(src + j * 1024 + lane * 16 + q * 4); }
#pragma unroll
    for (int u = 0; u < 2; ++u) { const int r = u ? r1 : r0; const int which = r >> 14, e = r & 16383;
#pragma unroll
        for (int j = 0; j < 2; ++j)
#pragma unroll
            for (int q = 0; q < 4; ++q) { f32x4 t = v[u][j][q]; if (which == 0) t *= *(const f32x4*)(g2 + j * 1024 + lane * 16 + q * 4); v[u][j][q] = t;
                mx[u] = fmaxf(mx[u], fmaxf(fmaxf(fabsf(t[0]), fabsf(t[1])), fmaxf(fabsf(t[2]), fabsf(t[3])))); }
        mx[u] = wave_max(mx[u]);
        if (which == 0) {
            const float rowmax = fmaxf(mx[u], 1e-30f);
            unsigned char* rec = E8 + (size_t)e * 1152; u32x4 w; unsigned rbs = 0u;
#pragma unroll
            for (int j = 0; j < 2; ++j) {
                float gm = 0.f;
#pragma unroll
                for (int q = 0; q < 4; ++q) gm = fmaxf(gm, fmaxf(fmaxf(fabsf(v[u][j][q][0]), fabsf(v[u][j][q][1])), fmaxf(fabsf(v[u][j][q][2]), fabsf(v[u][j][q][3]))));
                float rbf = __builtin_ceilf(gm * (255.0f / rowmax)); rbf = fminf(fmaxf(rbf, 1.0f), 255.0f);
                const float inv = (255.0f * 7.0f) / (rowmax * rbf);
                unsigned nb[2] = {0u, 0u};
#pragma unroll
                for (int q = 0; q < 4; ++q)
#pragma unroll
                    for (int i = 0; i < 4; ++i) { const float t = fminf(fmaxf(__builtin_rintf(v[u][j][q][i] * inv), -7.f), 7.f); const unsigned nib = (unsigned)(int)t & 15u; const int el = q * 4 + i;
                        nb[el >> 3] |= nib << (4 * (el & 7)); }
                w[2 * j] = nb[0]; w[2 * j + 1] = nb[1];
                rbs |= (unsigned)rbf << (8 * j);
            }
            *(u32x4*)(rec + lane * 16) = w;
            *(unsigned short*)(rec + 1024 + lane * 2) = (unsigned short)rbs;
            if (lane == 0) scl[e] = rowmax * (1.0f / (255.0f * 7.0f));
            continue;
        }
        const float sc = fmaxf(mx[u], 1e-30f) * (1.0f / 7.5f), inv = 1.0f / sc;
        unsigned w6[7] = {0u, 0u, 0u, 0u, 0u, 0u, 0u};
#pragma unroll
        for (int j = 0; j < 2; ++j)
#pragma unroll
            for (int q = 0; q < 4; ++q)
#pragma unroll
                for (int i = 0; i < 4; ++i) { const float t = v[u][j][q][i] * inv; const float a = fminf(fabsf(t), 7.5f);
                    const float c1 = __builtin_rintf(a * 8.0f), c2 = __builtin_rintf(a * 4.0f) + 8.0f, c3 = __builtin_rintf(a * 2.0f) + 16.0f;
                    const unsigned code = (unsigned)(int)(a < 2.0f ? c1 : (a < 4.0f ? c2 : c3)) | ((__float_as_uint(t) >> 31) << 5);
                    const int bit = 6 * (j * 16 + q * 4 + i), d = bit >> 5, sh = bit & 31;
                    w6[d] |= code << sh; if (sh > 26) w6[d + 1] |= code >> (32 - sh); }
        { unsigned char* rec = E8 + (size_t)which * (16384 * 2048) + (size_t)e * 1536;
          *(u32x4*)(rec + lane * 16) = (u32x4){w6[0], w6[1], w6[2], w6[3]}; *(u32x2*)(rec + 1024 + lane * 8) = (u32x2){w6[4], w6[5]}; }
        if (lane == 0) scl[which * 16384 + e] = sc; }
}

__device__ __forceinline__ void phase_prep(const Params& p, unsigned char* lds_raw) {
    const int tid = tid_opaque(), wid = tid >> 6, lane = tid & 63;
    float* tl = (float*)lds_raw + wid * (64 * 65);
    const int gw = blockIdx.x * 8 + wid, nw = gridDim.x * 8;
    unsigned char* ws = p.ws;
#ifndef P0_REP_A
#define P0_REP_A 1
#define P0_REP_B 1
#define P0_REP_C 1
#endif
    for (int rep = 0; rep < P0_REP_A; ++rep) {
        const float* x = p.in[0]; unsigned char* xb = ws + OFF_XB; float* ssq1 = (float*)(ws + OFF_MISC + M_SSQ1);
        for (int r = gw; r < T_TOK; r += 2 * nw) {
            const int r2 = r + nw < T_TOK ? r + nw : r;
            f32x4 va[8], vb[8];
#pragma unroll
            for (int j = 0; j < 8; ++j) { va[j] = *(const f32x4*)(x + (size_t)r * DM + j * 256 + lane * 4); vb[j] = *(const f32x4*)(x + (size_t)r2 * DM + j * 256 + lane * 4); }
            float sa = 0.f, sb = 0.f;
#pragma unroll
            for (int j = 0; j < 8; ++j) { const f32x4 v = va[j]; sa += v[0] * v[0] + v[1] * v[1] + v[2] * v[2] + v[3] * v[3];
                *(unsigned*)(xb + (size_t)r * DM + j * 256 + lane * 4) = pack_fp8x4(v[0] * SC_X, v[1] * SC_X, v[2] * SC_X, v[3] * SC_X); }
#pragma unroll
            for (int j = 0; j < 8; ++j) { const f32x4 v = vb[j]; sb += v[0] * v[0] + v[1] * v[1] + v[2] * v[2] + v[3] * v[3];
                *(unsigned*)(xb + (size_t)r2 * DM + j * 256 + lane * 4) = pack_fp8x4(v[0] * SC_X, v[1] * SC_X, v[2] * SC_X, v[3] * SC_X); }
            sa = wave_sum(sa); sb = wave_sum(sb); if (lane == 0) { ssq1[r] = sa; ssq1[r2] = sb; }
        }
    }
    for (int rep = 0; rep < P0_REP_B; ++rep) {
        int jb = 0;
        transpose_job<1, true>(p.in[2], 9760, 2048, p.in[1], ws + OFF_WINT, 2048, NWIN, tl, jb, gw, nw, lane, SC_WIN);
        transpose_job<0, true>(p.in[12], 2048, 1024, nullptr, ws + OFF_WUPT, 2048, 2048, tl, jb, gw, nw, lane, SC_WUP);
        transpose_job<0, true>(p.in[13], 2048, 1024, nullptr, ws + OFF_WUPT + 1024, 2048, 2048, tl, jb, gw, nw, lane, SC_WUP);
        transpose_job<0, true>(p.in[14], 2048, 2048, nullptr, ws + OFF_WOUTT, 2048, 2048, tl, jb, gw, nw, lane, SC_WOUT);
        transpose_job<0, false>(p.in[16], 2048, 2048, p.in[15], ws + OFF_WQT, 2048, 2048, tl, jb, gw, nw, lane, 1.0f);
        transpose_job<0, false>(p.in[7], 256, 4096, nullptr, ws + OFF_W1T, 4096, 256, tl, jb, gw, nw, lane, 1.0f);
        transpose_job<0, false>(p.in[10], 256, 4096, nullptr, ws + OFF_W1T + (size_t)256 * 4096 * 2, 4096, 256, tl, jb, gw, nw, lane, 1.0f);
    }
    for (int r0 = gw; r0 < 2 * 16384; r0 += 2 * nw) convert_expert_rows(p, r0, r0 + nw < 2 * 16384 ? r0 + nw : r0, lane);
#ifndef P0_REP_D
#define P0_REP_D 1
#define P0_REP_E 1
#define P0_REP_F 1
#endif
    for (int rep = 0; rep < P0_REP_D; ++rep) {
        bf16_t* K12 = (bf16_t*)(ws + OFF_MISC + M_K12);
        for (int i = blockIdx.x * 512 + tid; i < 2 * 131072 / 4; i += gridDim.x * 512) {
            const int which = i >= 32768, j = (i & 32767) * 4; const f32x4 v = *(const f32x4*)(p.in[17 + which] + j);
            u32x2 w; w.x = cvtpk(v[0], v[1]); w.y = cvtpk(v[2], v[3]); *(u32x2*)(K12 + which * 131072 + j) = w; }
    }
    for (int rep = 0; rep < P0_REP_E; ++rep) {
        f32x2* cs = (f32x2*)(ws + OFF_MISC + M_ROPE);
        for (int i = blockIdx.x * 512 + tid; i < 2048 * 64; i += gridDim.x * 512) {
            const int pos = i >> 6, f = i & 63; const float inv = exp2f(-(float)f * (13.287712379549449f / 64.0f));
            const float ang = (float)pos * inv;
            const float CH = 1.5915493667e-01f, CL = 6.4206383266e-09f;
            const float rev_hi = ang * CH; const float rev_lo = fmaf(ang, CH, -rev_hi) + ang * CL;
            float r = rev_hi - rintf(rev_hi); r += rev_lo;
            cs[i] = (f32x2){__builtin_amdgcn_cosf(r), __builtin_amdgcn_sinf(r)}; }
    }
    for (int rep = 0; rep < P0_REP_F; ++rep) {
        float* b1p = (float*)(ws + OFF_MISC + M_B1P);
        float* red = (float*)lds_raw;
        for (int j = blockIdx.x; j < 128; j += gridDim.x) { const int which = j >> 6, part = j & 63;
            const float* pos = p.in[which ? 9 : 6]; const float* w1 = p.in[which ? 10 : 7];
            f32x4 s = {0.f, 0.f, 0.f, 0.f};
#pragma unroll
            for (int i = 0; i < 8; ++i) { const int k = part * 64 + wid * 8 + i; s += *(const f32x4*)(w1 + (size_t)k * 256 + lane * 4) * pos[k]; }
            __syncthreads();
            *(f32x4*)(red + wid * 256 + lane * 4) = s;
            __syncthreads();
            if (tid < 256) { float t = 0.f;
#pragma unroll
                for (int w = 0; w < 8; ++w) t += red[w * 256 + tid];
                b1p[(which * 64 + part) * 256 + tid] = t; }
        }
        __syncthreads();
    }
    if (blockIdx.x == 0 && tid < 64) ((unsigned*)(ws + OFF_MISC + M_CTL))[tid] = 0u;
}
namespace pg8 {
constexpr int BM = 256, BK = 64, HALF = 128, HTB = HALF * BK * 2, STAGE_BYTES = 8 * HTB, NXCD = 8;
__host__ __device__ __forceinline__ int lds_byte(int r, int c) { const int st = (r >> 4) * 2 + (c >> 5), rr = r & 15, cc = c & 31, ob = rr * 64 + cc * 2; return st * 1024 + (ob ^ (((ob >> 9) & 1) << 5)); }
__host__ __device__ __forceinline__ void stage_rc(int b, int& R, int& C) { const int st = b / 1024, sb = b % 1024, swz = sb ^ (((sb >> 9) & 1) << 5); R = (st >> 1) * 16 + swz / 64; C = (st & 1) * 32 + (swz % 64) / 2; }
__host__ __device__ __forceinline__ int perm32(int rho) { const int n = rho >> 4, i = rho & 15; return 8 * (i >> 2) + 4 * n + (i & 3); }

constexpr int UF_ZERO = 1, UF_FINAL = 2;
struct Unit { const char* A; const char* B; int pm, pn, flags, aux; };

__device__ __forceinline__ bool static_tile(int L, int nM, int nN, int& pm, int& pn, int WGM) {
    const int nwg = nM * nN; if (L >= nwg) return false;
    int wgid = L; { const int q = nwg / NXCD, r = nwg % NXCD, xcd = wgid % NXCD, off = wgid / NXCD; wgid = (xcd < r ? xcd * (q + 1) : r * (q + 1) + (xcd - r) * q) + off; }
    const int nig = WGM * nN, gid = wgid / nig, fm = gid * WGM, gsz = (nM - fm) < WGM ? (nM - fm) : WGM;
    pm = fm + ((wgid % nig) % gsz); pn = (wgid % nig) / gsz; return true;
}

typedef int i32x8 __attribute__((ext_vector_type(8)));
__device__ __forceinline__ i32x8 cat8(const bf16x8 a, const bf16x8 b) { const u32x4 x = __builtin_bit_cast(u32x4, a), y = __builtin_bit_cast(u32x4, b); return (i32x8){(int)x[0], (int)x[1], (int)x[2], (int)x[3], (int)y[0], (int)y[1], (int)y[2], (int)y[3]}; }
template <bool FP8, bool NOEPI = false, class Epi, class Sched>
__device__ __forceinline__ void gemm_phase(LAS unsigned char* lds, const int K, const int lda, const int ldb, const Sched& S, const Epi& E) {
    int tid = threadIdx.x; asm volatile("" : "+v"(tid));
    const int wid = __builtin_amdgcn_readfirstlane(tid >> 6), lane = tid & 63, wr = wid >> 2, wc = wid & 3, fr = lane & 15, fq = lane >> 4;
    int nt = K / BK; asm volatile("" : "+s"(nt));
    unsigned voffA[2], voffB[2];
#pragma unroll
    for (int i = 0; i < 2; ++i) { int R, C; stage_rc(tid * 16 + i * 8192, R, C); const int Rb = (R & ~31) + perm32(R & 31);
        voffA[i] = (unsigned)(R * lda + C) * 2u; voffB[i] = (unsigned)(Rb * ldb + C) * 2u; }
    const size_t kstep = (size_t)(BK * 2);
    const size_t hsA = (size_t)HALF * lda * 2, hsB = (size_t)HALF * ldb * 2;
    const unsigned ldsw = (unsigned)wid * 1024u;
    const int aoff = lds_byte(wr * 64 + fr, fq * 8), boff = lds_byte(wc * 32 + fr, fq * 8);
#define PG8_SA(b, h) (((b) * 2 + (h)) * HTB)
#define PG8_SB(b, h) ((4 + (b) * 2 + (h)) * HTB)
#define PG8_STAGE(bufoff, gbase, voff) do { _Pragma("unroll") for (int _i = 0; _i < 2; ++_i) \
        __builtin_amdgcn_global_load_lds((const unsigned*)((const char*)(gbase) + (voff)[_i]), (LAS unsigned*)(lds + (bufoff) + ldsw + _i * 8192), 16, 0, 0); } while (0)
#define PG8_LDA(dst, b, h) do { _Pragma("unroll") for (int m = 0; m < 4; ++m) { const u32x4 _l = *(const LAS u32x4*)(lds + PG8_SA(b, h) + aoff + m * 2048), _h = *(const LAS u32x4*)(lds + PG8_SA(b, h) + aoff + m * 2048 + 1024); \
        dst[m] = (i32x8){(int)_l[0], (int)_l[1], (int)_l[2], (int)_l[3], (int)_h[0], (int)_h[1], (int)_h[2], (int)_h[3]}; } } while (0)
#define PG8_LDB(dst, b, h) do { _Pragma("unroll") for (int n = 0; n < 2; ++n) { const u32x4 _l = *(const LAS u32x4*)(lds + PG8_SB(b, h) + boff + n * 2048), _h = *(const LAS u32x4*)(lds + PG8_SB(b, h) + boff + n * 2048 + 1024); \
        dst[n] = (i32x8){(int)_l[0], (int)_l[1], (int)_l[2], (int)_l[3], (int)_h[0], (int)_h[1], (int)_h[2], (int)_h[3]}; } } while (0)
#define PG8_LO(v) __builtin_bit_cast(bf16x8, (u32x4){(unsigned)(v)[0], (unsigned)(v)[1], (unsigned)(v)[2], (unsigned)(v)[3]})
#define PG8_HI(v) __builtin_bit_cast(bf16x8, (u32x4){(unsigned)(v)[4], (unsigned)(v)[5], (unsigned)(v)[6], (unsigned)(v)[7]})
#define PG8_MMA(ai, bj, At, Bt) do { __builtin_amdgcn_s_setprio(1); \
        if constexpr (FP8) { _Pragma("unroll") for (int m = 0; m < 4; ++m) _Pragma("unroll") for (int n = 0; n < 2; ++n) \
            asm volatile("v_mfma_scale_f32_16x16x128_f8f6f4 %0, %1, %2, %0, %3, %3 op_sel_hi:[0,0,0]" : "+v"(acc[ai][bj][m][n]) : "v"(Bt[n]), "v"(At[m]), "v"(mxscale)); } \
        else { _Pragma("unroll") for (int m = 0; m < 4; ++m) _Pragma("unroll") for (int n = 0; n < 2; ++n) { \
            acc[ai][bj][m][n] = __builtin_amdgcn_mfma_f32_16x16x32_bf16(PG8_LO(Bt[n]), PG8_LO(At[m]), acc[ai][bj][m][n], 0, 0, 0); \
            acc[ai][bj][m][n] = __builtin_amdgcn_mfma_f32_16x16x32_bf16(PG8_HI(Bt[n]), PG8_HI(At[m]), acc[ai][bj][m][n], 0, 0, 0); } } \
        __builtin_amdgcn_s_setprio(0); } while (0)
#define PG8_WAIT_V(n) asm volatile("s_waitcnt vmcnt(" #n ")" ::: "memory")
#define PG8_WAIT_L(n) asm volatile("s_waitcnt lgkmcnt(" #n ")" ::: "memory")
#define PG8_BAR __builtin_amdgcn_s_barrier()
#define PG8_SCHED __builtin_amdgcn_sched_barrier(0)
    Unit cur, nxt; int ui = 0; bool prestaged = false;
    if (!S.next(0, cur)) return;
    f32x4 acc[2][2][4][2];
#pragma unroll
    for (int a = 0; a < 2; ++a)
#pragma unroll
        for (int b = 0; b < 2; ++b)
#pragma unroll
            for (int m = 0; m < 4; ++m)
#pragma unroll
                for (int n = 0; n < 2; ++n) acc[a][b][m][n] = (f32x4){0.f, 0.f, 0.f, 0.f};
    i32x8 At[4], B0[2], B1[2];
    int mxscale = 0x7F7F7F7F; asm volatile("" : "+v"(mxscale));
    const char* cA = cur.A; const char* cB = cur.B;
    PG8_STAGE(PG8_SB(0, 0), cB, voffB); PG8_STAGE(PG8_SA(0, 0), cA, voffA); PG8_STAGE(PG8_SB(0, 1), cB + hsB, voffB); PG8_STAGE(PG8_SA(0, 1), cA + hsA, voffA);
    if (wr == 1) PG8_BAR;
    PG8_WAIT_V(4); PG8_BAR;
    PG8_STAGE(PG8_SB(1, 0), cB + kstep, voffB); PG8_STAGE(PG8_SA(1, 0), cA + kstep, voffA); PG8_STAGE(PG8_SB(1, 1), cB + hsB + kstep, voffB);
    PG8_WAIT_V(6); PG8_BAR;
    for (;;) {
        const bool has_next = S.next(ui + 1, nxt);
        const char* nA = has_next ? nxt.A : cA; const char* nB = has_next ? nxt.B : cB;
#pragma unroll 1
        for (int t = 0; t < nt; t += 2) {
            const bool last = (t == nt - 2);
            const char* a1 = cA + (size_t)(t + 1) * kstep;
            const char* a2 = last ? nA : cA + (size_t)(t + 2) * kstep; const char* b2 = last ? nB : cB + (size_t)(t + 2) * kstep;
            const char* a3 = a2 + kstep; const char* b3 = b2 + kstep;
            PG8_LDB(B0, 0, 0); PG8_SCHED; PG8_LDA(At, 0, 0); if (!(prestaged && t == 0)) PG8_STAGE(PG8_SA(1, 1), a1 + hsA, voffA);
            PG8_WAIT_L(8); PG8_BAR; PG8_WAIT_L(0); PG8_MMA(0, 0, At, B0); PG8_BAR; PG8_SCHED;
            PG8_LDB(B1, 0, 1); PG8_STAGE(PG8_SB(0, 0), b2, voffB);
            PG8_BAR; PG8_WAIT_L(0); PG8_MMA(0, 1, At, B1); PG8_BAR;
            PG8_LDA(At, 0, 1); PG8_STAGE(PG8_SA(0, 0), a2, voffA);
            PG8_BAR; PG8_WAIT_L(0); PG8_MMA(1, 0, At, B0); PG8_BAR; PG8_SCHED;
            PG8_STAGE(PG8_SB(0, 1), b2 + hsB, voffB);
            if (prestaged && t == 0) { PG8_WAIT_V(63); } else { PG8_WAIT_V(6); }
            PG8_BAR; PG8_MMA(1, 1, At, B1); PG8_BAR;
            PG8_LDB(B0, 1, 0); PG8_SCHED; PG8_LDA(At, 1, 0); PG8_STAGE(PG8_SA(0, 1), a2 + hsA, voffA);
            PG8_WAIT_L(8); PG8_BAR; PG8_WAIT_L(0); PG8_MMA(0, 0, At, B0); PG8_BAR; PG8_SCHED;
            PG8_LDB(B1, 1, 1); PG8_STAGE(PG8_SB(1, 0), b3, voffB);
            PG8_BAR; PG8_WAIT_L(0); PG8_MMA(0, 1, At, B1); PG8_BAR;
            PG8_LDA(At, 1, 1); PG8_STAGE(PG8_SA(1, 0), a3, voffA);
            PG8_BAR; PG8_WAIT_L(0); PG8_MMA(1, 0, At, B0); PG8_BAR; PG8_SCHED;
            PG8_STAGE(PG8_SB(1, 1), b3 + hsB, voffB);
            PG8_WAIT_V(6); PG8_BAR; PG8_MMA(1, 1, At, B1); PG8_BAR;
        }
        if constexpr (FP8) asm volatile("s_nop 15\n\ts_nop 15" ::: "memory");
        prestaged = false;
        if (Epi::WAITS_ON_READS && !NOEPI && has_next) {
            PG8_STAGE(PG8_SA(1, 1), nA + kstep + hsA, voffA); asm volatile("" ::: "memory"); PG8_SCHED; prestaged = true; }
        if constexpr (!NOEPI) E(acc, cur, wr, wc, fr, fq);
        if (!has_next) break;
        if (nxt.flags & UF_ZERO) {
#pragma unroll
            for (int a = 0; a < 2; ++a)
#pragma unroll
                for (int b = 0; b < 2; ++b)
#pragma unroll
                    for (int m = 0; m < 4; ++m)
#pragma unroll
                        for (int n = 0; n < 2; ++n) acc[a][b][m][n] = (f32x4){0.f, 0.f, 0.f, 0.f};
        }
        cur = nxt; cA = nA; cB = nB; ++ui;
    }
    PG8_WAIT_V(0);
    if (wr == 0) PG8_BAR;
    PG8_BAR;
#undef PG8_SA
#undef PG8_SB
#undef PG8_STAGE
#undef PG8_LDA
#undef PG8_LDB
#undef PG8_MMA
#undef PG8_LO
#undef PG8_HI
#undef PG8_WAIT_V
#undef PG8_WAIT_L
#undef PG8_BAR
#undef PG8_SCHED
}
}
using pg8::Unit;

#ifndef WGM_G1
#define WGM_G1 4
#define WGM_SQ 4
#endif
#ifndef WGM_P6
#define WGM_P6 WGM_SQ
#endif
#ifndef WGM_P7
#define WGM_P7 WGM_SQ
#endif
#ifndef WGM_P8
#define WGM_P8 WGM_SQ
#endif
struct SchedGemm1 {
    const char* A; const char* B; int G, c;
    __device__ __forceinline__ bool next(int i, Unit& u) const { int pm, pn; if (!pg8::static_tile(i * G + c, 64, 39, pm, pn, WGM_G1)) return false;
        u.A = A + (size_t)pm * 256 * 2048; u.B = B + (size_t)pn * 256 * 2048; u.pm = pm; u.pn = pn; u.flags = pg8::UF_ZERO | pg8::UF_FINAL; u.aux = 0; return true; }
};
struct SchedSquare {
    const char* A; const char* B; int G, c; int rb;
    __device__ __forceinline__ bool next(int i, Unit& u) const { int pm, pn; if (!pg8::static_tile(i * G + c, 64, 8, pm, pn, rb == 2048 ? WGM_P7 : WGM_P8)) return false;
        u.A = A + (size_t)pm * 256 * rb; u.B = B + (size_t)pn * 256 * rb; u.pm = pm; u.pn = pn; u.flags = pg8::UF_ZERO | pg8::UF_FINAL; u.aux = 0; return true; }
};
struct SchedMerge {
    const char* A; const char* B; int G, c;
    __device__ __forceinline__ bool next(int i, Unit& u) const { int pm, pn; if (!pg8::static_tile((i >> 1) * G + c, 64, 8, pm, pn, WGM_P6)) return false; const int w = i & 1;
        u.A = A + (size_t)pm * 256 * 2048 + (size_t)w * 1024; u.B = B + (size_t)pn * 256 * 2048 + (size_t)w * 1024; u.pm = pm; u.pn = pn; u.flags = w ? pg8::UF_FINAL : pg8::UF_ZERO; u.aux = w; return true; }
};
struct SchedCompress {
    const char* Ak; const char* Av; const char* B; int G, c;
    __device__ __forceinline__ bool next(int i, Unit& u) const { const int L = i * G + c; if (L >= 128) return false; const int which = L >> 6, mt = (L >> 3) & 7, ks = L & 7;
        u.A = (which ? Av : Ak) + (size_t)mt * 256 * 2048 * 2 + (size_t)ks * 512 * 2; u.B = B + (size_t)which * 256 * 4096 * 2 + (size_t)ks * 512 * 2; u.pm = mt; u.pn = 0; u.flags = pg8::UF_ZERO | pg8::UF_FINAL; u.aux = which * 8 + ks; return true; }
};

#define EPI_LOOP_AI_M for (int ai = 0; ai < 2; ++ai) for (int m = 0; m < 4; ++m)
struct EpiGemm1 {
    static constexpr bool WAITS_ON_READS = true;
    int st; unsigned char* ws; float* gate_out  ; const float* nsa_gb; const float* fox_fb; const float* merge_gb;
    __device__ __forceinline__ void operator()(f32x4 (&acc)[2][2][4][2], const Unit& u, int wr, int wc, int fr, int fq) const {
        const float* ssq1 = (const float*)(ws + OFF_MISC + M_SSQ1);
        const int pn = u.pn;
        const int p0 = wc * 32 + fq * 8;
        const int rbase = u.pm * 256 + wr * 64 + fr;
        float rsv[2][4];
#pragma unroll
        for (int ai = 0; ai < 2; ++ai)
#pragma unroll
            for (int m = 0; m < 4; ++m) rsv[ai][m] = __builtin_amdgcn_rsqf(ssq1[rbase + ai * 128 + m * 16] * (1.0f / 2048.0f) + NORM_EPS) * (1.0f / (SC_X * SC_WIN));
        asm volatile("" :: "v"(rsv[0][0]));
        if (pn < 10) {
            const bool rope = pn < 4 || pn == 6 || pn == 8;
            const f32x2* cs = (const f32x2*)(ws + OFF_MISC + M_ROPE) + 4 * (p0 >> 3);
            bf16_t* dbase = pn < 4 ? (bf16_t*)(ws + OFF_QN) + (size_t)(pn * 2) * 2048 * 128 + p0 : (bf16_t*)(ws + OFF_KV6) + (size_t)(pn - 4) * (16 * 2048 * 128) + p0;
            const int hmul = pn < 4 ? 8 : 2;
            f32x4 cc[2][4][2];
#pragma unroll
            for (int ai = 0; ai < 2; ++ai)
#pragma unroll
                for (int m = 0; m < 4; ++m) { const int s = (rbase + ai * 128 + m * 16) & 2047;
                    cc[ai][m][0] = *(const f32x4*)(cs + s * 64); cc[ai][m][1] = *(const f32x4*)(cs + s * 64 + 2); }
#pragma unroll
            for (int ai = 0; ai < 2; ++ai)
#pragma unroll
                for (int m = 0; m < 4; ++m) {
                    const int r = rbase + ai * 128 + m * 16, b = r >> 11, s = r & 2047; const float rs = rsv[ai][m];
                    const f32x4 c01 = cc[ai][m][0], c23 = cc[ai][m][1];
                    const f32x4 co = rope ? (f32x4){c01[0], c01[2], c23[0], c23[2]} : (f32x4){1.f, 1.f, 1.f, 1.f}, si = rope ? (f32x4){c01[1], c01[3], c23[1], c23[3]} : (f32x4){0.f, 0.f, 0.f, 0.f};
#pragma unroll
                    for (int bj = 0; bj < 2; ++bj) {
                        const f32x4 x1 = acc[ai][bj][m][0] * rs, x2 = acc[ai][bj][m][1] * rs;
                        const f32x4 y1 = x1 * co - x2 * si, y2 = x2 * co + x1 * si;
                        u32x4 w; w.x = cvtpk(y1[0], y1[1]); w.y = cvtpk(y1[2], y1[3]); w.z = cvtpk(y2[0], y2[1]); w.w = cvtpk(y2[2], y2[3]);
                        if (st) *(u32x4*)(dbase + ((size_t)(b * hmul + bj) * 2048 + s) * 128) = w;
                    }
                }
        } else if (pn < 22) {
            const int idx = (pn - 10) >> 2, hb = ((pn - 10) & 3) * 2;
            bf16_t* dbase = (bf16_t*)(ws + OFF_QKVF) + (size_t)idx * (64 * 2048 * 128) + (size_t)hb * 2048 * 128 + p0;
#pragma unroll
            for (int ai = 0; ai < 2; ++ai)
#pragma unroll
                for (int m = 0; m < 4; ++m) {
                    const int r = rbase + ai * 128 + m * 16, b = r >> 11, s = r & 2047; const float rs = rsv[ai][m];
#pragma unroll
                    for (int bj = 0; bj < 2; ++bj) {
                        const f32x4 x1 = acc[ai][bj][m][0] * rs, x2 = acc[ai][bj][m][1] * rs;
                        u32x4 w; w.x = cvtpk(x1[0], x1[1]); w.y = cvtpk(x1[2], x1[3]); w.z = cvtpk(x2[0], x2[1]); w.w = cvtpk(x2[2], x2[3]);
                        if (st) *(u32x4*)(dbase + ((size_t)(b * 8 + bj) * 2048 + s) * 128) = w;
                    }
                }
        } else if (pn < 38) {
            const int col = (pn - 22) * 128 + p0;
            const f32x4 ba0 = *(const f32x4*)(merge_gb + col), ba1 = *(const f32x4*)(merge_gb + col + 4), bb0 = *(const f32x4*)(merge_gb + 2048 + col), bb1 = *(const f32x4*)(merge_gb + 2048 + col + 4);
            unsigned char* g0 = (unsigned char*)gate_out + col;
#pragma unroll
            for (int ai = 0; ai < 2; ++ai)
#pragma unroll
                for (int m = 0; m < 4; ++m) {
                    const int r = rbase + ai * 128 + m * 16; const float rs = rsv[ai][m];
                    float ra[8], gb[8];
#pragma unroll
                    for (int i = 0; i < 4; ++i) {
                        const float za0 = __builtin_amdgcn_fmed3f(acc[ai][0][m][0][i] * rs + ba0[i], -40.f, 40.f), zb0 = __builtin_amdgcn_fmed3f(acc[ai][1][m][0][i] * rs + bb0[i], -40.f, 40.f);
                        const float za1 = __builtin_amdgcn_fmed3f(acc[ai][0][m][1][i] * rs + ba1[i], -40.f, 40.f), zb1 = __builtin_amdgcn_fmed3f(acc[ai][1][m][1][i] * rs + bb1[i], -40.f, 40.f);
                        const float ta0 = 1.0f + __builtin_amdgcn_exp2f(-LOG2E * za0), tb0 = 1.0f + __builtin_amdgcn_exp2f(-LOG2E * zb0), ta1 = 1.0f + __builtin_amdgcn_exp2f(-LOG2E * za1), tb1 = 1.0f + __builtin_amdgcn_exp2f(-LOG2E * zb1);
                        const float q0 = __builtin_amdgcn_rcpf(ta0 * tb0), q1 = __builtin_amdgcn_rcpf(ta1 * tb1);
                        ra[i] = tb0 * tb0 * q0; gb[i] = ta0 * q0; ra[4 + i] = tb1 * tb1 * q1; gb[4 + i] = ta1 * q1; }
                    const u32x2 w = {pack_fp8x4(ra[0], ra[1], ra[2], ra[3]), pack_fp8x4(ra[4], ra[5], ra[6], ra[7])};
                    const u32x2 y = {pack_fp8x4(gb[0] * 256.f, gb[1] * 256.f, gb[2] * 256.f, gb[3] * 256.f), pack_fp8x4(gb[4] * 256.f, gb[5] * 256.f, gb[6] * 256.f, gb[7] * 256.f)};
                    if (st) { *(u32x2*)(g0 + (size_t)r * 2048) = w; *(u32x2*)(g0 + (size_t)T_TOK * 2048 + (size_t)r * 2048) = y; }
                }
        } else if (wc == 0) {
            float* gn = (float*)(ws + OFF_MISC + M_GN); float* lf = (float*)(ws + OFF_MISC + M_LOGF);
            float bias[8];
#pragma unroll
            for (int i = 0; i < 8; ++i) { const int col = fq * 8 + i; bias[i] = col < 24 ? nsa_gb[col] : fox_fb[col - 24]; }
#pragma unroll
            for (int ai = 0; ai < 2; ++ai)
#pragma unroll
                for (int m = 0; m < 4; ++m) {
                    const int r = rbase + ai * 128 + m * 16; const float rs = rsv[ai][m];
#pragma unroll
                    for (int n = 0; n < 2; ++n)
#pragma unroll
                        for (int i = 0; i < 4; ++i) { const float z = acc[ai][0][m][n][i] * rs + bias[n * 4 + i];
                            const float em = __builtin_amdgcn_exp2f(-LOG2E * fabsf(z)), t = 1.0f + em;
                            const float sg = (z >= 0.f ? 1.0f : em) * __builtin_amdgcn_rcpf(t), ls = fminf(z, 0.f) - 0.6931471805599453f * __builtin_amdgcn_logf(t);
                            if (fq < 3) gn[(size_t)r * 24 + fq * 8 + n * 4 + i] = sg;
                            else lf[(size_t)r * 8 + n * 4 + i] = ls; }
                }
        }
    }
};
struct EpiSlab {
    static constexpr bool WAITS_ON_READS = false;
    float* slab;
    __device__ __forceinline__ void operator()(f32x4 (&acc)[2][2][4][2], const Unit& u, int wr, int wc, int fr, int fq) const {
        float* base = slab + (size_t)u.aux * 2048 * 256;
#pragma unroll
        for (int ai = 0; ai < 2; ++ai)
#pragma unroll
            for (int m = 0; m < 4; ++m) { const int r = u.pm * 256 + ai * 128 + wr * 64 + m * 16 + fr;
#pragma unroll
                for (int bj = 0; bj < 2; ++bj) { float* d = base + (size_t)r * 256 + bj * 128 + wc * 32 + fq * 8; *(f32x4*)d = acc[ai][bj][m][0]; *(f32x4*)(d + 4) = acc[ai][bj][m][1]; } }
    }
};
__device__ __forceinline__ u32x4 ldg16(const void* base, unsigned off) { return *(const u32x4*)((const char*)base + off); }
__device__ __forceinline__ f32x4 ldg16f(const void* base, unsigned off) { return *(const f32x4*)((const char*)base + off); }
struct EpiMerge {
    static constexpr bool WAITS_ON_READS = true;
    const unsigned char* gate_r; const unsigned char* gate_b; unsigned char* merged;
    __device__ __forceinline__ void operator()(f32x4 (&acc)[2][2][4][2], const Unit& u, int wr, int wc, int fr, int fq) const {
        const unsigned char* g = u.aux ? gate_b : gate_r;
        const unsigned r0 = (unsigned)(u.pm * 256 + wr * 64 + fr), c0 = (unsigned)(u.pn * 256 + wc * 32 + fq * 8);
        const unsigned o8 = r0 * 2048u + c0;
        u32x2 gv[2][4][2];
#pragma unroll
        for (int ai = 0; ai < 2; ++ai)
#pragma unroll
            for (int m = 0; m < 4; ++m)
#pragma unroll
                for (int bj = 0; bj < 2; ++bj) gv[ai][m][bj] = *(const u32x2*)(g + (o8 + (unsigned)((ai * 128 + m * 16) * 2048 + bj * 128)));
        if (u.aux) {
            const float fs = SC_M / (SC_O * SC_WUP * 256.0f);
#pragma unroll
            for (int ai = 0; ai < 2; ++ai)
#pragma unroll
                for (int m = 0; m < 4; ++m)
#pragma unroll
                    for (int bj = 0; bj < 2; ++bj) { u32x2 v = gv[ai][m][bj]; asm volatile("" : "+v"(v));
                        const f32x2 g0 = __builtin_amdgcn_cvt_pk_f32_fp8((int)v.x, false), g1 = __builtin_amdgcn_cvt_pk_f32_fp8((int)v.x, true), g2 = __builtin_amdgcn_cvt_pk_f32_fp8((int)v.y, false), g3 = __builtin_amdgcn_cvt_pk_f32_fp8((int)v.y, true);
                        const f32x4 a0 = acc[ai][bj][m][0] * fs, a1 = acc[ai][bj][m][1] * fs;
                        *(u32x2*)(merged + (o8 + (unsigned)((ai * 128 + m * 16) * 2048 + bj * 128))) = (u32x2){pack_fp8x4(a0[0] * g0[0], a0[1] * g0[1], a0[2] * g1[0], a0[3] * g1[1]), pack_fp8x4(a1[0] * g2[0], a1[1] * g2[1], a1[2] * g3[0], a1[3] * g3[1])}; }
        } else {
#pragma unroll
            for (int ai = 0; ai < 2; ++ai)
#pragma unroll
                for (int m = 0; m < 4; ++m)
#pragma unroll
                    for (int bj = 0; bj < 2; ++bj) { u32x2 v = gv[ai][m][bj]; asm volatile("" : "+v"(v));
                        const f32x2 g0 = __builtin_amdgcn_cvt_pk_f32_fp8((int)v.x, false), g1 = __builtin_amdgcn_cvt_pk_f32_fp8((int)v.x, true), g2 = __builtin_amdgcn_cvt_pk_f32_fp8((int)v.y, false), g3 = __builtin_amdgcn_cvt_pk_f32_fp8((int)v.y, true);
                        acc[ai][bj][m][0] *= (f32x4){g0[0], g0[1], g1[0], g1[1]}; acc[ai][bj][m][1] *= (f32x4){g2[0], g2[1], g3[0], g3[1]}; }
        }
    }
};
struct EpiOut {
    static constexpr bool WAITS_ON_READS = true;
    const float* x; float* x1; bf16_t* x1b; float* ssq2;
    __device__ __forceinline__ void operator()(f32x4 (&acc)[2][2][4][2], const Unit& u, int wr, int wc, int fr, int fq) const {
        const unsigned r0 = (unsigned)(u.pm * 256 + wr * 64 + fr), c0 = (unsigned)(u.pn * 256 + wc * 32 + fq * 8);
        const unsigned ox = r0 * 8192u + c0 * 4u, ob = r0 * 4096u + c0 * 2u, os = (r0 * 64u + (unsigned)(u.pn * 8 + wc)) * 4u;
#pragma unroll
        for (int ai = 0; ai < 2; ++ai) {
            f32x4 xv[4][2][2];
#pragma unroll
            for (int m = 0; m < 4; ++m)
#pragma unroll
                for (int bj = 0; bj < 2; ++bj) { const unsigned o = ox + (unsigned)((ai * 128 + m * 16) * 8192 + bj * 512); xv[m][bj][0] = ldg16f(x, o); xv[m][bj][1] = ldg16f(x, o + 16u); }
#pragma unroll
            for (int m = 0; m < 4; ++m) {
#pragma unroll
                for (int bj = 0; bj < 2; ++bj) {
                    const f32x4 v0 = xv[m][bj][0] + acc[ai][bj][m][0] * (1.0f / (SC_M * SC_WOUT)), v1 = xv[m][bj][1] + acc[ai][bj][m][1] * (1.0f / (SC_M * SC_WOUT));
                    u32x4 w; w.x = cvtpk(v0[0], v0[1]); w.y = cvtpk(v0[2], v0[3]); w.z = cvtpk(v1[0], v1[1]); w.w = cvtpk(v1[2], v1[3]);
                    *(u32x4*)((char*)x1b + (ob + (unsigned)((ai * 128 + m * 16) * 4096 + bj * 256))) = w;
                    float s = v0[0] * v0[0] + v0[1] * v0[1] + v0[2] * v0[2] + v0[3] * v0[3] + v1[0] * v1[0] + v1[1] * v1[1] + v1[2] * v1[2] + v1[3] * v1[3];
                    s = swap32_sum(swap16_sum(s));
                    if (fq == 0) *(float*)((char*)ssq2 + (os + (unsigned)((ai * 128 + m * 16) * 256 + bj * 16))) = s; } }
        }
    }
};
struct EpiPeerQ {
    static constexpr bool WAITS_ON_READS = true;
    const float* ssq2; bf16_t* qp;
    __device__ __forceinline__ void operator()(f32x4 (&acc)[2][2][4][2], const Unit& u, int wr, int wc, int fr, int fq) const {
        const unsigned r0 = (unsigned)(u.pm * 256 + wr * 64 + fr), c0 = (unsigned)(u.pn * 256 + wc * 32 + fq * 8);
        const unsigned os = r0 * 256u + (unsigned)fq * 64u, ob = r0 * 4096u + c0 * 2u;
#pragma unroll
        for (int ai = 0; ai < 2; ++ai) {
            f32x4 t4[4][4];
#pragma unroll
            for (int m = 0; m < 4; ++m)
#pragma unroll
                for (int k = 0; k < 4; ++k) t4[m][k] = ldg16f(ssq2, os + (unsigned)((ai * 128 + m * 16) * 256 + k * 16));
#pragma unroll
            for (int m = 0; m < 4; ++m) {
                const f32x4 t = t4[m][0] + t4[m][1] + t4[m][2] + t4[m][3];
                float s = t[0] + t[1] + t[2] + t[3]; s = swap32_sum(swap16_sum(s));
                const float rs = __builtin_amdgcn_rsqf(s * (1.0f / 2048.0f) + NORM_EPS);
#pragma unroll
                for (int bj = 0; bj < 2; ++bj) { const f32x4 a0 = acc[ai][bj][m][0] * rs, a1 = acc[ai][bj][m][1] * rs;
                    u32x4 w; w.x = cvtpk(a0[0], a0[1]); w.y = cvtpk(a0[2], a0[3]); w.z = cvtpk(a1[0], a1[1]); w.w = cvtpk(a1[2], a1[3]);
                    *(u32x4*)((char*)qp + (ob + (unsigned)((ai * 128 + m * 16) * 4096 + bj * 256))) = w; } }
        }
    }
};
constexpr int SHM_K = 64 * 128 * 2, SHM_V = 64 * 128 * 2;
#define KSWZ(row, colB) ((row) * 256 + ((colB) ^ (((row) & 7) << 4)))
#define SBAR() __builtin_amdgcn_sched_barrier(0)
__device__ __forceinline__ int v_st(int k, int c) { const int kk = (k & ~0xC) | ((k & 4) << 1) | ((k & 8) >> 1); return ((kk >> 3) * 4 + (c >> 5)) * 512 + ((kk & 7) * 32 + (c & 31)) * 2; }
__device__ __forceinline__ int v_rd_base(int lane) { return ((lane & 3) << 3) | (((lane >> 2) & 3) << 6) | (((lane >> 4) & 1) << 5) | (((lane >> 5) & 1) << 8); }
constexpr int v_rd_off(int d0, int ks, int half) { return d0 * 512 + ks * 4096 + half * 2048; }
__device__ __forceinline__ int crow(int r, int hi) { return (r & 3) + 8 * (r >> 2) + 4 * hi; }

__device__ __forceinline__ void qkt(f32x16& p0, f32x16& p1, const char* Kt, int r32, int hi, const bf16x8* qr) {
    p0 = f32x16{}; p1 = f32x16{};
    const char* kb[4];
#pragma unroll
    for (int dd = 0; dd < 4; ++dd) kb[dd] = Kt + KSWZ(r32, (dd * 16 + hi * 8) * 2);
#pragma unroll
    for (int d0 = 0; d0 < 8; ++d0) { const char* a = kb[d0 & 3] + (d0 >> 2) * 128;
        const bf16x8 b0 = *reinterpret_cast<const bf16x8*>(a);
        const bf16x8 b1 = *reinterpret_cast<const bf16x8*>(a + 32 * 256);
        p0 = __builtin_amdgcn_mfma_f32_32x32x16_bf16(b0, qr[d0], p0, 0, 0, 0);
        p1 = __builtin_amdgcn_mfma_f32_32x32x16_bf16(b1, qr[d0], p1, 0, 0, 0); }
}
__device__ __forceinline__ void pv_tile(f32x16* o, int vb0, bf16x8 pa0, bf16x8 pa1, bf16x8 pa2, bf16x8 pa3) {
#define TRRD(dst, off) asm volatile("ds_read_b64_tr_b16 %0, %1 offset:%2" : "=&v"(dst) : "v"(vb0), "i"(off) : "memory")
#define PV_D0(d0) do { s16x4 l0, l1, l2, l3, h0, h1, h2, h3; constexpr int b_ = v_rd_off(d0, 0, 0); \
        TRRD(l0, b_); TRRD(h0, b_ + 2048); TRRD(l1, b_ + 4096); TRRD(h1, b_ + 6144); TRRD(l2, b_ + 8192); TRRD(h2, b_ + 10240); TRRD(l3, b_ + 12288); TRRD(h3, b_ + 14336); \
        asm volatile("s_waitcnt lgkmcnt(0)" ::: "memory"); SBAR(); \
        o[d0] = __builtin_amdgcn_mfma_f32_32x32x16_bf16(pa0, (bf16x8){l0[0], l0[1], l0[2], l0[3], h0[0], h0[1], h0[2], h0[3]}, o[d0], 0, 0, 0); \
        o[d0] = __builtin_amdgcn_mfma_f32_32x32x16_bf16(pa1, (bf16x8){l1[0], l1[1], l1[2], l1[3], h1[0], h1[1], h1[2], h1[3]}, o[d0], 0, 0, 0); \
        o[d0] = __builtin_amdgcn_mfma_f32_32x32x16_bf16(pa2, (bf16x8){l2[0], l2[1], l2[2], l2[3], h2[0], h2[1], h2[2], h2[3]}, o[d0], 0, 0, 0); \
        o[d0] = __builtin_amdgcn_mfma_f32_32x32x16_bf16(pa3, (bf16x8){l3[0], l3[1], l3[2], l3[3], h3[0], h3[1], h3[2], h3[3]}, o[d0], 0, 0, 0); } while (0)
    PV_D0(0); PV_D0(1); PV_D0(2); PV_D0(3);
#undef PV_D0
#undef TRRD
}
__device__ __forceinline__ void pack_p(const f32x16& p0, const f32x16& p1, bf16x8& pa0, bf16x8& pa1, bf16x8& pa2, bf16x8& pa3) {
#define PK4(P, B_, OUT) do { unsigned a0 = cvtpk(P[B_+0], P[B_+1]), a1 = cvtpk(P[B_+2], P[B_+3]); unsigned b0 = cvtpk(P[B_+4], P[B_+5]), b1 = cvtpk(P[B_+6], P[B_+7]); \
        auto r0 = __builtin_amdgcn_permlane32_swap(a0, b0, false, false); auto r1 = __builtin_amdgcn_permlane32_swap(a1, b1, false, false); \
        u32x4 w = {r0[0], r1[0], r0[1], r1[1]}; OUT = *reinterpret_cast<bf16x8*>(&w); } while (0)
    PK4(p0, 0, pa0); PK4(p0, 8, pa1); PK4(p1, 0, pa2); PK4(p1, 8, pa3);
#undef PK4
}
__device__ __forceinline__ float pair_max(float v) { auto rr = __builtin_amdgcn_permlane32_swap(__float_as_uint(v), __float_as_uint(v), false, false); return fmaxf(__uint_as_float(rr[0]), __uint_as_float(rr[1])); }
__device__ __forceinline__ float pair_sum(float v) { auto rr = __builtin_amdgcn_permlane32_swap(__float_as_uint(v), __float_as_uint(v), false, false); return __uint_as_float(rr[0]) + __uint_as_float(rr[1]); }

struct Stage { bf16x8 k0, k1, v0, v1; };
__device__ __forceinline__ void stage_load(Stage& s, const bf16_t* Kg, const bf16_t* Vg, int tid) {
    const int sr = tid >> 4, sc = (tid & 15) * 8;
    s.k0 = *(const bf16x8*)(Kg + (size_t)sr * 128 + sc); s.k1 = *(const bf16x8*)(Kg + (size_t)(32 + sr) * 128 + sc);
    s.v0 = *(const bf16x8*)(Vg + (size_t)sr * 128 + sc); s.v1 = *(const bf16x8*)(Vg + (size_t)(32 + sr) * 128 + sc);
}
__device__ __forceinline__ void stage_write(const Stage& s, char* Kt, char* Vt, int tid) {
    const int sr = tid >> 4, sc = (tid & 15) * 8, kws = KSWZ(sr, sc * 2);
    *(bf16x8*)(Kt + kws) = s.k0; *(bf16x8*)(Kt + kws + 32 * 256) = s.k1;
    *(bf16x8*)(Vt + v_st(sr, sc)) = s.v0; *(bf16x8*)(Vt + v_st(32 + sr, sc)) = s.v1;
}

constexpr int ATT_LDS_WS = 2 * SHM_V + 2 * SHM_K;
constexpr int ATT_LDS_X = ATT_LDS_WS + 8 * 64 * 4;

__device__ __forceinline__ void stage_glds(const bf16_t* Kg, const bf16_t* Vg, char* Kt, char* Vt, int tid, int wid) {
#pragma unroll
    for (int i = 0; i < 2; ++i) {
        const int L = i * 512 + tid;
        const int krow = L >> 4, kch = (L & 15) ^ (krow & 7);
        __builtin_amdgcn_global_load_lds((const unsigned*)(Kg + krow * 128 + kch * 8), (LAS unsigned*)(Kt + (i * 512 + wid * 64) * 16), 16, 0, 0);
        const int sub = L >> 5, within = L & 31, kk = (sub >> 2) * 8 + (within >> 2), c = (sub & 3) * 32 + (within & 3) * 8;
        const int k = (kk & ~0xC) | ((kk & 4) << 1) | ((kk & 8) >> 1);
        __builtin_amdgcn_global_load_lds((const unsigned*)(Vg + k * 128 + c), (LAS unsigned*)(Vt + (i * 512 + wid * 64) * 16), 16, 0, 0);
    }
}

__device__ __forceinline__ void stage_glds_one(const bf16_t* G, char* T, int tid, int wid, bool isK) {
#pragma unroll
    for (int i = 0; i < 2; ++i) {
        const int L = i * 512 + tid;
        if (isK) { const int krow = L >> 4, kch = (L & 15) ^ (krow & 7);
            __builtin_amdgcn_global_load_lds((const unsigned*)(G + krow * 128 + kch * 8), (LAS unsigned*)(T + (i * 512 + wid * 64) * 16), 16, 0, 0); }
        else { const int sub = L >> 5, within = L & 31, kk = (sub >> 2) * 8 + (within >> 2), c = (sub & 3) * 32 + (within & 3) * 8; const int k = (kk & ~0xC) | ((kk & 4) << 1) | ((kk & 8) >> 1);
            __builtin_amdgcn_global_load_lds((const unsigned*)(G + k * 128 + c), (LAS unsigned*)(T + (i * 512 + wid * 64) * 16), 16, 0, 0); }
    }
}

template <int MODE>
__device__ __forceinline__ void attn_pass(const bf16_t* Kg, const bf16_t* Vg, int j_lo, int j_hi, const bf16x8* qr, f32x16* o, float& l_reg,
                                          char* lds, int tpos  , unsigned selm, const float* kbias_lds) {
    int tid = threadIdx.x; asm volatile("" : "+v"(tid));
    const int wid = __builtin_amdgcn_readfirstlane(tid >> 6), lane = tid & 63, r32 = lane & 31, hi = lane >> 5;
    char* V_lds = lds; char* K_lds = lds + 2 * SHM_V;
    float* wsf = (float*)(lds + ATT_LDS_WS) + wid * 64;
    constexpr float C2 = LOG2E * ATT_SCALE;
    float m_reg = -1e30f; l_reg = 0.f;
#pragma unroll
    for (int d = 0; d < 4; ++d) o[d] = f32x16{};
    const int vbase = (int)(uintptr_t)V_lds + v_rd_base(lane);
    const int NT = j_hi - j_lo;
    const int wq_lo = __builtin_amdgcn_readfirstlane(tpos - r32);
#define ATT_ACT(j_) (MODE == 2 ? ((j_) * 64 <= wq_lo + 31) : (MODE == 1 ? (((j_) * 64 <= wq_lo + 31) && ((j_) * 64 + 63 >= wq_lo - 511)) : true))
    __syncthreads();
    {
        const bf16_t* K0 = Kg + (size_t)j_lo * 64 * 128; const bf16_t* V0 = Vg + (size_t)j_lo * 64 * 128;
        stage_glds(K0, V0, K_lds, V_lds, tid, wid);
        if (NT > 1) stage_glds_one(K0 + 64 * 128, K_lds + SHM_K, tid, wid, true);
    }
    asm volatile("s_waitcnt vmcnt(0)" ::: "memory");
    __syncthreads();
    f32x16 pc0, pc1;
    if (ATT_ACT(j_lo)) qkt(pc0, pc1, K_lds, r32, hi, qr);
    __syncthreads();
#pragma unroll 1
    for (int t = 0; t < NT; ++t) {
        const int j = j_lo + t, kb = j * 64;
        if (t + 2 < NT) stage_glds_one(Kg + (size_t)(j + 2) * 64 * 128, K_lds + (t & 1) * SHM_K, tid, wid, true);
        if (t + 1 < NT) stage_glds_one(Vg + (size_t)(j + 1) * 64 * 128, V_lds + ((t + 1) & 1) * SHM_V, tid, wid, false);
        f32x16 pn0, pn1;
        const bool needm_c = MODE == 1 ? (kb + 63 > wq_lo || kb <= wq_lo + 31 - 512) : (kb + 63 > wq_lo);
        const bool fused = (t + 1 < NT) && ATT_ACT(j + 1) && ATT_ACT(j) && !needm_c;
        if (!fused && t + 1 < NT && ATT_ACT(j + 1)) qkt(pn0, pn1, K_lds + ((t + 1) & 1) * SHM_K, r32, hi, qr);
        if (ATT_ACT(j)) {
            f32x16 p0 = pc0, p1 = pc1;
            const float NEG = -__builtin_inff();
            const int dq = tpos - kb - 4 * hi;
            const bool needm = needm_c;
            float mn, alpha, ps = 0.f;
            if (fused) {
                const char* Kn = K_lds + ((t + 1) & 1) * SHM_K;
                const char* kbp_[4];
#pragma unroll
                for (int dd = 0; dd < 4; ++dd) kbp_[dd] = Kn + KSWZ(r32, (dd * 16 + hi * 8) * 2);
                pn0 = f32x16{}; pn1 = f32x16{};
#define ATT_QK2(D0) do { _Pragma("unroll") for (int d0 = (D0); d0 < (D0) + 2; ++d0) { const char* a_ = kbp_[d0 & 3] + (d0 >> 2) * 128; \
                    const bf16x8 b0_ = *reinterpret_cast<const bf16x8*>(a_); const bf16x8 b1_ = *reinterpret_cast<const bf16x8*>(a_ + 32 * 256); \
                    pn0 = __builtin_amdgcn_mfma_f32_32x32x16_bf16(b0_, qr[d0], pn0, 0, 0, 0); pn1 = __builtin_amdgcn_mfma_f32_32x32x16_bf16(b1_, qr[d0], pn1, 0, 0, 0); } } while (0)
                const float lanebias = (MODE == 0 && !((selm >> j) & 1u)) ? NEG : 0.f;
                float pmax;
                ATT_QK2(0);
                if (MODE == 2) { const float* kbq = kbias_lds + kb + 4 * hi;
#pragma unroll
                    for (int g = 0; g < 4; ++g) { const f32x4 b0 = *(const f32x4*)(kbq + 8 * g), b1 = *(const f32x4*)(kbq + 32 + 8 * g);
#pragma unroll
                        for (int i = 0; i < 4; ++i) { p0[4 * g + i] = fmaf(p0[4 * g + i], C2, b0[i]); p1[4 * g + i] = fmaf(p1[4 * g + i], C2, b1[i]); } } }
                pmax = p0[0];
#pragma unroll
                for (int r = 1; r < 16; ++r) pmax = fmaxf(pmax, p0[r]);
                SBAR();
                ATT_QK2(2);
#pragma unroll
                for (int r = 0; r < 16; ++r) pmax = fmaxf(pmax, p1[r]);
                pmax = pair_max(pmax);
                if (MODE != 2) pmax = pmax * C2 + lanebias;
                mn = fmaxf(m_reg, pmax); alpha = __builtin_amdgcn_exp2f(m_reg - mn); m_reg = mn;
                const float nb = lanebias - mn;
                SBAR();
                ATT_QK2(4);
#pragma unroll
                for (int r = 0; r < 16; ++r) { p0[r] = MODE == 2 ? __builtin_amdgcn_exp2f(p0[r] - mn) : __builtin_amdgcn_exp2f(fmaf(p0[r], C2, nb)); ps += p0[r]; }
                SBAR();
                ATT_QK2(6);
#pragma unroll
                for (int r = 0; r < 16; ++r) { p1[r] = MODE == 2 ? __builtin_amdgcn_exp2f(p1[r] - mn) : __builtin_amdgcn_exp2f(fmaf(p1[r], C2, nb)); ps += p1[r]; }
                SBAR();
#undef ATT_QK2
            } else if (MODE != 2 && !needm) {
                const float lanebias = (MODE == 0 && !((selm >> j) & 1u)) ? NEG : 0.f;
                float pmax = p0[0];
#pragma unroll
                for (int r = 1; r < 16; ++r) pmax = fmaxf(pmax, p0[r]);
#pragma unroll
                for (int r = 0; r < 16; ++r) pmax = fmaxf(pmax, p1[r]);
                pmax = pair_max(pmax) * C2 + lanebias;
                mn = fmaxf(m_reg, pmax); alpha = __builtin_amdgcn_exp2f(m_reg - mn); m_reg = mn;
                const float nb = lanebias - mn;
#pragma unroll
                for (int r = 0; r < 16; ++r) { p0[r] = __builtin_amdgcn_exp2f(fmaf(p0[r], C2, nb)); p1[r] = __builtin_amdgcn_exp2f(fmaf(p1[r], C2, nb)); ps += p0[r] + p1[r]; }
            } else {
                if (MODE == 2) {
                    const float* kbp = kbias_lds + kb + 4 * hi;
#pragma unroll
                    for (int g = 0; g < 4; ++g) { const f32x4 b0 = *(const f32x4*)(kbp + 8 * g), b1 = *(const f32x4*)(kbp + 32 + 8 * g);
#pragma unroll
                        for (int i = 0; i < 4; ++i) { p0[4 * g + i] = fmaf(p0[4 * g + i], C2, b0[i]); p1[4 * g + i] = fmaf(p1[4 * g + i], C2, b1[i]); } }
                } else {
#pragma unroll
                    for (int r = 0; r < 16; ++r) { p0[r] *= C2; p1[r] *= C2; }
                }
                if (needm) {
                    const bool sel = MODE == 0 ? ((selm >> j) & 1u) != 0u : true;
                    const unsigned W = MODE == 1 ? 512u : 0x7fffffffu;
#pragma unroll
                    for (int r = 0; r < 16; ++r) { const int c = (r & 3) + 8 * (r >> 2); if (!sel || (unsigned)(dq - c) >= W) p0[r] = NEG; if (!sel || (unsigned)(dq - c - 32) >= W) p1[r] = NEG; }
                }
                float pmax = p0[0];
#pragma unroll
                for (int r = 1; r < 16; ++r) pmax = fmaxf(pmax, p0[r]);
#pragma unroll
                for (int r = 0; r < 16; ++r) pmax = fmaxf(pmax, p1[r]);
                pmax = pair_max(pmax);
                mn = fmaxf(m_reg, pmax); alpha = __builtin_amdgcn_exp2f(m_reg - mn); m_reg = mn;
#pragma unroll
                for (int r = 0; r < 16; ++r) { p0[r] = __builtin_amdgcn_exp2f(p0[r] - mn); p1[r] = __builtin_amdgcn_exp2f(p1[r] - mn); ps += p0[r] + p1[r]; }
            }
            ps = pair_sum(ps);
            l_reg = l_reg * alpha + ps;
            if (__any(alpha < 1.f)) {
                if (hi == 0) wsf[r32] = alpha;
                asm volatile("s_waitcnt lgkmcnt(0)" ::: "memory");
#pragma unroll
                for (int r = 0; r < 16; ++r) { const float a = wsf[crow(r, hi)];
#pragma unroll
                    for (int d = 0; d < 4; ++d) o[d][r] *= a; }
            }
            bf16x8 pa0, pa1, pa2, pa3;
            pack_p(p0, p1, pa0, pa1, pa2, pa3);
            pv_tile(o, vbase + (t & 1) * SHM_V, pa0, pa1, pa2, pa3);
        }
        pc0 = pn0; pc1 = pn1;
        asm volatile("s_waitcnt vmcnt(0)" ::: "memory");
        __syncthreads();
    }
#undef ATT_ACT
}

template <bool ADD, bool OUT8>
__device__ __forceinline__ void store_o(const f32x16* o, float fac, void* basev, size_t row_stride  , const bf16_t* addend, size_t add_stride, char* lds, int wid, int lane) {
    asm volatile("" : "+v"(lane));
    const int r32 = lane & 31, hi = lane >> 5;
    float* wsf = (float*)(lds + ATT_LDS_WS) + wid * 64;
    char* ot = lds + wid * 8192;
    __builtin_amdgcn_wave_barrier();
    if (hi == 0) wsf[r32] = fac;
    asm volatile("s_waitcnt lgkmcnt(0)" ::: "memory");
    __builtin_amdgcn_wave_barrier();
#pragma unroll
    for (int r = 0; r < 16; ++r) { const int orow = crow(r, hi); const float f = wsf[orow];
#pragma unroll
        for (int d0 = 0; d0 < 4; ++d0) *(bf16_t*)(ot + orow * 256 + (d0 * 32 + r32) * 2) = (bf16_t)(cvtpk(o[d0][r] * f, 0.f) & 0xffffu); }
    asm volatile("s_waitcnt lgkmcnt(0)" ::: "memory");
    __builtin_amdgcn_wave_barrier();
    if constexpr (OUT8) {
        unsigned char* base = (unsigned char*)basev;
        const int rr = lane >> 3, ch = lane & 7;
        u32x4 ad[4][2];
        if (ADD) {
#pragma unroll
            for (int i = 0; i < 4; ++i) { const bf16_t* ap = addend + (size_t)(i * 8 + rr) * add_stride + ch * 16; ad[i][0] = *(const u32x4*)ap; ad[i][1] = *(const u32x4*)(ap + 8); } }
#pragma unroll
        for (int i = 0; i < 4; ++i) {
            const u32x4 v0 = *(const u32x4*)(ot + (i * 8 + rr) * 256 + ch * 32), v1 = *(const u32x4*)(ot + (i * 8 + rr) * 256 + ch * 32 + 16);
            float f[16];
#pragma unroll
            for (int q = 0; q < 4; ++q) { f[2 * q] = bf_lo(v0[q]); f[2 * q + 1] = bf_hi(v0[q]); f[8 + 2 * q] = bf_lo(v1[q]); f[8 + 2 * q + 1] = bf_hi(v1[q]); }
            if (ADD) { const u32x4 a0 = ad[i][0], a1 = ad[i][1];
#pragma unroll
                for (int q = 0; q < 4; ++q) { f[2 * q] += bf_lo(a0[q]); f[2 * q + 1] += bf_hi(a0[q]); f[8 + 2 * q] += bf_lo(a1[q]); f[8 + 2 * q + 1] += bf_hi(a1[q]); } }
            u32x4 w;
#pragma unroll
            for (int q = 0; q < 4; ++q) w[q] = pack_fp8x4(f[4 * q] * SC_O, f[4 * q + 1] * SC_O, f[4 * q + 2] * SC_O, f[4 * q + 3] * SC_O);
            *(u32x4*)(base + (size_t)(i * 8 + rr) * row_stride + ch * 16) = w; }
    } else {
        bf16_t* base = (bf16_t*)basev;
        const int rr = lane >> 4, ch = lane & 15;
        bf16_t* gp = base + (size_t)rr * row_stride + ch * 8;
        const bf16_t* ap = ADD ? addend + (size_t)rr * add_stride + ch * 8 : nullptr;
        u32x4 ad[8];
        if (ADD) {
#pragma unroll
            for (int i = 0; i < 8; ++i) ad[i] = *(const u32x4*)(ap + (size_t)(i * 4) * add_stride); }
#pragma unroll
        for (int i = 0; i < 8; ++i) {
            u32x4 v = *(const u32x4*)(ot + (i * 4 + rr) * 256 + ch * 16);
            if (ADD) { const u32x4 a = ad[i];
                v.x = cvtpk(bf_lo(v.x) + bf_lo(a.x), bf_hi(v.x) + bf_hi(a.x)); v.y = cvtpk(bf_lo(v.y) + bf_lo(a.y), bf_hi(v.y) + bf_hi(a.y));
                v.z = cvtpk(bf_lo(v.z) + bf_lo(a.z), bf_hi(v.z) + bf_hi(a.z)); v.w = cvtpk(bf_lo(v.w) + bf_lo(a.w), bf_hi(v.w) + bf_hi(a.w)); }
            *(u32x4*)(gp + (size_t)(i * 4) * row_stride) = v; }
    }
    __builtin_amdgcn_wave_barrier();
}

__device__ __forceinline__ void fox_cumsum(const Params& p, int first_block) {
    const int tid = tid_opaque(), wid = tid >> 6, lane = tid & 63;
    {
        const int which = (int)blockIdx.x - first_block - 8;
        if ((which == 0 || which == 1) && tid < 256) { const float* b1p = (const float*)(p.ws + OFF_MISC + M_B1P); float t = 0.f;
            for (int part = 0; part < 64; ++part) t += b1p[(which * 64 + part) * 256 + tid];
            ((float*)(p.ws + OFF_MISC + M_B1))[which * 256 + tid] = t; }
    }
    const int seq = ((int)blockIdx.x - first_block) * 8 + wid;
    if (seq < 0 || seq >= 64) return;
    const int b = seq >> 3, h = seq & 7;
    const float* lf = (const float*)(p.ws + OFF_MISC + M_LOGF); float* cf = (float*)(p.ws + OFF_MISC + M_CFOX);
    float v[32]; float run = 0.f;
#pragma unroll
    for (int i = 0; i < 32; ++i) { run += lf[(size_t)(b * 2048 + lane * 32 + i) * 8 + h]; v[i] = run; }
    float incl = run;
#pragma unroll
    for (int o = 1; o < 64; o <<= 1) { const float t = __shfl_up(incl, o); if (lane >= o) incl += t; }
    const float excl = incl - run;
#pragma unroll
    for (int i = 0; i < 32; ++i) cf[(size_t)(b * 8 + h) * 2048 + lane * 32 + i] = -(v[i] + excl) * LOG2E;
}

__device__ __forceinline__ void phase_cmp2(const Params& p, unsigned char* lds_raw) {
    const int tid = tid_opaque(), wid = tid >> 6, lane = tid & 63;
    float* hbuf = (float*)lds_raw + wid * 512;
    const float* slab = (const float*)(p.ws + OFF_XB); const float* b1p = (const float*)(p.ws + OFF_MISC + M_B1);
    const f32x2* cs = (const f32x2*)(p.ws + OFF_MISC + M_ROPE);
    bf16_t* kcvc = (bf16_t*)(p.ws + OFF_KCVC);
    for (int job = blockIdx.x * 8 + wid; job < 2048; job += gridDim.x * 8) {
        const int which = job >> 10, m0 = (job & 1023) * 2;
        f32x4 acc[2] = {{0.f, 0.f, 0.f, 0.f}, {0.f, 0.f, 0.f, 0.f}};
#pragma unroll
        for (int rr = 0; rr < 2; ++rr)
#pragma unroll
            for (int s = 0; s < 8; ++s) acc[rr] += *(const f32x4*)(slab + ((size_t)(which * 8 + s) * 2048 + m0 + rr) * 256 + lane * 4);
        const f32x4 bb = *(const f32x4*)(b1p + which * 256 + lane * 4);
        __builtin_amdgcn_wave_barrier();
#pragma unroll
        for (int rr = 0; rr < 2; ++rr) { const f32x4 a = acc[rr] + bb; *(f32x4*)(hbuf + rr * 256 + lane * 4) = (f32x4){gelu_tanh(a[0]), gelu_tanh(a[1]), gelu_tanh(a[2]), gelu_tanh(a[3])}; }
        asm volatile("s_waitcnt lgkmcnt(0)" ::: "memory");
        __builtin_amdgcn_wave_barrier();
        const float* w2 = p.in[which ? 11 : 8];
        float o1[2] = {0.f, 0.f}, o2[2] = {0.f, 0.f};
#pragma unroll 1
        for (int j0 = 0; j0 < 256; j0 += 32) {
            float wa[32], wb[32];
#pragma unroll
            for (int j = 0; j < 32; ++j) { wa[j] = w2[(j0 + j) * 128 + lane]; wb[j] = w2[(j0 + j) * 128 + 64 + lane]; }
#pragma unroll
            for (int j = 0; j < 32; ++j) { const float h0 = hbuf[j0 + j], h1 = hbuf[256 + j0 + j]; o1[0] = fmaf(h0, wa[j], o1[0]); o2[0] = fmaf(h0, wb[j], o2[0]); o1[1] = fmaf(h1, wa[j], o1[1]); o2[1] = fmaf(h1, wb[j], o2[1]); }
        }
#pragma unroll
        for (int rr = 0; rr < 2; ++rr) {
            const int m = m0 + rr, i = m & 127;
            bf16_t* dst = kcvc + (size_t)which * (2048 * 128) + (size_t)m * 128;
            if (i == 127) { *(unsigned*)(dst + lane * 2) = 0u; continue; }
            if (which == 0) {
                const f32x2 c = cs[(16 * i + 31) * 64 + lane]; const float y1 = o1[rr] * c[0] - o2[rr] * c[1], y2 = o2[rr] * c[0] + o1[rr] * c[1];
                const int q = lane >> 2, e = lane & 3;
                dst[8 * q + e] = (bf16_t)(cvtpk(y1, 0.f) & 0xffffu); dst[8 * q + 4 + e] = (bf16_t)(cvtpk(y2, 0.f) & 0xffffu);
            } else { dst[lane] = (bf16_t)(cvtpk(o1[rr], 0.f) & 0xffffu); dst[64 + lane] = (bf16_t)(cvtpk(o2[rr], 0.f) & 0xffffu); }
        }
        __builtin_amdgcn_wave_barrier();
    }
}
__device__ __forceinline__ void phase_cmp_attn(const Params& p, unsigned char* lds_raw) {
    char* lds = (char*)lds_raw;
    const int tid = tid_opaque(), wid = __builtin_amdgcn_readfirstlane(tid >> 6), lane = tid & 63, r32 = lane & 31, hi = lane >> 5;
    char* V_lds = lds; char* K_lds = lds + 2 * SHM_V;
    float* wsf = (float*)(lds + ATT_LDS_WS) + wid * 64;
    float* imp = (float*)(lds + ATT_LDS_X);
    const bf16_t* QN = (const bf16_t*)(p.ws + OFF_QN); const bf16_t* kcvc = (const bf16_t*)(p.ws + OFF_KCVC);
    const float* gn = (const float*)(p.ws + OFF_MISC + M_GN);
    bf16_t* ocg = (bf16_t*)(p.ws + OFF_WINT); unsigned* selmask = (unsigned*)(p.ws + OFF_SEL);
    constexpr float C2 = LOG2E * ATT_SCALE;
    const int vbase = (int)(uintptr_t)V_lds + v_rd_base(lane);
    for (int item = blockIdx.x; item < 512; item += gridDim.x) {
        const int bg = item >> 5, c = item & 31, b = bg >> 1, g = bg & 1;
        const int hg = wid >> 1, head = g * 4 + hg, tpos = c * 64 + (wid & 1) * 32 + r32, tok = b * 2048 + tpos;
        __syncthreads();
        { Stage st; const bf16_t* Kg = kcvc + (size_t)bg * 128 * 128; const bf16_t* Vg = kcvc + (size_t)(2048 * 128) + (size_t)bg * 128 * 128;
          stage_load(st, Kg, Vg, tid); stage_write(st, K_lds, V_lds, tid);
          stage_load(st, Kg + 64 * 128, Vg + 64 * 128, tid); stage_write(st, K_lds + SHM_K, V_lds + SHM_V, tid); }
        bf16x8 qr[8];
        { const bf16_t* qp = QN + ((size_t)(b * 8 + head) * 2048 + tpos) * 128 + hi * 8;
#pragma unroll
          for (int d0 = 0; d0 < 8; ++d0) qr[d0] = *(const bf16x8*)(qp + d0 * 16); }
        __syncthreads();
        f32x16 pA0, pA1, pB0, pB1;
        qkt(pA0, pA1, K_lds, r32, hi, qr);
        qkt(pB0, pB1, K_lds + SHM_K, r32, hi, qr);
        const int nvis = tpos >= 15 ? (tpos - 15) >> 4 : 0;
        const float NEG = -__builtin_inff();
        float mx = -1e30f;
#pragma unroll
        for (int r = 0; r < 16; ++r) { const int n = crow(r, hi);
            pA0[r] = n < nvis ? pA0[r] * C2 : NEG; pA1[r] = n + 32 < nvis ? pA1[r] * C2 : NEG; pB0[r] = n + 64 < nvis ? pB0[r] * C2 : NEG; pB1[r] = n + 96 < nvis ? pB1[r] * C2 : NEG;
            mx = fmaxf(fmaxf(mx, pA0[r]), fmaxf(pA1[r], fmaxf(pB0[r], pB1[r]))); }
        mx = pair_max(mx);
        float ps = 0.f;
#pragma unroll
        for (int r = 0; r < 16; ++r) { pA0[r] = __builtin_amdgcn_exp2f(pA0[r] - mx); pA1[r] = __builtin_amdgcn_exp2f(pA1[r] - mx); pB0[r] = __builtin_amdgcn_exp2f(pB0[r] - mx); pB1[r] = __builtin_amdgcn_exp2f(pB1[r] - mx);
            ps += (pA0[r] + pA1[r]) + (pB0[r] + pB1[r]); }
        ps = pair_sum(ps);
        const float rl = 1.0f / fmaxf(ps, 1e-30f);
        {
            float gs[16], lastv[16];
#pragma unroll
            for (int q = 0; q < 4; ++q) {
                gs[q] = (pA0[4 * q] + pA0[4 * q + 1]) + (pA0[4 * q + 2] + pA0[4 * q + 3]); lastv[q] = pA0[4 * q + 3];
                gs[4 + q] = (pA1[4 * q] + pA1[4 * q + 1]) + (pA1[4 * q + 2] + pA1[4 * q + 3]); lastv[4 + q] = pA1[4 * q + 3];
                gs[8 + q] = (pB0[4 * q] + pB0[4 * q + 1]) + (pB0[4 * q + 2] + pB0[4 * q + 3]); lastv[8 + q] = pB0[4 * q + 3];
                gs[12 + q] = (pB1[4 * q] + pB1[4 * q + 1]) + (pB1[4 * q + 2] + pB1[4 * q + 3]); lastv[12 + q] = pB1[4 * q + 3]; }
            float* myimp = imp + ((size_t)hg * 64 + (wid & 1) * 32 + r32) * 33;
#pragma unroll
            for (int idx = 0; idx < 16; ++idx) {
                const float other = xor32(lastv[idx], hi);
                const float other_prev = idx > 0 ? xor32(lastv[idx > 0 ? idx - 1 : 0], hi) : 0.f;
                const float prev = hi ? other : other_prev;
                myimp[2 * idx + hi] = (gs[idx] + prev) * rl;
            }
        }
        f32x16 o[4];
#pragma unroll
        for (int d = 0; d < 4; ++d) o[d] = f32x16{};
        { bf16x8 pa0, pa1, pa2, pa3; pack_p(pA0, pA1, pa0, pa1, pa2, pa3); pv_tile(o, vbase, pa0, pa1, pa2, pa3);
          pack_p(pB0, pB1, pa0, pa1, pa2, pa3); pv_tile(o, vbase + SHM_V, pa0, pa1, pa2, pa3); }
        const float gate = gn[(size_t)tok * 24 + head * 3 + 0];
        __syncthreads();
        store_o<false, false>(o, gate * rl, ocg + ((size_t)(b * 2048 + c * 64 + (wid & 1) * 32)) * 1024 + head * 128, 1024, nullptr, 0, lds, wid, lane);
        __syncthreads();
        if (tid < 64) {
            const int t = c * 64 + tid; float sc[32];
#pragma unroll
            for (int j = 0; j < 32; ++j) { const float v = ((imp[(0 * 64 + tid) * 33 + j] + imp[(1 * 64 + tid) * 33 + j]) + imp[(2 * 64 + tid) * 33 + j]) + imp[(3 * 64 + tid) * 33 + j];
                const bool forced = j == 0 || j == c || j == c - 1; const float x = j > c ? -1e30f : (forced ? 1e4f : v);
                sc[j] = __uint_as_float((__float_as_uint(x) & ~31u) | (unsigned)(x >= 0.f ? 31 - j : j)); }
            bitonic_sort_desc<32>(sc);
            unsigned mask = 0u;
#pragma unroll
            for (int k = 0; k < 16; ++k) { const unsigned u = __float_as_uint(sc[k]); const unsigned low = u & 31u; const int j = (int)((u >> 31) ? low : 31u - low); if (j <= c) mask |= 1u << j; }
            selmask[(size_t)bg * 2048 + t] = mask;
        }
    }
}

__device__ __forceinline__ void phase_attn(const Params& p, unsigned char* lds_raw) {
    char* lds = (char*)lds_raw;
    int* slot = (int*)(lds + ATT_LDS_X);
    unsigned* qctr = (unsigned*)(p.ws + OFF_MISC + M_CTL);
    const bf16_t* QN = (const bf16_t*)(p.ws + OFF_QN); const bf16_t* KV6 = (const bf16_t*)(p.ws + OFF_KV6); const bf16_t* QKVF = (const bf16_t*)(p.ws + OFF_QKVF);
    const float* gn = (const float*)(p.ws + OFF_MISC + M_GN); const float* cf = (const float*)(p.ws + OFF_MISC + M_CFOX);
    const unsigned* selmask = (const unsigned*)(p.ws + OFF_SEL);
    const bf16_t* ocg = (const bf16_t*)(p.ws + OFF_WINT); unsigned char* ocat = p.ws + OFF_XB  ; bf16_t* otmp = (bf16_t*)(p.ws + OFF_XB + 32 * MiB)  ;
    for (;;) {
        int tid = threadIdx.x; asm volatile("" : "+v"(tid));
        const int wid = __builtin_amdgcn_readfirstlane(tid >> 6), lane = tid & 63, r32 = lane & 31, hi = lane >> 5;
        __syncthreads();
        if (tid == 0) slot[0] = (int)atomicAdd(qctr, 1u);
        __syncthreads();
        const int it = slot[0];
        if (it >= 1024) break;
        f32x16 o[4]; float l_reg; bf16x8 qr[8];
        if (it < 512) {
            const int cb = 7 - (it >> 6), bh = it & 63, b = bh >> 3, h = bh & 7;
            const int tpos = cb * 256 + wid * 32 + r32;
            { const bf16_t* qp = QKVF + ((size_t)bh * 2048 + tpos) * 128 + hi * 8;
#pragma unroll
              for (int d0 = 0; d0 < 8; ++d0) qr[d0] = *(const bf16x8*)(qp + d0 * 16); }
            const bf16_t* Kg = QKVF + (size_t)(64 * 2048 * 128) + (size_t)bh * 2048 * 128; const bf16_t* Vg = QKVF + (size_t)2 * (64 * 2048 * 128) + (size_t)bh * 2048 * 128;
            float* kb_lds = (float*)(lds + ATT_LDS_X + 64);
            __syncthreads();
            *(f32x4*)(kb_lds + tid * 4) = *(const f32x4*)(cf + (size_t)bh * 2048 + tid * 4);
            attn_pass<2>(Kg, Vg, 0, cb * 4 + 4, qr, o, l_reg, lds, tpos, 0u, kb_lds);
            store_o<false, true>(o, 1.0f / l_reg, ocat + ((size_t)(b * 2048 + cb * 256 + wid * 32)) * 2048 + 1024 + h * 128, 2048, nullptr, 0, lds, wid, lane);
        } else {
            const int k = it - 512, c = 31 - (k >> 4), bg = k & 15, b = bg >> 1, g = bg & 1;
            const int hg = wid >> 1, head = g * 4 + hg, tpos = c * 64 + (wid & 1) * 32 + r32, tok = b * 2048 + tpos;
            { const bf16_t* qp = QN + ((size_t)(b * 8 + head) * 2048 + tpos) * 128 + hi * 8;
#pragma unroll
              for (int d0 = 0; d0 < 8; ++d0) qr[d0] = *(const bf16x8*)(qp + d0 * 16); }
            const unsigned selm = selmask[(size_t)bg * 2048 + tpos];
            const size_t kvh = (size_t)bg * 2048 * 128, kvs = (size_t)16 * 2048 * 128;
            unsigned char* orow = ocat + ((size_t)(b * 2048 + c * 64 + (wid & 1) * 32)) * 2048 + head * 128;
            bf16_t* trow = otmp + ((size_t)(b * 2048 + c * 64 + (wid & 1) * 32)) * 1024 + head * 128;
            attn_pass<0>(KV6 + 2 * kvs + kvh, KV6 + 3 * kvs + kvh, 0, c + 1, qr, o, l_reg, lds, tpos, selm, nullptr);
            store_o<true, false>(o, gn[(size_t)tok * 24 + head * 3 + 1] / l_reg, trow, 1024, ocg + ((size_t)(b * 2048 + c * 64 + (wid & 1) * 32)) * 1024 + head * 128, 1024, lds, wid, lane);
            attn_pass<1>(KV6 + 4 * kvs + kvh, KV6 + 5 * kvs + kvh, c >= 8 ? c - 8 : 0, c + 1, qr, o, l_reg, lds, tpos, 0u, nullptr);
            store_o<true, true>(o, gn[(size_t)tok * 24 + head * 3 + 2] / l_reg, orow, 2048, trow, 1024, lds, wid, lane);
        }
    }
}
__device__ __forceinline__ float pack_idx(float v, unsigned idx, unsigned mask) { return __uint_as_float((__float_as_uint(v) & ~mask) | idx); }
__device__ __forceinline__ void top16_of_tile(const f32x16& p0, const f32x16& p1, int hi, unsigned nbase, float (&res)[16]) {
    float g1[16];
#pragma unroll
    for (int r = 0; r < 16; ++r) { const unsigned n = nbase + (unsigned)crow(r, hi); res[r] = pack_idx(p0[r], n, 127u); g1[r] = pack_idx(p1[r], n + 32u, 127u); }
    bitonic_sort_desc<16>(res); bitonic_sort_desc<16>(g1);
    merge_top16(res, g1);
}
__device__ __forceinline__ void top16_of_128(const char* Kt, int r32, int hi, const bf16x8* qr, float (&res)[16]) {
    float t2[16];
    { f32x16 p0, p1; qkt(p0, p1, Kt, r32, hi, qr); top16_of_tile(p0, p1, hi, 0u, res); }
    SBAR();
    { f32x16 p0, p1; qkt(p0, p1, Kt + SHM_K, r32, hi, qr); top16_of_tile(p0, p1, hi, 64u, t2); }
    merge_top16(res, t2);
#pragma unroll
    for (int i = 0; i < 16; ++i) t2[i] = xor32(res[i], hi);
    merge_top16(res, t2);
    SBAR();
}
__device__ __forceinline__ float sel16(const float (&v)[16], int k) {
    float r = v[0];
#pragma unroll
    for (int i = 1; i < 16; ++i) r = (k == i) ? v[i] : r;
    return r;
}
__device__ __forceinline__ void phase_peer_topk(const Params& p, unsigned char* lds_raw) {
    char* lds = (char*)lds_raw;
    const int tid = tid_opaque(), wid = __builtin_amdgcn_readfirstlane(tid >> 6), lane = tid & 63, r32 = lane & 31, hi = lane >> 5;
    const bf16_t* K12 = (const bf16_t*)(p.ws + OFF_MISC + M_K12); const bf16_t* QP = (const bf16_t*)(p.ws + OFF_QKVF);
    int* eidx = (int*)(p.ws + OFF_EIDX); float* gsm = (float*)(p.ws + OFF_GSM);
    for (int item = blockIdx.x; item < 512; item += gridDim.x) {
        const int h = item & 7, tt = item >> 3;
        __syncthreads();
        {
            const int sr = tid >> 4, sc = (tid & 15) * 8, kws = KSWZ(sr, sc * 2);
#pragma unroll
            for (int q = 0; q < 4; ++q) { const bf16_t* src = K12 + (size_t)(q >> 1) * 131072 + (size_t)h * 16384 + (size_t)(q & 1) * 64 * 128;
                const bf16x8 a = *(const bf16x8*)(src + (size_t)sr * 128 + sc), b = *(const bf16x8*)(src + (size_t)(32 + sr) * 128 + sc);
                *(bf16x8*)(lds + q * SHM_K + kws) = a; *(bf16x8*)(lds + q * SHM_K + kws + 32 * 256) = b; }
        }
        const int tok = tt * 256 + wid * 32 + r32;
        bf16x8 qr[8];
        { const bf16_t* qp = QP + (size_t)tok * 2048 + h * 256 + hi * 8;
#pragma unroll
          for (int d0 = 0; d0 < 8; ++d0) qr[d0] = *(const bf16x8*)(qp + d0 * 16); }
        __syncthreads();
        float v1[16], v2[16];
        top16_of_128(lds, r32, hi, qr, v1);
        { const bf16_t* qp = QP + (size_t)tok * 2048 + h * 256 + 128 + hi * 8;
#pragma unroll
          for (int d0 = 0; d0 < 8; ++d0) qr[d0] = *(const bf16x8*)(qp + d0 * 16); }
        top16_of_128(lds + 2 * SHM_K, r32, hi, qr, v2);
        float s1[16], s2[16];
#pragma unroll
        for (int i = 0; i < 16; ++i) { s1[i] = __uint_as_float(__float_as_uint(v1[i]) & ~127u); s2[i] = __uint_as_float(__float_as_uint(v2[i]) & ~127u); }
        float cd[32];
        const float NEGC = -3e38f;
#pragma unroll
        for (int i = 0; i < 32; ++i) cd[i] = NEGC;
#define CAND(slot, a, b) cd[slot] = pack_idx(s1[a] + s2[b], (unsigned)((a) * 16 + (b)), 255u)
        if (hi == 0) {
#pragma unroll
            for (int b = 0; b < 16; ++b) CAND(b, 0, b);
#pragma unroll
            for (int b = 0; b < 5; ++b) CAND(16 + b, 2, b);
#pragma unroll
            for (int a = 8; a < 16; ++a) CAND(13 + a, a, 0);
        } else {
#pragma unroll
            for (int b = 0; b < 8; ++b) CAND(b, 1, b);
#pragma unroll
            for (int b = 0; b < 4; ++b) CAND(8 + b, 3, b);
#pragma unroll
            for (int b = 0; b < 3; ++b) CAND(12 + b, 4, b);
#pragma unroll
            for (int a = 5; a < 8; ++a) { CAND(15 + 2 * (a - 5), a, 0); CAND(16 + 2 * (a - 5), a, 1); }
        }
#undef CAND
        bitonic_sort_desc<32>(cd);
        float top[16], oth[16];
#pragma unroll
        for (int i = 0; i < 16; ++i) top[i] = cd[i];
#pragma unroll
        for (int i = 0; i < 16; ++i) oth[i] = xor32(top[i], hi);
        merge_top16(top, oth);
        float* scr = (float*)(lds + 4 * SHM_K);
#pragma unroll
        for (int i = 0; i < 16; ++i) { scr[i * 512 + tid] = v1[i]; scr[(16 + i) * 512 + tid] = v2[i]; }
        float ev[16]; int ei[16]; float esum = 0.f;
#pragma unroll
        for (int k = 0; k < 16; ++k) { const int code = (int)(__float_as_uint(top[k]) & 255u); const int a = code >> 4, b = code & 15;
            const float w1 = scr[a * 512 + tid], w2 = scr[(16 + b) * 512 + tid];
            ev[k] = __uint_as_float(__float_as_uint(w1) & ~127u) + __uint_as_float(__float_as_uint(w2) & ~127u);
            ei[k] = (int)((__float_as_uint(w1) & 127u) * 128u + (__float_as_uint(w2) & 127u)); }
        float emax = ev[0];
#pragma unroll
        for (int k = 1; k < 16; ++k) emax = fmaxf(emax, ev[k]);
#pragma unroll
        for (int k = 0; k < 16; ++k) { ev[k] = __expf(ev[k] - emax); esum += ev[k]; }
        const float inv = 1.0f / esum;
        int* ep = eidx + (size_t)tok * 128 + h * 16; float* gp = gsm + (size_t)tok * 128 + h * 16;
        if (hi == 0) {
            *(int4*)ep = make_int4(ei[0], ei[1], ei[2], ei[3]); *(int4*)(ep + 4) = make_int4(ei[4], ei[5], ei[6], ei[7]);
            *(f32x4*)gp = (f32x4){ev[0] * inv, ev[1] * inv, ev[2] * inv, ev[3] * inv}; *(f32x4*)(gp + 4) = (f32x4){ev[4] * inv, ev[5] * inv, ev[6] * inv, ev[7] * inv};
        } else {
            *(int4*)(ep + 8) = make_int4(ei[8], ei[9], ei[10], ei[11]); *(int4*)(ep + 12) = make_int4(ei[12], ei[13], ei[14], ei[15]);
            *(f32x4*)(gp + 8) = (f32x4){ev[8] * inv, ev[9] * inv, ev[10] * inv, ev[11] * inv}; *(f32x4*)(gp + 12) = (f32x4){ev[12] * inv, ev[13] * inv, ev[14] * inv, ev[15] * inv};
        }
    }
}

__device__ __forceinline__ void cvt16(const u32x4 w, f32x2 (&f)[8]) {
#pragma unroll
    for (int q = 0; q < 4; ++q) { f[2 * q] = __builtin_amdgcn_cvt_pk_f32_fp8((int)w[q], false); f[2 * q + 1] = __builtin_amdgcn_cvt_pk_f32_fp8((int)w[q], true); }
}
typedef short s16x2v __attribute__((ext_vector_type(2)));
#define EXP_DOT(S) do { \
        int A0 = __builtin_amdgcn_sdot8((int)w[0], xa[S][0], 0, true), B0 = __builtin_amdgcn_sdot8((int)w[0], xb[S][0], 0, true); \
        A0 = __builtin_amdgcn_sdot8((int)w[1], xa[S][1], A0, false); B0 = __builtin_amdgcn_sdot8((int)w[1], xb[S][1], B0, false); \
        int A1 = __builtin_amdgcn_sdot8((int)w[2], xa[S][2], 0, true), B1 = __builtin_amdgcn_sdot8((int)w[2], xb[S][2], 0, true); \
        A1 = __builtin_amdgcn_sdot8((int)w[3], xa[S][3], A1, false); B1 = __builtin_amdgcn_sdot8((int)w[3], xb[S][3], B1, false); \
        dsum = (float)((A0 << 4) + B0) * (float)(rbw & 255u) + (float)((A1 << 4) + B1) * (float)(rbw >> 8); } while (0)
typedef _Float16 h2 __attribute__((ext_vector_type(2)));
#ifndef UPR
#define UPR 8
#endif
typedef unsigned u32x6 __attribute__((ext_vector_type(6)));
typedef _Float16 h32 __attribute__((ext_vector_type(32)));
struct H2x16 { h2 a[16]; };
#define EXP_ACC(S) do { _Pragma("unroll") for (int m = 0; m < 8; ++m) { \
        acc[S][0][m] = __builtin_elementwise_fma(hv.a[m], ws2, acc[S][0][m]); acc[S][1][m] = __builtin_elementwise_fma(hv.a[8 + m], ws2, acc[S][1][m]); } } while (0)
template <int VAR>
__device__ __forceinline__ void phase_experts(const Params& p, unsigned char* lds_raw) {
    const int tid = tid_opaque(), wid = __builtin_amdgcn_readfirstlane(tid >> 6);
    const unsigned char* ED = p.ws + OFF_ED; const unsigned char* EU = p.ws + OFF_ED + (size_t)16384 * 2048; const float* scl = (const float*)(p.ws + OFF_ESCL);
    const bf16_t* X1B = (const bf16_t*)(p.ws + OFF_XB); const float* ssq2 = (const float*)(p.ws + OFF_SSQ2);
    const int* eidx = (const int*)(p.ws + OFF_EIDX); const float* gsm = (const float*)(p.ws + OFF_GSM);
    const float* fgain = p.in[21]; float* out = p.out;
    unsigned* KY = (unsigned*)lds_raw + wid * 1024;
    float* AW = (float*)(KY + 512);
    const int gw = blockIdx.x * 8 + wid, nw = gridDim.x * 8;
#pragma unroll 1
    for (int t0 = gw; t0 < T_TOK; t0 += 4 * nw) {
        int lane; asm volatile("v_mbcnt_lo_u32_b32 %0, -1, 0\n\tv_mbcnt_hi_u32_b32 %0, -1, %0" : "=v"(lane));
        int tok[4];
#pragma unroll
        for (int s = 0; s < 4; ++s) { const int t = t0 + s * nw; tok[s] = t < T_TOK ? t : t0; }
#pragma unroll
        for (int r = 0; r < 8; ++r) { const int s = r >> 1, pos = (r & 1) * 64 + lane; const int e = eidx[(size_t)tok[s] * 128 + pos]; KY[r * 64 + lane] = ((unsigned)e << 9) | ((unsigned)s << 7) | (unsigned)pos; }
        asm volatile("s_waitcnt lgkmcnt(0)" ::: "memory"); __builtin_amdgcn_wave_barrier();
#pragma unroll 1
        for (int k = 2; k <= 512; k <<= 1)
#pragma unroll 1
            for (int j = k >> 1; j > 0; j >>= 1) {
                unsigned sa[4], sb[4]; int si[4];
#pragma unroll
                for (int q = 0; q < 4; ++q) { const int idx = q * 64 + lane; const int i = ((idx & ~(j - 1)) << 1) | (idx & (j - 1)); si[q] = i; sa[q] = KY[i]; sb[q] = KY[i | j]; }
#pragma unroll
                for (int q = 0; q < 4; ++q) { const unsigned a = sa[q], b = sb[q]; const bool asc = (si[q] & k) == 0; const bool sw = asc ? (a > b) : (a < b); sa[q] = sw ? b : a; sb[q] = sw ? a : b; }
#pragma unroll
                for (int q = 0; q < 4; ++q) { KY[si[q]] = sa[q]; KY[si[q] | j] = sb[q]; }
                asm volatile("s_waitcnt lgkmcnt(0)" ::: "memory"); __builtin_amdgcn_wave_barrier();
            }
        float rsv[4];
#pragma unroll
        for (int s = 0; s < 4; ++s) { float sq = ssq2[(size_t)tok[s] * 64 + lane]; sq = wave_sum(sq); rsv[s] = __uint_as_float((unsigned)__builtin_amdgcn_readfirstlane((int)__float_as_uint(__builtin_amdgcn_rsqf(sq * (1.0f / 2048.0f) + NORM_EPS)))); }
        {
            int xa[4][4], xb[4][4];
#pragma unroll
            for (int s = 0; s < 4; ++s) {
                u32x4 xr[4];
#pragma unroll
                for (int j = 0; j < 2; ++j) { xr[2 * j] = *(const u32x4*)(X1B + (size_t)tok[s] * 2048 + j * 1024 + lane * 16); xr[2 * j + 1] = *(const u32x4*)(X1B + (size_t)tok[s] * 2048 + j * 1024 + lane * 16 + 8); }
                float mx = 0.f;
#pragma unroll
                for (int h = 0; h < 4; ++h)
#pragma unroll
                    for (int q = 0; q < 4; ++q) mx = fmaxf(mx, fmaxf(fabsf(bf_lo(xr[h][q])), fabsf(bf_hi(xr[h][q]))));
                mx = fmaxf(wave_max(mx), 1e-30f);
                const float inv = 119.0f / mx;
#pragma unroll
                for (int h = 0; h < 4; ++h) { unsigned pa = 0u, pb = 0u;
#pragma unroll
                    for (int k = 0; k < 8; ++k) { const float f = ((k & 1) ? bf_hi(xr[h][k >> 1]) : bf_lo(xr[h][k >> 1])) * inv; const int xi = (int)__builtin_rintf(f);
                        pa |= ((unsigned)((xi + 8) >> 4) & 15u) << (4 * k); pb |= ((unsigned)xi & 15u) << (4 * k); }
                    xa[s][h] = (int)pa; xb[s][h] = (int)pb; }
                rsv[s] *= __uint_as_float((unsigned)__builtin_amdgcn_readfirstlane((int)__float_as_uint(mx * (1.0f / 119.0f))));
            }
            int lane_d = lane; asm volatile("" : "+v"(lane_d));
            const unsigned lo16 = (unsigned)lane_d * 16u, lo2 = 1024u + (unsigned)lane_d * 2u;
#pragma unroll 1
            for (int c = 0; c < ((VAR & 1) ? 0 : 8); ++c) {
                const unsigned kv = KY[c * 64 + lane];
                float mine = 0.f;
#pragma unroll 1
                for (int bt = 0; bt < 4; ++bt) {
                    float dd[16];
#pragma unroll
                    for (int il = 0; il < 1; ++il) {
                        SBAR();
                        u32x4 r0[16]; unsigned r1[16]; unsigned ky[16];
#pragma unroll
                        for (int s = 0; s < 16; ++s) { ky[s] = (unsigned)__builtin_amdgcn_readlane((int)kv, bt * 16 + il * 16 + s);
                            const unsigned char* row = ED + (ky[s] >> 9) * 1152u; unsigned oa = lo16, ob = lo2; asm volatile("" : "+v"(oa), "+v"(ob)); r0[s] = *(const u32x4*)(row + oa); r1[s] = *(const unsigned short*)(row + ob); }
#pragma unroll
                        for (int s = 0; s < 16; ++s) { const u32x4 w = r0[s]; const unsigned rbw = r1[s]; const unsigned sl = (ky[s] >> 7) & 3u; float dsum;
                            if (sl == 0u) { EXP_DOT(0); asm volatile("; slot 0" : "+v"(dsum)); } else if (sl == 1u) { EXP_DOT(1); asm volatile("; slot 1" : "+v"(dsum)); }
                            else if (sl == 2u) { EXP_DOT(2); asm volatile("; slot 2" : "+v"(dsum)); } else { EXP_DOT(3); asm volatile("; slot 3" : "+v"(dsum)); }
                            dd[il * 16 + s] = dsum; }
                    }
                    const float v = butterfly16(dd, lane);
                    mine = ((lane >> 4) == bt) ? v : mine;
                }
                AW[c * 64 + lane] = mine;
            }
        }
        {
            float sd[8], gg[8], su[8], av[8]; float rs8[8];
#pragma unroll
            for (int c = 0; c < 8; ++c) {
                const unsigned kv = KY[c * 64 + lane]; av[c] = AW[c * 64 + lane];
                const unsigned e = kv >> 9, sl = (kv >> 7) & 3u, pos = kv & 127u;
                const int mytok = sl == 0u ? tok[0] : (sl == 1u ? tok[1] : (sl == 2u ? tok[2] : tok[3]));
                rs8[c] = sl == 0u ? rsv[0] : (sl == 1u ? rsv[1] : (sl == 2u ? rsv[2] : rsv[3]));
                const unsigned eo = e * 4u, go = ((unsigned)mytok * 128u + pos) * 4u;
                sd[c] = *(const float*)((const char*)scl + eo); gg[c] = *(const float*)((const char*)gsm + go); su[c] = *(const float*)((const char*)(scl + 16384) + eo);
            }
#pragma unroll
            for (int c = 0; c < 8; ++c) { const _Float16 wh = (_Float16)(gelu_tanh(av[c] * sd[c] * rs8[c]) * gg[c] * su[c] * 1024.0f); AW[c * 64 + lane] = __builtin_bit_cast(float, (h2){wh, wh}); }
        }
        int lane_u = lane; asm volatile("" : "+v"(lane_u));
        const unsigned uo16 = (unsigned)lane_u * 16u, uo8 = 1024u + (unsigned)lane_u * 8u;
        h2 acc[4][2][8];
#pragma unroll
        for (int s = 0; s < 4; ++s)
#pragma unroll
            for (int j = 0; j < 2; ++j)
#pragma unroll
                for (int q = 0; q < 8; ++q) acc[s][j][q] = (h2){(_Float16)0.f, (_Float16)0.f};
#pragma unroll 1
        for (int c = 0; c < ((VAR & 2) ? 0 : 8); ++c) {
            const unsigned kv = KY[c * 64 + lane]; const float wv = AW[c * 64 + lane];
#pragma unroll 1
            for (int b8 = 0; b8 < 64 / UPR; ++b8) {
                u32x4 r0[UPR]; u32x2 r1[UPR]; unsigned ky[UPR];
#pragma unroll
                for (int k = 0; k < UPR; ++k) { ky[k] = (unsigned)__builtin_amdgcn_readlane((int)kv, b8 * UPR + k);
                    const unsigned char* row = EU + (ky[k] >> 9) * 1536u; unsigned oa = uo16, ob = uo8; asm volatile("" : "+v"(oa), "+v"(ob)); r0[k] = *(const u32x4*)(row + oa); r1[k] = *(const u32x2*)(row + ob); }
#pragma unroll
                for (int k = 0; k < UPR; ++k) { const unsigned sl = (ky[k] >> 7) & 3u;
                    const H2x16 hv = __builtin_bit_cast(H2x16, __builtin_amdgcn_cvt_scalef32_pk32_f16_fp6((u32x6){r0[k][0], r0[k][1], r0[k][2], r0[k][3], r1[k][0], r1[k][1]}, 1.0f));
                    const h2 ws2 = __builtin_bit_cast(h2, (unsigned)__builtin_amdgcn_readlane((int)__float_as_uint(wv), b8 * UPR + k));
                    if (sl == 0u) { EXP_ACC(0); } asm volatile("; slot 0" ::: "memory"); if (sl == 1u) { EXP_ACC(1); } asm volatile("; slot 1" ::: "memory");
                    if (sl == 2u) { EXP_ACC(2); } asm volatile("; slot 2" ::: "memory"); if (sl == 3u) { EXP_ACC(3); } asm volatile("; slot 3" ::: "memory"); }
            }
        }
        {
            int lane_f = lane; asm volatile("" : "+v"(lane_f));
            u32x4 xl[4][4]; f32x4 gn[2][4];
#pragma unroll
            for (int s = 0; s < 4; ++s)
#pragma unroll
                for (int j = 0; j < 2; ++j) { const bf16_t* xp = X1B + (size_t)tok[s] * 2048 + j * 1024 + lane_f * 16; xl[s][2 * j] = *(const u32x4*)xp; xl[s][2 * j + 1] = *(const u32x4*)(xp + 8); }
#pragma unroll
            for (int j = 0; j < 2; ++j)
#pragma unroll
                for (int q = 0; q < 4; ++q) gn[j][q] = *(const f32x4*)(fgain + j * 1024 + lane_f * 16 + 4 * q);
#pragma unroll
            for (int s = 0; s < 4; ++s) {
                float ss = 0.f; f32x2 xo[2][8];
#pragma unroll
                for (int j = 0; j < 2; ++j) { const u32x4 xa = xl[s][2 * j], xb2 = xl[s][2 * j + 1];
#pragma unroll
                    for (int q = 0; q < 4; ++q) { const unsigned w0_ = q < 2 ? xa[2 * q] : xb2[2 * q - 4], w1_ = q < 2 ? xa[2 * q + 1] : xb2[2 * q - 3]; const f32x4 a = {bf_lo(w0_), bf_hi(w0_), bf_lo(w1_), bf_hi(w1_)};
                        xo[j][2 * q] = (f32x2){a[0] + (float)acc[s][j][2 * q].x * (1.0f / 1024.0f), a[1] + (float)acc[s][j][2 * q].y * (1.0f / 1024.0f)};
                        xo[j][2 * q + 1] = (f32x2){a[2] + (float)acc[s][j][2 * q + 1].x * (1.0f / 1024.0f), a[3] + (float)acc[s][j][2 * q + 1].y * (1.0f / 1024.0f)};
                        ss += xo[j][2 * q].x * xo[j][2 * q].x + xo[j][2 * q].y * xo[j][2 * q].y + xo[j][2 * q + 1].x * xo[j][2 * q + 1].x + xo[j][2 * q + 1].y * xo[j][2 * q + 1].y; } }
                ss = wave_sum(ss);
                const float rf = __builtin_amdgcn_rsqf(ss * (1.0f / 2048.0f) + NORM_EPS);
                if (t0 + s * nw < T_TOK) {
#pragma unroll
                    for (int j = 0; j < 2; ++j) { float* xp = out + (size_t)tok[s] * 2048 + j * 1024 + lane_f * 16;
#pragma unroll
                        for (int q = 0; q < 4; ++q) { const f32x4 g = gn[j][q];
                            *(f32x4*)(xp + 4 * q) = (f32x4){xo[j][2 * q].x * rf * g[0], xo[j][2 * q].y * rf * g[1], xo[j][2 * q + 1].x * rf * g[2], xo[j][2 * q + 1].y * rf * g[3]}; } }
                }
            }
        }
        __builtin_amdgcn_wave_barrier();
    }
}
#undef EXP_DOT
#undef EXP_ACC

#define XB_TMO      128
#define XB_XCNT(j)  (256  + 64 * (j))
#define XB_XSUB(j)  (1280 + 64 * (j))
#define XB_XGEN(j)  (2304 + 64 * (j))
#define XB_TOP      3328
#define XB_TOPGEN   3392
#define XCD_BAR_WORDS 3456
#define XB_SPIN_CAP (1u << 18)

__device__ __forceinline__ unsigned xb_ld(unsigned* p)              { return __hip_atomic_load(p, __ATOMIC_RELAXED, __HIP_MEMORY_SCOPE_AGENT); }
__device__ __forceinline__ unsigned xb_add(unsigned* p, unsigned v) { return __hip_atomic_fetch_add(p, v, __ATOMIC_RELAXED, __HIP_MEMORY_SCOPE_AGENT); }
__device__ __forceinline__ unsigned xb_xcc_id() { return (unsigned)__builtin_amdgcn_s_getreg((3 << 11) | 20) & 0xFu; }
#define XB_SPIN(cond, bar) do { unsigned _sp = 0; while (cond) { __builtin_amdgcn_s_sleep(1); \
    if ((++_sp & 255u) == 0u) { if (xb_ld(&(bar)[XB_TMO])) break; if (_sp > XB_SPIN_CAP) { atomicAdd(&(bar)[XB_TMO], 1u); break; } } } } while (0)

struct XcdBarrier {
    unsigned* bar; unsigned x;
    volatile LAS unsigned* st;
};

__device__ __forceinline__ XcdBarrier xcd_barrier_post(unsigned* bar, volatile LAS unsigned* st) {
    XcdBarrier b; b.bar = bar; b.x = xb_xcc_id(); b.st = st;
    if (threadIdx.x == 0) (void)xb_add(&bar[XB_XCNT(b.x)], 1u);
    return b;
}
__device__ __forceinline__ void xcd_barrier_complete(unsigned* bar, unsigned x, unsigned& nloc, unsigned& nx) {
    const unsigned G = gridDim.x * gridDim.y * gridDim.z;
    unsigned sum, cnt, mine, sp = 0u;
    for (;;) {
        sum = 0u; cnt = 0u; mine = 0u;
#pragma unroll
        for (unsigned j = 0; j < 16; ++j) { const unsigned c = xb_ld(&bar[XB_XCNT(j)]); sum += c; cnt += (c > 0u) ? 1u : 0u; mine = (j == x) ? c : mine; }
        if (sum == G) break;
        __builtin_amdgcn_s_sleep(1);
        if ((++sp & 255u) == 0u) { if (xb_ld(&bar[XB_TMO])) break; if (sp > XB_SPIN_CAP) { atomicAdd(&bar[XB_TMO], 1u); break; } }
    }
    nloc = mine > 0u ? mine : 1u; nx = cnt > 0u ? cnt : 1u;
}

__device__ __forceinline__ void xcd_barrier(const XcdBarrier& b) {
    asm volatile("s_waitcnt vmcnt(0)" ::: "memory");
    __syncthreads();
    if (threadIdx.x == 0) {
        unsigned* bar = b.bar;
        __builtin_amdgcn_s_waitcnt(0);
        unsigned nloc = b.st[0], nx = b.st[1];
        if (nloc == 0u) { xcd_barrier_complete(bar, b.x, nloc, nx); b.st[0] = nloc; b.st[1] = nx; }
        const unsigned old = xb_add(&bar[XB_XSUB(b.x)], 1u);
        const unsigned gen = old / nloc;
        if (old + 1u == (gen + 1u) * nloc) {
            __builtin_amdgcn_fence(__ATOMIC_RELEASE, "agent");
            asm volatile("s_waitcnt vmcnt(0)" ::: "memory");
            const unsigned og = xb_add(&bar[XB_TOP], 1u);
            const unsigned tg = og / nx;
            if (og + 1u == (tg + 1u) * nx) xb_add(&bar[XB_TOPGEN], 1u);
            else XB_SPIN(xb_ld(&bar[XB_TOPGEN]) == tg, bar);
            __builtin_amdgcn_fence(__ATOMIC_ACQUIRE, "agent");
            xb_add(&bar[XB_XGEN(b.x)], 1u);
            asm volatile("s_waitcnt vmcnt(0)" ::: "memory");
        } else {
            XB_SPIN(xb_ld(&bar[XB_XGEN(b.x)]) == gen, bar);
            __builtin_amdgcn_fence(__ATOMIC_ACQUIRE, "agent");
            asm volatile("s_waitcnt vmcnt(0)" ::: "memory");
        }
    }
    __syncthreads();
}


#ifdef DBG_PROBE
constexpr size_t OFF_DBG = 470 * MiB;
constexpr int DBG_NS = 32;
__device__ __forceinline__ int dbg_token(int i) { return (i * 509 + 37 * (i & 7) * 64 + 5) & (T_TOK - 1); }
__device__ __forceinline__ float block_sum(float v, float* red) {
    v = wave_sum(v); __syncthreads(); if ((threadIdx.x & 63) == 0) red[threadIdx.x >> 6] = v; __syncthreads();
    float s = 0.f; for (int i = 0; i < 8; ++i) s += red[i]; __syncthreads(); return s;
}
__device__ void probe_peer_naive(const Params& p, unsigned char* lds_raw) {
    if ((int)blockIdx.x >= DBG_NS) return;
    const int tid = threadIdx.x, t = dbg_token(blockIdx.x);
    float* xn = (float*)lds_raw;
    float* q = xn + 2048;
    float* sc = q + 2048;
    float* wexp = sc + 2048;
    int* eix = (int*)(wexp + 128);
    float* gg = (float*)(eix + 128);
    float* red = gg + 128;
    float* tmpv = red + 16;
    int* tmpi = (int*)(tmpv + 256);
    float* cand = (float*)(tmpi + 256);
    const float* x1 = p.out + (size_t)t * 2048; const float* g2 = p.in[15];
    float ss = 0.f; for (int i = tid; i < 2048; i += 512) { const float v = x1[i]; ss += v * v; }
    ss = block_sum(ss, red);
    const float rs = 1.0f / sqrtf(ss / 2048.0f + NORM_EPS);
    for (int i = tid; i < 2048; i += 512) xn[i] = x1[i] * rs * g2[i];
    __syncthreads();
    { const float* wq = p.in[16]; float a0 = 0, a1 = 0, a2 = 0, a3 = 0;
      for (int k = 0; k < 2048; ++k) { const float xv = xn[k]; const float* w = wq + (size_t)k * 2048; a0 += xv * w[tid]; a1 += xv * w[tid + 512]; a2 += xv * w[tid + 1024]; a3 += xv * w[tid + 1536]; }
      q[tid] = a0; q[tid + 512] = a1; q[tid + 1024] = a2; q[tid + 1536] = a3; }
    __syncthreads();
    for (int i = tid; i < 2048; i += 512) { const int which = i >> 10, h = (i >> 7) & 7, key = i & 127; const float* kk = p.in[17 + which] + ((size_t)h * 128 + key) * 128; const float* qq = q + h * 256 + which * 128;
        float s = 0.f; for (int d = 0; d < 128; ++d) s += qq[d] * kk[d]; sc[i] = s; }
    __syncthreads();
    if (tid < 16) { const int which = tid >> 3, h = tid & 7; float* s = sc + which * 1024 + h * 128;
        for (int r = 0; r < 16; ++r) { int bi = 0; float bv = -3e38f; for (int k = 0; k < 128; ++k) if (s[k] > bv) { bv = s[k]; bi = k; } tmpv[(h * 2 + which) * 16 + r] = bv; tmpi[(h * 2 + which) * 16 + r] = bi; s[bi] = -3e38f; } }
    __syncthreads();
    for (int i = tid; i < 2048; i += 512) { const int h = i >> 8, a = (i >> 4) & 15, b = i & 15; cand[i] = tmpv[(h * 2) * 16 + a] + tmpv[(h * 2 + 1) * 16 + b]; }
    __syncthreads();
    if (tid < 8) { const int h = tid; float* c = cand + h * 256; float mx = -3e38f;
        for (int r = 0; r < 16; ++r) { int bi = 0; float bv = -3e38f; for (int k = 0; k < 256; ++k) if (c[k] > bv) { bv = c[k]; bi = k; } c[bi] = -3e38f;
            eix[h * 16 + r] = tmpi[(h * 2) * 16 + (bi >> 4)] * 128 + tmpi[(h * 2 + 1) * 16 + (bi & 15)]; gg[h * 16 + r] = bv; if (bv > mx) mx = bv; }
        float sm = 0.f; for (int r = 0; r < 16; ++r) { const float e = expf(gg[h * 16 + r] - mx); gg[h * 16 + r] = e; sm += e; }
        for (int r = 0; r < 16; ++r) gg[h * 16 + r] /= sm; }
    __syncthreads();
    { const int wid = tid >> 6, lane = tid & 63;
      for (int e = wid; e < 128; e += 8) { const float* u = p.in[19] + (size_t)eix[e] * 2048; float s = 0.f; for (int d = lane; d < 2048; d += 64) s += xn[d] * u[d]; s = wave_sum(s);
          if (lane == 0) wexp[e] = gelu_tanh(s) * gg[e]; } }
    __syncthreads();
    float* dbg = (float*)(p.ws + OFF_DBG) + (size_t)blockIdx.x * 2048;
    float o[4]; float s2 = 0.f;
    for (int j = 0; j < 4; ++j) { const int c = tid + j * 512; float a = 0.f; for (int e = 0; e < 128; ++e) a += wexp[e] * p.in[20][(size_t)eix[e] * 2048 + c]; o[j] = x1[c] + a; s2 += o[j] * o[j]; }
    s2 = block_sum(s2, red);
    const float rf = 1.0f / sqrtf(s2 / 2048.0f + NORM_EPS);
    for (int j = 0; j < 4; ++j) { const int c = tid + j * 512; dbg[c] = o[j] * rf * p.in[21][c]; }
    int* dsel = (int*)(p.ws + OFF_DBG + 1 * MiB) + (size_t)blockIdx.x * 256;
    if (tid < 128) { dsel[tid] = eix[tid]; ((float*)dsel)[128 + tid] = gg[tid]; }
}
__device__ void probe_peer_compare(const Params& p, unsigned char* lds_raw, int mode) {
    float* red = (float*)lds_raw; const int tid = threadIdx.x;
    if (blockIdx.x == 0) {
        float num = 0.f, den = 0.f;
        if (mode == 0) { for (int i = 0; i < DBG_NS; ++i) { const float* a = p.out + (size_t)dbg_token(i) * 2048; const float* b = (const float*)(p.ws + OFF_DBG) + (size_t)i * 2048;
                for (int c = tid; c < 2048; c += 512) { const float d = a[c] - b[c]; num += d * d; den += b[c] * b[c]; } } }
        else { const int* eidx = (const int*)(p.ws + OFF_EIDX); const float* gsm = (const float*)(p.ws + OFF_GSM);
            for (int i = tid; i < DBG_NS * 128; i += 512) { const int s = i >> 7, k = i & 127, h = k >> 4; const int* dsel = (const int*)(p.ws + OFF_DBG + 1 * MiB) + (size_t)s * 256; const int t = dbg_token(s);
                const int e = dsel[k]; const float g = ((const float*)dsel)[128 + k]; bool found = false; float gp = 0.f;
                for (int r = 0; r < 16; ++r) if (eidx[(size_t)t * 128 + h * 16 + r] == e) { found = true; gp = gsm[(size_t)t * 128 + h * 16 + r]; }
                if (mode == 1) { num += found ? 0.f : 1.f; den += 1.f; } else { if (found) { num += (gp - g) * (gp - g); den += g * g; } } } }
        num = block_sum(num, red + 32); den = block_sum(den, red + 32);
        if (tid == 0) ((float*)(p.ws + OFF_MISC + M_CTL))[32] = num / fmaxf(den, 1e-30f);
    }
}
__device__ void probe_encode(const Params& p) {
    const float e = ((const float*)(p.ws + OFF_MISC + M_CTL))[32];
    const float beta = 0.967f - 0.9f * sqrtf(fminf(fmaxf(e, 0.f), 1.f));
    const float bb = (e == e) ? beta : -1.0f;
    for (size_t i = (size_t)blockIdx.x * 512 + threadIdx.x; i < (size_t)T_TOK * 2048; i += (size_t)gridDim.x * 512) p.out[i] = p.in[0][i] * bb;
}
#endif

constexpr int LDS_BYTES = 132 * 1024;
#ifndef N_PHASES
#define N_PHASES 11
#endif
__device__ __forceinline__ void run_phase(int ph, const Params& p, unsigned char* lds) {
    const int G = gridDim.x, c = blockIdx.x;
    unsigned char* ws = p.ws;
    switch (ph) {
    case 0: phase_prep(p, lds); break;
    case 1: { SchedGemm1 S{(const char*)(ws + OFF_XB), (const char*)(ws + OFF_WINT), G, c}; EpiGemm1 E{1, ws, p.out, p.in[3], p.in[4], p.in[5]};
              pg8::gemm_phase<true>((LAS unsigned char*)lds, 1024, 1024, 1024, S, E); } break;
    case 2: { SchedCompress S{(const char*)(ws + OFF_KV6), (const char*)(ws + OFF_KV6) + (size_t)16 * 2048 * 128 * 2, (const char*)(ws + OFF_W1T), G, c}; EpiSlab E{(float*)(ws + OFF_XB)};
              pg8::gemm_phase<false>((LAS unsigned char*)lds, 512, 2048, 4096, S, E);
              fox_cumsum(p, G >= 138 ? 128 : 0); } break;
    case 3: phase_cmp2(p, lds); break;
    case 4: phase_cmp_attn(p, lds); break;
    case 5: phase_attn(p, lds); break;
    case 6: { SchedMerge S{(const char*)(ws + OFF_XB), (const char*)(ws + OFF_WUPT), G, c}; EpiMerge E{(const unsigned char*)p.out, (const unsigned char*)p.out + (size_t)T_TOK * 2048, ws + OFF_QKVF};
              pg8::gemm_phase<true>((LAS unsigned char*)lds, 512, 1024, 1024, S, E); } break;
    case 7: { SchedSquare S{(const char*)(ws + OFF_QKVF), (const char*)(ws + OFF_WOUTT), G, c, 2048}; EpiOut E{p.in[0], p.out, (bf16_t*)(ws + OFF_XB), (float*)(ws + OFF_SSQ2)};
              pg8::gemm_phase<true>((LAS unsigned char*)lds, 1024, 1024, 1024, S, E); } break;
    case 8: { SchedSquare S{(const char*)(ws + OFF_XB), (const char*)(ws + OFF_WQT), G, c, 4096}; EpiPeerQ E{(const float*)(ws + OFF_SSQ2), (bf16_t*)(ws + OFF_QKVF)};
              pg8::gemm_phase<false>((LAS unsigned char*)lds, 2048, 2048, 2048, S, E); } break;
    case 9: phase_peer_topk(p, lds); break;
    case 10: phase_experts<0>(p, lds); break;
    }
}

constexpr size_t OFF_BAR = OFF_MISC + 7 * MiB;
__global__ void __launch_bounds__(512, 2) fwd_megakernel(Params p) {
    extern __shared__ __attribute__((aligned(16))) unsigned char shm[];
    cg::grid_group grid = cg::this_grid();
    volatile LAS unsigned* bst = (volatile LAS unsigned*)((LAS unsigned char*)shm + LDS_BYTES - 16);
    if (threadIdx.x < 4) bst[threadIdx.x] = 0u;
    __syncthreads();
    const XcdBarrier xb = xcd_barrier_post((unsigned*)(p.ws + OFF_BAR), bst);
#define GSYNC() xcd_barrier(xb)
#ifdef ONLY_PHASE
    run_phase(ONLY_PHASE, p, shm); grid.sync();
#else
#ifndef REPEAT_MASK
#define REPEAT_MASK 0
#endif
#define RUNP(k) do { run_phase(k, p, shm); GSYNC(); if (REPEAT_MASK & (1 << (k))) { if ((k) == 5) { if (blockIdx.x == 0 && threadIdx.x == 0) *(unsigned*)(p.ws + OFF_MISC + M_CTL) = 0u; GSYNC(); } run_phase(k, p, shm); GSYNC(); } } while (0)
    run_phase(0, p, shm);
#if REPEAT_MASK & 1
    GSYNC(); run_phase(0, p, shm);
#endif
    if (p.ws == nullptr) grid.sync();
    GSYNC();
#ifdef P1VAR
    { const int G = gridDim.x, c = blockIdx.x; unsigned char* ws = p.ws;
      SchedGemm1 S{(const char*)(ws + ((P1VAR & 2) ? 160 * MiB : OFF_XB)), (const char*)(ws + ((P1VAR & 2) ? 350 * MiB : OFF_WINT)), G, c}; int st_ = (P1VAR & 4) ? 0 : 1; asm volatile("" : "+s"(st_)); EpiGemm1 E{st_, ws, p.out, p.in[3], p.in[4], p.in[5]};
      pg8::gemm_phase<true, (P1VAR & 1) != 0>((LAS unsigned char*)shm, 1024, 1024, 1024, S, E); GSYNC(); }
#endif
    RUNP(1); RUNP(2); RUNP(3); RUNP(4); RUNP(5);
#ifdef PXVAR
    { const int G = gridDim.x, c = blockIdx.x; unsigned char* ws = p.ws;
      if (PXVAR & 1) { SchedMerge S{(const char*)(ws + OFF_XB), (const char*)(ws + OFF_WUPT), G, c}; EpiMerge E{(const unsigned char*)p.out, (const unsigned char*)p.out + (size_t)T_TOK * 2048, ws + OFF_QKVF};
          pg8::gemm_phase<true, true>((LAS unsigned char*)shm, 512, 1024, 1024, S, E); GSYNC(); }
      if (PXVAR & 2) { SchedSquare S{(const char*)(ws + OFF_QKVF), (const char*)(ws + OFF_WOUTT), G, c, 2048}; EpiOut E{p.in[0], p.out, (bf16_t*)(ws + OFF_XB), (float*)(ws + OFF_SSQ2)};
          pg8::gemm_phase<true, true>((LAS unsigned char*)shm, 1024, 1024, 1024, S, E); GSYNC(); }
      if (PXVAR & 4) { SchedSquare S{(const char*)(ws + OFF_XB), (const char*)(ws + OFF_WQT), G, c, 4096}; EpiPeerQ E{(const float*)(ws + OFF_SSQ2), (bf16_t*)(ws + OFF_QKVF)};
          pg8::gemm_phase<false, true>((LAS unsigned char*)shm, 2048, 2048, 2048, S, E); GSYNC(); } }
#endif
    RUNP(6); RUNP(7); RUNP(8); RUNP(9);
#if 0
#endif
#ifdef DBG_PROBE
    probe_peer_naive(p, shm); grid.sync();
#endif
#if (REPEAT_MASK >> 10) & 1
    phase_experts<P10VAR>(p, shm); GSYNC();
#endif
#ifdef EXTRA_GSYNC
    for (int i_ = 0; i_ < EXTRA_GSYNC; ++i_) GSYNC();
#endif
    run_phase(10, p, shm);
#ifdef DBG_PROBE
    grid.sync(); probe_peer_compare(p, shm, DBG_PROBE - 1); grid.sync(); probe_encode(p);
#endif
#endif
}

extern "C" void kernel_launch(void* const* d_in, const int* in_sizes, int n_in, void* d_out, int out_size, void* d_ws, size_t ws_size, hipStream_t stream) {
    static int grid_blocks = 0;
    if (grid_blocks == 0) {
        if (n_in != 22 || out_size != T_TOK * DM || ws_size < WS_END) { fprintf(stderr, "kernel_launch: unexpected shapes (n_in %d out %d ws %zu, need ws >= %zu)\n", n_in, out_size, ws_size, (size_t)WS_END); grid_blocks = -1; return; }
        int dev = 0, cus = 0, per_cu = 0;
        hipGetDevice(&dev); hipDeviceGetAttribute(&cus, hipDeviceAttributeMultiprocessorCount, dev);
        if (hipFuncSetAttribute((const void*)fwd_megakernel, hipFuncAttributeMaxDynamicSharedMemorySize, LDS_BYTES) != hipSuccess) { fprintf(stderr, "kernel_launch: hipFuncSetAttribute failed\n"); grid_blocks = -1; return; }
        if (hipOccupancyMaxActiveBlocksPerMultiprocessor(&per_cu, (const void*)fwd_megakernel, 512, LDS_BYTES) != hipSuccess || per_cu < 1) { fprintf(stderr, "kernel_launch: occupancy query says %d\n", per_cu); grid_blocks = -1; return; }
        grid_blocks = cus;
    }
    if (grid_blocks < 0) return;
    Params p{};
    for (int i = 0; i < 22; ++i) p.in[i] = (const float*)d_in[i];
    p.out = (float*)d_out; p.ws = (unsigned char*)d_ws;
    if (hipMemsetAsync((char*)d_ws + OFF_BAR, 0, XCD_BAR_WORDS * 4, stream) != hipSuccess) { fprintf(stderr, "kernel_launch: memset of the barrier words failed\n"); return; }
#ifdef P1VAR
    if (P1VAR & 2) { hipMemsetAsync((char*)d_ws + 160 * MiB, 0, 32 * MiB, stream); hipMemsetAsync((char*)d_ws + 350 * MiB, 0, 20 * MiB, stream); }
#endif
    void* args[] = {&p};
    hipError_t e = hipLaunchCooperativeKernel((const void*)fwd_megakernel, dim3(grid_blocks), dim3(512), args, LDS_BYTES, stream);
    if (e != hipSuccess) fprintf(stderr, "cooperative launch failed: %s (grid %d)\n", hipGetErrorString(e), grid_blocks);
}
```

```cpp
#include <hip/hip_runtime.h>
#include <hip/hip_cooperative_groups.h>
#include <cstdio>
#include <cstdint>
namespace cg = cooperative_groups;

#define LAS __attribute__((address_space(3)))
typedef unsigned short bf16_t;
typedef short bf16x8 __attribute__((ext_vector_type(8)));
typedef short s16x4 __attribute__((ext_vector_type(4)));
typedef float f32x2 __attribute__((ext_vector_type(2)));
typedef float f32x4 __attribute__((ext_vector_type(4)));
typedef float f32x16 __attribute__((ext_vector_type(16)));
typedef unsigned u32x2 __attribute__((ext_vector_type(2)));
typedef unsigned u32x4 __attribute__((ext_vector_type(4)));
typedef __bf16 bf16x2v __attribute__((ext_vector_type(2)));

constexpr int T_TOK = 16384, DM = 2048, NB = 8, SEQ = 2048;
constexpr int NWIN = 9984;
constexpr float NORM_EPS = 1e-6f;
constexpr float LOG2E = 1.4426950408889634f;
constexpr float ATT_SCALE = 0.08838834764831845f;

constexpr float SC_X = 16.f, SC_WIN = 1024.f, SC_O = 16.f, SC_WUP = 512.f, SC_M = 64.f, SC_WOUT = 1024.f;
constexpr size_t MiB = 1ull << 20;
constexpr size_t OFF_ED = 0, OFF_EU = 64 * MiB, OFF_XB = 128 * MiB  , OFF_WINT = 192 * MiB  ;
constexpr size_t OFF_WUPT = 232 * MiB, OFF_WOUTT = 240 * MiB, OFF_WQT = 248 * MiB, OFF_W1T = 256 * MiB, OFF_MISC = 260 * MiB;
constexpr size_t OFF_QN = 268 * MiB, OFF_KV6 = 300 * MiB, OFF_QKVF = 350 * MiB  ;
constexpr size_t OFF_KCVC = 446 * MiB, OFF_SEL = 447 * MiB, OFF_SSQ2 = 448 * MiB, OFF_EIDX = 452 * MiB, OFF_GSM = 460 * MiB, WS_END = 468 * MiB;
constexpr size_t M_ROPE = 0  , M_K12 = 1 * MiB  , M_B1P = M_K12 + 512 * 1024  ;
constexpr size_t M_B1 = M_B1P + 128 * 1024  , M_SSQ1 = M_B1P + 160 * 1024  , M_GN = 2 * MiB  , M_LOGF = 4 * MiB  , M_CFOX = M_LOGF + 512 * 1024;
constexpr size_t M_CTL = 5 * MiB  ;
constexpr size_t OFF_ESCL = OFF_MISC + 6 * MiB;

struct Params {
    const float* in[22];
    float* out;
    unsigned char* ws;
};

__device__ __forceinline__ unsigned cvtpk(float lo, float hi) { unsigned r; asm volatile("v_cvt_pk_bf16_f32 %0, %1, %2" : "=v"(r) : "v"(lo), "v"(hi)); return r; }
__device__ __forceinline__ unsigned pack_fp8x4(float a, float b, float c, float d) {
    a = fminf(fmaxf(a, -448.f), 448.f); b = fminf(fmaxf(b, -448.f), 448.f); c = fminf(fmaxf(c, -448.f), 448.f); d = fminf(fmaxf(d, -448.f), 448.f);
    int pk = 0; pk = __builtin_amdgcn_cvt_pk_fp8_f32(a, b, pk, false); pk = __builtin_amdgcn_cvt_pk_fp8_f32(c, d, pk, true); return (unsigned)pk; }
__device__ __forceinline__ unsigned pack_i8x4(float a, float b, float c, float d) {
    const int ia = (int)__builtin_rintf(a), ib = (int)__builtin_rintf(b), ic = (int)__builtin_rintf(c), id = (int)__builtin_rintf(d);
    return ((unsigned)ia & 0xffu) | (((unsigned)ib & 0xffu) << 8) | (((unsigned)ic & 0xffu) << 16) | ((unsigned)id << 24); }
__device__ __forceinline__ float bf_lo(unsigned u) { return __uint_as_float(u << 16); }
__device__ __forceinline__ float bf_hi(unsigned u) { return __uint_as_float(u & 0xffff0000u); }
__device__ __forceinline__ float sigmoidf_(float x) { return __builtin_amdgcn_rcpf(1.0f + __builtin_amdgcn_exp2f(-LOG2E * x)); }
__device__ __forceinline__ float gelu_tanh(float x) { const float u = 0.7978845608028654f * (x + 0.044715f * x * x * x); const float e = __builtin_amdgcn_exp2f(2.0f * LOG2E * u); const float t = 1.0f - 2.0f * __builtin_amdgcn_rcpf(e + 1.0f); return 0.5f * x * (1.0f + t); }
__device__ __forceinline__ int tid_opaque() { int t = threadIdx.x; asm volatile("" : "+v"(t)); return t; }
template <int CTRL> __device__ __forceinline__ float dppx(float v) { return __uint_as_float((unsigned)__builtin_amdgcn_update_dpp(0, (int)__float_as_uint(v), CTRL, 0xf, 0xf, true)); }
constexpr int DPP_XOR1 = 0xB1  , DPP_XOR2 = 0x4E  , DPP_HMIRROR = 0x141  , DPP_MIRROR = 0x140  ;
__device__ __forceinline__ float swap16_sum(float v) { auto r = __builtin_amdgcn_permlane16_swap(__float_as_uint(v), __float_as_uint(v), false, false); return __uint_as_float(r[0]) + __uint_as_float(r[1]); }
__device__ __forceinline__ float swap32_sum(float v) { auto r = __builtin_amdgcn_permlane32_swap(__float_as_uint(v), __float_as_uint(v), false, false); return __uint_as_float(r[0]) + __uint_as_float(r[1]); }
__device__ __forceinline__ float swap16_max(float v) { auto r = __builtin_amdgcn_permlane16_swap(__float_as_uint(v), __float_as_uint(v), false, false); return fmaxf(__uint_as_float(r[0]), __uint_as_float(r[1])); }
__device__ __forceinline__ float swap32_max(float v) { auto r = __builtin_amdgcn_permlane32_swap(__float_as_uint(v), __float_as_uint(v), false, false); return fmaxf(__uint_as_float(r[0]), __uint_as_float(r[1])); }
__device__ __forceinline__ float xor32(float v, int hi) { auto r = __builtin_amdgcn_permlane32_swap(__float_as_uint(v), __float_as_uint(v), false, false); return __uint_as_float(hi ? r[0] : r[1]); }
__device__ __forceinline__ float wave_sum(float v) {
    v += dppx<DPP_XOR1>(v); v += dppx<DPP_XOR2>(v); v += dppx<DPP_HMIRROR>(v); v += dppx<DPP_MIRROR>(v);
    return swap32_sum(swap16_sum(v));
}
__device__ __forceinline__ float wave_max(float v) {
    v = fmaxf(v, dppx<DPP_XOR1>(v)); v = fmaxf(v, dppx<DPP_XOR2>(v)); v = fmaxf(v, dppx<DPP_HMIRROR>(v)); v = fmaxf(v, dppx<DPP_MIRROR>(v));
    return swap32_max(swap16_max(v));
}
__device__ __forceinline__ float butterfly16(float (&dd)[16], int lane) {
#define BF_STEP(S, N, CTRL) do { const bool up = (lane & (S)) != 0; _Pragma("unroll") for (int i = 0; i < (N); ++i) { const float send = up ? dd[i] : dd[i + (N)]; const float keep = up ? dd[i + (N)] : dd[i]; dd[i] = keep + dppx<CTRL>(send); } } while (0)
    BF_STEP(8, 8, DPP_MIRROR); BF_STEP(4, 4, DPP_HMIRROR); BF_STEP(2, 2, DPP_XOR2); BF_STEP(1, 1, DPP_XOR1);
#undef BF_STEP
    return swap32_sum(swap16_sum(dd[0]));
}
#define CE_DESC(a, b) do { const float _x = fmaxf(a, b), _y = fminf(a, b); a = _x; b = _y; } while (0)
template <int N> __device__ __forceinline__ void bitonic_sort_desc(float (&v)[N]) {
#pragma unroll
    for (int k = 2; k <= N; k <<= 1)
#pragma unroll
        for (int j = k >> 1; j > 0; j >>= 1)
#pragma unroll
            for (int i = 0; i < N; ++i) { const int l = i ^ j; if (l > i) { if ((i & k) == 0) { CE_DESC(v[i], v[l]); } else { CE_DESC(v[l], v[i]); } } }
}
__device__ __forceinline__ void merge_top16(float (&a)[16], const float (&b)[16]) {
#pragma unroll
    for (int i = 0; i < 16; ++i) a[i] = fmaxf(a[i], b[15 - i]);
#pragma unroll
    for (int j = 8; j > 0; j >>= 1)
#pragma unroll
        for (int i = 0; i < 16; ++i) { const int l = i ^ j; if (l > i) CE_DESC(a[i], a[l]); }
}

__device__ __forceinline__ int win_src_col(int n) {
    const int tile = n >> 8, w = n & 255;
    if (tile < 4) { const int p = w & 127, hd = tile * 2 + (w >> 7), q = p >> 3, e = p & 7; const int d = e < 4 ? 4 * q + e : 64 + 4 * q + (e - 4); return hd * 128 + d; }
    if (tile < 10) { const int idx = tile - 4, g = w >> 7, p = w & 127; int d = p; if (idx == 2 || idx == 4) { const int q = p >> 3, e = p & 7; d = e < 4 ? 4 * q + e : 64 + 4 * q + (e - 4); } return 1024 + idx * 256 + g * 128 + d; }
    if (tile < 22) return 2584 + (n - 2560);
    if (tile < 38) { const int j = tile - 22; return w < 128 ? 5664 + 128 * j + w : 7712 + 128 * j + (w - 128); }
    if (w < 24) return 2560 + w;
    if (w < 32) return 5656 + (w - 24);
    return -1;
}
template <int MAPKIND, bool OUT8>
__device__ __forceinline__ void transpose_tile_w(const float* __restrict__ src, int ld_src, const float* __restrict__ gain, void* __restrict__ dstv, int ld_dst, int k0, int n0, float* tl, int lane, float scale) {
    const int sc = MAPKIND == 1 ? win_src_col(n0 + lane) : n0 + lane;
    const float* sp = src + (size_t)k0 * ld_src + (sc >= 0 ? sc : 0);
#pragma unroll 1
    for (int kb = 0; kb < 64; kb += 32) {
        float v[32];
#pragma unroll
        for (int i = 0; i < 32; ++i) v[i] = sp[(size_t)(kb + i) * ld_src];
#pragma unroll
        for (int i = 0; i < 32; ++i) { float x = sc >= 0 ? v[i] * scale : 0.f; if (gain) x *= gain[k0 + kb + i]; tl[(kb + i) * 65 + lane] = x; }
    }
    asm volatile("s_waitcnt lgkmcnt(0)" ::: "memory"); __builtin_amdgcn_wave_barrier();
    if constexpr (OUT8) {
        unsigned char* dst = (unsigned char*)dstv; const int kq = (lane & 3) * 16, rq = lane >> 2;
#pragma unroll
        for (int r = 0; r < 4; ++r) { const int n2 = r * 16 + rq; u32x4 w;
#pragma unroll
            for (int q = 0; q < 4; ++q) w[q] = pack_fp8x4(tl[(kq + 4 * q + 0) * 65 + n2], tl[(kq + 4 * q + 1) * 65 + n2], tl[(kq + 4 * q + 2) * 65 + n2], tl[(kq + 4 * q + 3) * 65 + n2]);
            *(u32x4*)(dst + (size_t)(n0 + n2) * ld_dst + k0 + kq) = w; }
    } else {
        bf16_t* dst = (bf16_t*)dstv; const int kq = (lane & 15) * 4, rq = lane >> 4;
#pragma unroll 4
        for (int r = 0; r < 16; ++r) { const int n2 = r * 4 + rq;
            u32x2 w; w.x = cvtpk(tl[(kq + 0) * 65 + n2], tl[(kq + 1) * 65 + n2]); w.y = cvtpk(tl[(kq + 2) * 65 + n2], tl[(kq + 3) * 65 + n2]);
            *(u32x2*)(dst + (size_t)(n0 + n2) * ld_dst + k0 + kq) = w; }
    }
    asm volatile("s_waitcnt lgkmcnt(0)" ::: "memory"); __builtin_amdgcn_wave_barrier();
}
template <int MAPKIND, bool OUT8>
__device__ __forceinline__ void transpose_job(const float* src, int ld_src, int K, const float* gain, void* dst, int ld_dst, int N_dst, float* tl, int& jb, int gw, int nw, int lane, float scale) {
    const int nkt = K / 64, nnt = N_dst / 64, total = nkt * nnt;
    for (int j = (gw + nw - (jb % nw)) % nw; j < total; j += nw) {
        const int nt = j % nnt, kt = j / nnt;
        transpose_tile_w<MAPKIND, OUT8>(src, ld_src, gain, dst, ld_dst, kt * 64, nt * 64, tl, lane, scale);
    }
    jb += total;
}

constexpr int LATE_ROWS = 6144;
__device__ __forceinline__ void convert_expert_rows(const Params& p, int r0, int r1, int lane) {
    const float* g2 = p.in[15];
    unsigned char* E8 = p.ws + OFF_ED; float* scl = (float*)(p.ws + OFF_ESCL);
    f32x4 v[2][2][4]; float mx[2] = {0.f, 0.f};
#pragma unroll
    for (int u = 0; u < 2; ++u) { const int r = u ? r1 : r0; const int which = r >> 14, e = r & 16383; const float* src = p.in[19 + which] + (size_t)e * 2048;
#pragma unroll
        for (int j = 0; j < 2; ++j)
#pragma unroll
            for (int q = 0; q < 4; ++q) v[u][j][q] = *(const f32x4*)(src + j * 1024 + lane * 16 + q * 4); }
#pragma unroll
    for (int u = 0; u < 2; ++u) { const int r = u ? r1 : r0; const int which = r >> 14, e = r & 16383;
#pragma unroll
        for (int j = 0; j < 2; ++j)
#pragma unroll
            for (int q = 0; q < 4; ++q) { f32x4 t = v[u][j][q]; if (which == 0) t *= *(const f32x4*)(g2 + j * 1024 + lane * 16 + q * 4); v[u][j][q] = t;
                mx[u] = fmaxf(mx[u], fmaxf(fmaxf(fabsf(t[0]), fabsf(t[1])), fmaxf(fabsf(t[2]), fabsf(t[3])))); }
        mx[u] = wave_max(mx[u]);
        if (which == 0) {
            const float rowmax = fmaxf(mx[u], 1e-30f);
            unsigned char* rec = E8 + (size_t)e * 1152; u32x4 w; unsigned rbs = 0u;
#pragma unroll
            for (int j = 0; j < 2; ++j) {
                float gm = 0.f;
#pragma unroll
                for (int q = 0; q < 4; ++q) gm = fmaxf(gm, fmaxf(fmaxf(fabsf(v[u][j][q][0]), fabsf(v[u][j][q][1])), fmaxf(fabsf(v[u][j][q][2]), fabsf(v[u][j][q][3]))));
                float rbf = __builtin_ceilf(gm * (255.0f / rowmax)); rbf = fminf(fmaxf(rbf, 1.0f), 255.0f);
                const float inv = (255.0f * 7.0f) / (rowmax * rbf);
                unsigned nb[2] = {0u, 0u};
#pragma unroll
                for (int q = 0; q < 4; ++q)
#pragma unroll
                    for (int i = 0; i < 4; ++i) { const float t = fminf(fmaxf(__builtin_rintf(v[u][j][q][i] * inv), -7.f), 7.f); const unsigned nib = (unsigned)(int)t & 15u; const int el = q * 4 + i;
                        nb[el >> 3] |= nib << (4 * (el & 7)); }
                w[2 * j] = nb[0]; w[2 * j + 1] = nb[1];
                rbs |= (unsigned)rbf << (8 * j);
            }
            *(u32x4*)(rec + lane * 16) = w;
            *(unsigned short*)(rec + 1024 + lane * 2) = (unsigned short)rbs;
            if (lane == 0) scl[e] = rowmax * (1.0f / (255.0f * 7.0f));
            continue;
        }
        const float sc = fmaxf(mx[u], 1e-30f) * (1.0f / 7.5f), inv = 1.0f / sc;
        unsigned w6[7] = {0u, 0u, 0u, 0u, 0u, 0u, 0u};
#pragma unroll
        for (int j = 0; j < 2; ++j)
#pragma unroll
            for (int q = 0; q < 4; ++q)
#pragma unroll
                for (int i = 0; i < 4; ++i) { const float t = v[u][j][q][i] * inv; const float a = fminf(fabsf(t), 7.5f);
                    const float c1 = __builtin_rintf(a * 8.0f), c2 = __builtin_rintf(a * 4.0f) + 8.0f, c3 = __builtin_rintf(a * 2.0f) + 16.0f;
                    const unsigned code = (unsigned)(int)(a < 2.0f ? c1 : (a < 4.0f ? c2 : c3)) | ((__float_as_uint(t) >> 31) << 5);
                    const int bit = 6 * (j * 16 + q * 4 + i), d = bit >> 5, sh = bit & 31;
                    w6[d] |= code << sh; if (sh > 26) w6[d + 1] |= code >> (32 - sh); }
        { unsigned char* rec = E8 + (size_t)which * (16384 * 2048) + (size_t)e * 1536;
          *(u32x4*)(rec + lane * 16) = (u32x4){w6[0], w6[1], w6[2], w6[3]}; *(u32x2*)(rec + 1024 + lane * 8) = (u32x2){w6[4], w6[5]}; }
        if (lane == 0) scl[which * 16384 + e] = sc; }
}

__device__ __forceinline__ void phase_prep(const Params& p, unsigned char* lds_raw) {
    const int tid = tid_opaque(), wid = tid >> 6, lane = tid & 63;
    float* tl = (float*)lds_raw + wid * (64 * 65);
    const int gw = blockIdx.x * 8 + wid, nw = gridDim.x * 8;
    unsigned char* ws = p.ws;
#ifndef P0_REP_A
#define P0_REP_A 1
#define P0_REP_B 1
#define P0_REP_C 1
#endif
    for (int rep = 0; rep < P0_REP_A; ++rep) {
        const float* x = p.in[0]; unsigned char* xb = ws + OFF_XB; float* ssq1 = (float*)(ws + OFF_MISC + M_SSQ1);
        for (int r = gw; r < T_TOK; r += 2 * nw) {
            const int r2 = r + nw < T_TOK ? r + nw : r;
            f32x4 va[8], vb[8];
#pragma unroll
            for (int j = 0; j < 8; ++j) { va[j] = *(const f32x4*)(x + (size_t)r * DM + j * 256 + lane * 4); vb[j] = *(const f32x4*)(x + (size_t)r2 * DM + j * 256 + lane * 4); }
            float sa = 0.f, sb = 0.f;
#pragma unroll
            for (int j = 0; j < 8; ++j) { const f32x4 v = va[j]; sa += v[0] * v[0] + v[1] * v[1] + v[2] * v[2] + v[3] * v[3];
                *(unsigned*)(xb + (size_t)r * DM + j * 256 + lane * 4) = pack_fp8x4(v[0] * SC_X, v[1] * SC_X, v[2] * SC_X, v[3] * SC_X); }
#pragma unroll
            for (int j = 0; j < 8; ++j) { const f32x4 v = vb[j]; sb += v[0] * v[0] + v[1] * v[1] + v[2] * v[2] + v[3] * v[3];
                *(unsigned*)(xb + (size_t)r2 * DM + j * 256 + lane * 4) = pack_fp8x4(v[0] * SC_X, v[1] * SC_X, v[2] * SC_X, v[3] * SC_X); }
            sa = wave_sum(sa); sb = wave_sum(sb); if (lane == 0) { ssq1[r] = sa; ssq1[r2] = sb; }
        }
    }
    for (int rep = 0; rep < P0_REP_B; ++rep) {
        int jb = 0;
        transpose_job<1, true>(p.in[2], 9760, 2048, p.in[1], ws + OFF_WINT, 2048, NWIN, tl, jb, gw, nw, lane, SC_WIN);
        transpose_job<0, true>(p.in[12], 2048, 1024, nullptr, ws + OFF_WUPT, 2048, 2048, tl, jb, gw, nw, lane, SC_WUP);
        transpose_job<0, true>(p.in[13], 2048, 1024, nullptr, ws + OFF_WUPT + 1024, 2048, 2048, tl, jb, gw, nw, lane, SC_WUP);
        transpose_job<0, true>(p.in[14], 2048, 2048, nullptr, ws + OFF_WOUTT, 2048, 2048, tl, jb, gw, nw, lane, SC_WOUT);
        transpose_job<0, false>(p.in[16], 2048, 2048, p.in[15], ws + OFF_WQT, 2048, 2048, tl, jb, gw, nw, lane, 1.0f);
        transpose_job<0, false>(p.in[7], 256, 4096, nullptr, ws + OFF_W1T, 4096, 256, tl, jb, gw, nw, lane, 1.0f);
        transpose_job<0, false>(p.in[10], 256, 4096, nullptr, ws + OFF_W1T + (size_t)256 * 4096 * 2, 4096, 256, tl, jb, gw, nw, lane, 1.0f);
    }
    {
        const int nrows0 = 2 * 16384 - (gridDim.x == 256 ? LATE_ROWS : 0);
        for (int r0 = gw; r0 < nrows0; r0 += 2 * nw) convert_expert_rows(p, r0, r0 + nw < nrows0 ? r0 + nw : r0, lane);
    }
#ifndef P0_REP_D
#define P0_REP_D 1
#define P0_REP_E 1
#define P0_REP_F 1
#endif
    for (int rep = 0; rep < P0_REP_D; ++rep) {
        bf16_t* K12 = (bf16_t*)(ws + OFF_MISC + M_K12);
        for (int i = blockIdx.x * 512 + tid; i < 2 * 131072 / 4; i += gridDim.x * 512) {
            const int which = i >= 32768, j = (i & 32767) * 4; const f32x4 v = *(const f32x4*)(p.in[17 + which] + j);
            u32x2 w; w.x = cvtpk(v[0], v[1]); w.y = cvtpk(v[2], v[3]); *(u32x2*)(K12 + which * 131072 + j) = w; }
    }
    for (int rep = 0; rep < P0_REP_E; ++rep) {
        f32x2* cs = (f32x2*)(ws + OFF_MISC + M_ROPE);
        for (int i = blockIdx.x * 512 + tid; i < 2048 * 64; i += gridDim.x * 512) {
            const int pos = i >> 6, f = i & 63; const float inv = exp2f(-(float)f * (13.287712379549449f / 64.0f));
            const float ang = (float)pos * inv;
            const float CH = 1.5915493667e-01f, CL = 6.4206383266e-09f;
            const float rev_hi = ang * CH; const float rev_lo = fmaf(ang, CH, -rev_hi) + ang * CL;
            float r = rev_hi - rintf(rev_hi); r += rev_lo;
            cs[i] = (f32x2){__builtin_amdgcn_cosf(r), __builtin_amdgcn_sinf(r)}; }
    }
    for (int rep = 0; rep < P0_REP_F; ++rep) {
        float* b1p = (float*)(ws + OFF_MISC + M_B1P);
        float* red = (float*)lds_raw;
        for (int j = blockIdx.x; j < 128; j += gridDim.x) { const int which = j >> 6, part = j & 63;
            const float* pos = p.in[which ? 9 : 6]; const float* w1 = p.in[which ? 10 : 7];
            f32x4 s = {0.f, 0.f, 0.f, 0.f};
#pragma unroll
            for (int i = 0; i < 8; ++i) { const int k = part * 64 + wid * 8 + i; s += *(const f32x4*)(w1 + (size_t)k * 256 + lane * 4) * pos[k]; }
            __syncthreads();
            *(f32x4*)(red + wid * 256 + lane * 4) = s;
            __syncthreads();
            if (tid < 256) { float t = 0.f;
#pragma unroll
                for (int w = 0; w < 8; ++w) t += red[w * 256 + tid];
                b1p[(which * 64 + part) * 256 + tid] = t; }
        }
        __syncthreads();
    }
    if (blockIdx.x == 0 && tid < 64) ((unsigned*)(ws + OFF_MISC + M_CTL))[tid] = 0u;
}
namespace pg8 {
constexpr int BM = 256, BK = 64, HALF = 128, HTB = HALF * BK * 2, STAGE_BYTES = 8 * HTB, NXCD = 8;
__host__ __device__ __forceinline__ int lds_byte(int r, int c) { const int st = (r >> 4) * 2 + (c >> 5), rr = r & 15, cc = c & 31, ob = rr * 64 + cc * 2; return st * 1024 + (ob ^ (((ob >> 9) & 1) << 5)); }
__host__ __device__ __forceinline__ void stage_rc(int b, int& R, int& C) { const int st = b / 1024, sb = b % 1024, swz = sb ^ (((sb >> 9) & 1) << 5); R = (st >> 1) * 16 + swz / 64; C = (st & 1) * 32 + (swz % 64) / 2; }
__host__ __device__ __forceinline__ int perm32(int rho) { const int n = rho >> 4, i = rho & 15; return 8 * (i >> 2) + 4 * n + (i & 3); }

constexpr int UF_ZERO = 1, UF_FINAL = 2;
struct Unit { const char* A; const char* B; int pm, pn, flags, aux; };

__device__ __forceinline__ bool static_tile(int L, int nM, int nN, int& pm, int& pn, int WGM) {
    const int nwg = nM * nN; if (L >= nwg) return false;
    int wgid = L; { const int q = nwg / NXCD, r = nwg % NXCD, xcd = wgid % NXCD, off = wgid / NXCD; wgid = (xcd < r ? xcd * (q + 1) : r * (q + 1) + (xcd - r) * q) + off; }
    const int nig = WGM * nN, gid = wgid / nig, fm = gid * WGM, gsz = (nM - fm) < WGM ? (nM - fm) : WGM;
    pm = fm + ((wgid % nig) % gsz); pn = (wgid % nig) / gsz; return true;
}

typedef int i32x8 __attribute__((ext_vector_type(8)));
__device__ __forceinline__ i32x8 cat8(const bf16x8 a, const bf16x8 b) { const u32x4 x = __builtin_bit_cast(u32x4, a), y = __builtin_bit_cast(u32x4, b); return (i32x8){(int)x[0], (int)x[1], (int)x[2], (int)x[3], (int)y[0], (int)y[1], (int)y[2], (int)y[3]}; }
template <bool FP8, bool NOEPI = false, class Epi, class Sched>
__device__ __forceinline__ void gemm_phase(LAS unsigned char* lds, const int K, const int lda, const int ldb, const Sched& S, const Epi& E) {
    int tid = threadIdx.x; asm volatile("" : "+v"(tid));
    const int wid = __builtin_amdgcn_readfirstlane(tid >> 6), lane = tid & 63, wr = wid >> 2, wc = wid & 3, fr = lane & 15, fq = lane >> 4;
    int nt = K / BK; asm volatile("" : "+s"(nt));
    unsigned voffA[2], voffB[2];
#pragma unroll
    for (int i = 0; i < 2; ++i) { int R, C; stage_rc(tid * 16 + i * 8192, R, C); const int Rb = (R & ~31) + perm32(R & 31);
        voffA[i] = (unsigned)(R * lda + C) * 2u; voffB[i] = (unsigned)(Rb * ldb + C) * 2u; }
    const size_t kstep = (size_t)(BK * 2);
    const size_t hsA = (size_t)HALF * lda * 2, hsB = (size_t)HALF * ldb * 2;
    const unsigned ldsw = (unsigned)wid * 1024u;
    const int aoff = lds_byte(wr * 64 + fr, fq * 8), boff = lds_byte(wc * 32 + fr, fq * 8);
#define PG8_SA(b, h) (((b) * 2 + (h)) * HTB)
#define PG8_SB(b, h) ((4 + (b) * 2 + (h)) * HTB)
#define PG8_STAGE(bufoff, gbase, voff) do { _Pragma("unroll") for (int _i = 0; _i < 2; ++_i) \
        __builtin_amdgcn_global_load_lds((const unsigned*)((const char*)(gbase) + (voff)[_i]), (LAS unsigned*)(lds + (bufoff) + ldsw + _i * 8192), 16, 0, 0); } while (0)
#define PG8_LDA(dst, b, h) do { _Pragma("unroll") for (int m = 0; m < 4; ++m) { const u32x4 _l = *(const LAS u32x4*)(lds + PG8_SA(b, h) + aoff + m * 2048), _h = *(const LAS u32x4*)(lds + PG8_SA(b, h) + aoff + m * 2048 + 1024); \
        dst[m] = (i32x8){(int)_l[0], (int)_l[1], (int)_l[2], (int)_l[3], (int)_h[0], (int)_h[1], (int)_h[2], (int)_h[3]}; } } while (0)
#define PG8_LDB(dst, b, h) do { _Pragma("unroll") for (int n = 0; n < 2; ++n) { const u32x4 _l = *(const LAS u32x4*)(lds + PG8_SB(b, h) + boff + n * 2048), _h = *(const LAS u32x4*)(lds + PG8_SB(b, h) + boff + n * 2048 + 1024); \
        dst[n] = (i32x8){(int)_l[0], (int)_l[1], (int)_l[2], (int)_l[3], (int)_h[0], (int)_h[1], (int)_h[2], (int)_h[3]}; } } while (0)
#define PG8_LO(v) __builtin_bit_cast(bf16x8, (u32x4){(unsigned)(v)[0], (unsigned)(v)[1], (unsigned)(v)[2], (unsigned)(v)[3]})
#define PG8_HI(v) __builtin_bit_cast(bf16x8, (u32x4){(unsigned)(v)[4], (unsigned)(v)[5], (unsigned)(v)[6], (unsigned)(v)[7]})
#define PG8_MMA(ai, bj, At, Bt) do { __builtin_amdgcn_s_setprio(1); \
        if constexpr (FP8) { _Pragma("unroll") for (int m = 0; m < 4; ++m) _Pragma("unroll") for (int n = 0; n < 2; ++n) \
            asm volatile("v_mfma_scale_f32_16x16x128_f8f6f4 %0, %1, %2, %0, %3, %3 op_sel_hi:[0,0,0]" : "+v"(acc[ai][bj][m][n]) : "v"(Bt[n]), "v"(At[m]), "v"(mxscale)); } \
        else { _Pragma("unroll") for (int m = 0; m < 4; ++m) _Pragma("unroll") for (int n = 0; n < 2; ++n) { \
            acc[ai][bj][m][n] = __builtin_amdgcn_mfma_f32_16x16x32_bf16(PG8_LO(Bt[n]), PG8_LO(At[m]), acc[ai][bj][m][n], 0, 0, 0); \
            acc[ai][bj][m][n] = __builtin_amdgcn_mfma_f32_16x16x32_bf16(PG8_HI(Bt[n]), PG8_HI(At[m]), acc[ai][bj][m][n], 0, 0, 0); } } \
        __builtin_amdgcn_s_setprio(0); } while (0)
#define PG8_WAIT_V(n) asm volatile("s_waitcnt vmcnt(" #n ")" ::: "memory")
#define PG8_WAIT_L(n) asm volatile("s_waitcnt lgkmcnt(" #n ")" ::: "memory")
#define PG8_BAR __builtin_amdgcn_s_barrier()
#define PG8_SCHED __builtin_amdgcn_sched_barrier(0)
    Unit cur, nxt; int ui = 0; bool prestaged = false;
    if (!S.next(0, cur)) return;
    f32x4 acc[2][2][4][2];
#pragma unroll
    for (int a = 0; a < 2; ++a)
#pragma unroll
        for (int b = 0; b < 2; ++b)
#pragma unroll
            for (int m = 0; m < 4; ++m)
#pragma unroll
                for (int n = 0; n < 2; ++n) acc[a][b][m][n] = (f32x4){0.f, 0.f, 0.f, 0.f};
    i32x8 At[4], B0[2], B1[2];
    int mxscale = 0x7F7F7F7F; asm volatile("" : "+v"(mxscale));
    const char* cA = cur.A; const char* cB = cur.B;
    PG8_STAGE(PG8_SB(0, 0), cB, voffB); PG8_STAGE(PG8_SA(0, 0), cA, voffA); PG8_STAGE(PG8_SB(0, 1), cB + hsB, voffB); PG8_STAGE(PG8_SA(0, 1), cA + hsA, voffA);
    if (wr == 1) PG8_BAR;
    PG8_WAIT_V(4); PG8_BAR;
    PG8_STAGE(PG8_SB(1, 0), cB + kstep, voffB); PG8_STAGE(PG8_SA(1, 0), cA + kstep, voffA); PG8_STAGE(PG8_SB(1, 1), cB + hsB + kstep, voffB);
    PG8_WAIT_V(6); PG8_BAR;
    for (;;) {
        const bool has_next = S.next(ui + 1, nxt);
        const char* nA = has_next ? nxt.A : cA; const char* nB = has_next ? nxt.B : cB;
#pragma unroll 1
        for (int t = 0; t < nt; t += 2) {
            const bool last = (t == nt - 2);
            const char* a1 = cA + (size_t)(t + 1) * kstep;
            const char* a2 = last ? nA : cA + (size_t)(t + 2) * kstep; const char* b2 = last ? nB : cB + (size_t)(t + 2) * kstep;
            const char* a3 = a2 + kstep; const char* b3 = b2 + kstep;
            PG8_LDB(B0, 0, 0); PG8_SCHED; PG8_LDA(At, 0, 0); if (!(prestaged && t == 0)) PG8_STAGE(PG8_SA(1, 1), a1 + hsA, voffA);
            PG8_WAIT_L(8); PG8_BAR; PG8_WAIT_L(0); PG8_MMA(0, 0, At, B0); PG8_BAR; PG8_SCHED;
            PG8_LDB(B1, 0, 1); PG8_STAGE(PG8_SB(0, 0), b2, voffB);
            PG8_BAR; PG8_WAIT_L(0); PG8_MMA(0, 1, At, B1); PG8_BAR;
            PG8_LDA(At, 0, 1); PG8_STAGE(PG8_SA(0, 0), a2, voffA);
            PG8_BAR; PG8_WAIT_L(0); PG8_MMA(1, 0, At, B0); PG8_BAR; PG8_SCHED;
            PG8_STAGE(PG8_SB(0, 1), b2 + hsB, voffB);
            if (prestaged && t == 0) { PG8_WAIT_V(63); } else { PG8_WAIT_V(6); }
            PG8_BAR; PG8_MMA(1, 1, At, B1); PG8_BAR;
            PG8_LDB(B0, 1, 0); PG8_SCHED; PG8_LDA(At, 1, 0); PG8_STAGE(PG8_SA(0, 1), a2 + hsA, voffA);
            PG8_WAIT_L(8); PG8_BAR; PG8_WAIT_L(0); PG8_MMA(0, 0, At, B0); PG8_BAR; PG8_SCHED;
            PG8_LDB(B1, 1, 1); PG8_STAGE(PG8_SB(1, 0), b3, voffB);
            PG8_BAR; PG8_WAIT_L(0); PG8_MMA(0, 1, At, B1); PG8_BAR;
            PG8_LDA(At, 1, 1); PG8_STAGE(PG8_SA(1, 0), a3, voffA);
            PG8_BAR; PG8_WAIT_L(0); PG8_MMA(1, 0, At, B0); PG8_BAR; PG8_SCHED;
            PG8_STAGE(PG8_SB(1, 1), b3 + hsB, voffB);
            PG8_WAIT_V(6); PG8_BAR; PG8_MMA(1, 1, At, B1); PG8_BAR;
        }
        if constexpr (FP8) asm volatile("s_nop 15\n\ts_nop 15" ::: "memory");
        prestaged = false;
        if (Epi::WAITS_ON_READS && !NOEPI && has_next) {
            PG8_STAGE(PG8_SA(1, 1), nA + kstep + hsA, voffA); asm volatile("" ::: "memory"); PG8_SCHED; prestaged = true; }
        if constexpr (!NOEPI) E(acc, cur, wr, wc, fr, fq);
        if (!has_next) break;
        if (nxt.flags & UF_ZERO) {
#pragma unroll
            for (int a = 0; a < 2; ++a)
#pragma unroll
                for (int b = 0; b < 2; ++b)
#pragma unroll
                    for (int m = 0; m < 4; ++m)
#pragma unroll
                        for (int n = 0; n < 2; ++n) acc[a][b][m][n] = (f32x4){0.f, 0.f, 0.f, 0.f};
        }
        cur = nxt; cA = nA; cB = nB; ++ui;
    }
    PG8_WAIT_V(0);
    if (wr == 0) PG8_BAR;
    PG8_BAR;
#undef PG8_SA
#undef PG8_SB
#undef PG8_STAGE
#undef PG8_LDA
#undef PG8_LDB
#undef PG8_MMA
#undef PG8_LO
#undef PG8_HI
#undef PG8_WAIT_V
#undef PG8_WAIT_L
#undef PG8_BAR
#undef PG8_SCHED
}
}
using pg8::Unit;

#ifndef WGM_G1
#define WGM_G1 4
#define WGM_SQ 4
#endif
#ifndef WGM_P6
#define WGM_P6 WGM_SQ
#endif
#ifndef WGM_P7
#define WGM_P7 WGM_SQ
#endif
#ifndef WGM_P8
#define WGM_P8 WGM_SQ
#endif
struct SchedGemm1 {
    const char* A; const char* B; int G, c;
    __device__ __forceinline__ bool next(int i, Unit& u) const { int pm, pn; if (!pg8::static_tile(i * G + c, 64, 39, pm, pn, WGM_G1)) return false;
        u.A = A + (size_t)pm * 256 * 2048; u.B = B + (size_t)pn * 256 * 2048; u.pm = pm; u.pn = pn; u.flags = pg8::UF_ZERO | pg8::UF_FINAL; u.aux = 0; return true; }
};
struct SchedSquare {
    const char* A; const char* B; int G, c; int rb;
    __device__ __forceinline__ bool next(int i, Unit& u) const { int pm, pn; if (!pg8::static_tile(i * G + c, 64, 8, pm, pn, rb == 2048 ? WGM_P7 : WGM_P8)) return false;
        u.A = A + (size_t)pm * 256 * rb; u.B = B + (size_t)pn * 256 * rb; u.pm = pm; u.pn = pn; u.flags = pg8::UF_ZERO | pg8::UF_FINAL; u.aux = 0; return true; }
};
struct SchedMerge {
    const char* A; const char* B; int G, c;
    __device__ __forceinline__ bool next(int i, Unit& u) const { int pm, pn; if (!pg8::static_tile((i >> 1) * G + c, 64, 8, pm, pn, WGM_P6)) return false; const int w = i & 1;
        u.A = A + (size_t)pm * 256 * 2048 + (size_t)w * 1024; u.B = B + (size_t)pn * 256 * 2048 + (size_t)w * 1024; u.pm = pm; u.pn = pn; u.flags = w ? pg8::UF_FINAL : pg8::UF_ZERO; u.aux = w; return true; }
};
struct SchedCompress {
    const char* Ak; const char* Av; const char* B; int G, c;
    __device__ __forceinline__ bool next(int i, Unit& u) const { const int L = i * G + c; if (L >= 128) return false; const int which = L >> 6, mt = (L >> 3) & 7, ks = L & 7;
        u.A = (which ? Av : Ak) + (size_t)mt * 256 * 2048 * 2 + (size_t)ks * 512 * 2; u.B = B + (size_t)which * 256 * 4096 * 2 + (size_t)ks * 512 * 2; u.pm = mt; u.pn = 0; u.flags = pg8::UF_ZERO | pg8::UF_FINAL; u.aux = which * 8 + ks; return true; }
};

#define EPI_LOOP_AI_M for (int ai = 0; ai < 2; ++ai) for (int m = 0; m < 4; ++m)
struct EpiGemm1 {
    static constexpr bool WAITS_ON_READS = true;
    int st; unsigned char* ws; float* gate_out  ; const float* nsa_gb; const float* fox_fb; const float* merge_gb;
    __device__ __forceinline__ void operator()(f32x4 (&acc)[2][2][4][2], const Unit& u, int wr, int wc, int fr, int fq) const {
        const float* ssq1 = (const float*)(ws + OFF_MISC + M_SSQ1);
        const int pn = u.pn;
        const int p0 = wc * 32 + fq * 8;
        const int rbase = u.pm * 256 + wr * 64 + fr;
        float rsv[2][4];
#pragma unroll
        for (int ai = 0; ai < 2; ++ai)
#pragma unroll
            for (int m = 0; m < 4; ++m) rsv[ai][m] = __builtin_amdgcn_rsqf(ssq1[rbase + ai * 128 + m * 16] * (1.0f / 2048.0f) + NORM_EPS) * (1.0f / (SC_X * SC_WIN));
        asm volatile("" :: "v"(rsv[0][0]));
        if (pn < 10) {
            const bool rope = pn < 4 || pn == 6 || pn == 8;
            const f32x2* cs = (const f32x2*)(ws + OFF_MISC + M_ROPE) + 4 * (p0 >> 3);
            bf16_t* dbase = pn < 4 ? (bf16_t*)(ws + OFF_QN) + (size_t)(pn * 2) * 2048 * 128 + p0 : (bf16_t*)(ws + OFF_KV6) + (size_t)(pn - 4) * (16 * 2048 * 128) + p0;
            const int hmul = pn < 4 ? 8 : 2;
            f32x4 cc[2][4][2];
#pragma unroll
            for (int ai = 0; ai < 2; ++ai)
#pragma unroll
                for (int m = 0; m < 4; ++m) { const int s = (rbase + ai * 128 + m * 16) & 2047;
                    cc[ai][m][0] = *(const f32x4*)(cs + s * 64); cc[ai][m][1] = *(const f32x4*)(cs + s * 64 + 2); }
#pragma unroll
            for (int ai = 0; ai < 2; ++ai)
#pragma unroll
                for (int m = 0; m < 4; ++m) {
                    const int r = rbase + ai * 128 + m * 16, b = r >> 11, s = r & 2047; const float rs = rsv[ai][m];
                    const f32x4 c01 = cc[ai][m][0], c23 = cc[ai][m][1];
                    const f32x4 co = rope ? (f32x4){c01[0], c01[2], c23[0], c23[2]} : (f32x4){1.f, 1.f, 1.f, 1.f}, si = rope ? (f32x4){c01[1], c01[3], c23[1], c23[3]} : (f32x4){0.f, 0.f, 0.f, 0.f};
#pragma unroll
                    for (int bj = 0; bj < 2; ++bj) {
                        const f32x4 x1 = acc[ai][bj][m][0] * rs, x2 = acc[ai][bj][m][1] * rs;
                        const f32x4 y1 = x1 * co - x2 * si, y2 = x2 * co + x1 * si;
                        u32x4 w; w.x = cvtpk(y1[0], y1[1]); w.y = cvtpk(y1[2], y1[3]); w.z = cvtpk(y2[0], y2[1]); w.w = cvtpk(y2[2], y2[3]);
                        if (st) *(u32x4*)(dbase + ((size_t)(b * hmul + bj) * 2048 + s) * 128) = w;
                    }
                }
        } else if (pn < 22) {
            const int idx = (pn - 10) >> 2, hb = ((pn - 10) & 3) * 2;
            bf16_t* dbase = (bf16_t*)(ws + OFF_QKVF) + (size_t)idx * (64 * 2048 * 128) + (size_t)hb * 2048 * 128 + p0;
#pragma unroll
            for (int ai = 0; ai < 2; ++ai)
#pragma unroll
                for (int m = 0; m < 4; ++m) {
                    const int r = rbase + ai * 128 + m * 16, b = r >> 11, s = r & 2047; const float rs = rsv[ai][m];
#pragma unroll
                    for (int bj = 0; bj < 2; ++bj) {
                        const f32x4 x1 = acc[ai][bj][m][0] * rs, x2 = acc[ai][bj][m][1] * rs;
                        u32x4 w; w.x = cvtpk(x1[0], x1[1]); w.y = cvtpk(x1[2], x1[3]); w.z = cvtpk(x2[0], x2[1]); w.w = cvtpk(x2[2], x2[3]);
                        if (st) *(u32x4*)(dbase + ((size_t)(b * 8 + bj) * 2048 + s) * 128) = w;
                    }
                }
        } else if (pn < 38) {
            const int col = (pn - 22) * 128 + p0;
            const f32x4 ba0 = *(const f32x4*)(merge_gb + col), ba1 = *(const f32x4*)(merge_gb + col + 4), bb0 = *(const f32x4*)(merge_gb + 2048 + col), bb1 = *(const f32x4*)(merge_gb + 2048 + col + 4);
            unsigned char* g0 = (unsigned char*)gate_out + col;
#pragma unroll
            for (int ai = 0; ai < 2; ++ai)
#pragma unroll
                for (int m = 0; m < 4; ++m) {
                    const int r = rbase + ai * 128 + m * 16; const float rs = rsv[ai][m];
                    float ra[8], gb[8];
#pragma unroll
                    for (int i = 0; i < 4; ++i) {
                        const float za0 = __builtin_amdgcn_fmed3f(acc[ai][0][m][0][i] * rs + ba0[i], -40.f, 40.f), zb0 = __builtin_amdgcn_fmed3f(acc[ai][1][m][0][i] * rs + bb0[i], -40.f, 40.f);
                        const float za1 = __builtin_amdgcn_fmed3f(acc[ai][0][m][1][i] * rs + ba1[i], -40.f, 40.f), zb1 = __builtin_amdgcn_fmed3f(acc[ai][1][m][1][i] * rs + bb1[i], -40.f, 40.f);
                        const float ta0 = 1.0f + __builtin_amdgcn_exp2f(-LOG2E * za0), tb0 = 1.0f + __builtin_amdgcn_exp2f(-LOG2E * zb0), ta1 = 1.0f + __builtin_amdgcn_exp2f(-LOG2E * za1), tb1 = 1.0f + __builtin_amdgcn_exp2f(-LOG2E * zb1);
                        const float q0 = __builtin_amdgcn_rcpf(ta0 * tb0), q1 = __builtin_amdgcn_rcpf(ta1 * tb1);
                        ra[i] = tb0 * tb0 * q0; gb[i] = ta0 * q0; ra[4 + i] = tb1 * tb1 * q1; gb[4 + i] = ta1 * q1; }
                    const u32x2 w = {pack_fp8x4(ra[0], ra[1], ra[2], ra[3]), pack_fp8x4(ra[4], ra[5], ra[6], ra[7])};
                    const u32x2 y = {pack_fp8x4(gb[0] * 256.f, gb[1] * 256.f, gb[2] * 256.f, gb[3] * 256.f), pack_fp8x4(gb[4] * 256.f, gb[5] * 256.f, gb[6] * 256.f, gb[7] * 256.f)};
                    if (st) { *(u32x2*)(g0 + (size_t)r * 2048) = w; *(u32x2*)(g0 + (size_t)T_TOK * 2048 + (size_t)r * 2048) = y; }
                }
        } else if (wc == 0) {
            float* gn = (float*)(ws + OFF_MISC + M_GN); float* lf = (float*)(ws + OFF_MISC + M_LOGF);
            float bias[8];
#pragma unroll
            for (int i = 0; i < 8; ++i) { const int col = fq * 8 + i; bias[i] = col < 24 ? nsa_gb[col] : fox_fb[col - 24]; }
#pragma unroll
            for (int ai = 0; ai < 2; ++ai)
#pragma unroll
                for (int m = 0; m < 4; ++m) {
                    const int r = rbase + ai * 128 + m * 16; const float rs = rsv[ai][m];
#pragma unroll
                    for (int n = 0; n < 2; ++n)
#pragma unroll
                        for (int i = 0; i < 4; ++i) { const float z = acc[ai][0][m][n][i] * rs + bias[n * 4 + i];
                            const float em = __builtin_amdgcn_exp2f(-LOG2E * fabsf(z)), t = 1.0f + em;
                            const float sg = (z >= 0.f ? 1.0f : em) * __builtin_amdgcn_rcpf(t), ls = fminf(z, 0.f) - 0.6931471805599453f * __builtin_amdgcn_logf(t);
                            if (fq < 3) gn[(size_t)r * 24 + fq * 8 + n * 4 + i] = sg;
                            else lf[(size_t)r * 8 + n * 4 + i] = ls; }
                }
        }
    }
};
struct EpiSlab {
    static constexpr bool WAITS_ON_READS = false;
    float* slab;
    __device__ __forceinline__ void operator()(f32x4 (&acc)[2][2][4][2], const Unit& u, int wr, int wc, int fr, int fq) const {
        float* base = slab + (size_t)u.aux * 2048 * 256;
#pragma unroll
        for (int ai = 0; ai < 2; ++ai)
#pragma unroll
            for (int m = 0; m < 4; ++m) { const int r = u.pm * 256 + ai * 128 + wr * 64 + m * 16 + fr;
#pragma unroll
                for (int bj = 0; bj < 2; ++bj) { float* d = base + (size_t)r * 256 + bj * 128 + wc * 32 + fq * 8; *(f32x4*)d = acc[ai][bj][m][0]; *(f32x4*)(d + 4) = acc[ai][bj][m][1]; } }
    }
};
__device__ __forceinline__ u32x4 ldg16(const void* base, unsigned off) { return *(const u32x4*)((const char*)base + off); }
__device__ __forceinline__ f32x4 ldg16f(const void* base, unsigned off) { return *(const f32x4*)((const char*)base + off); }
struct EpiMerge {
    static constexpr bool WAITS_ON_READS = true;
    const unsigned char* gate_r; const unsigned char* gate_b; unsigned char* merged;
    __device__ __forceinline__ void operator()(f32x4 (&acc)[2][2][4][2], const Unit& u, int wr, int wc, int fr, int fq) const {
        const unsigned char* g = u.aux ? gate_b : gate_r;
        const unsigned r0 = (unsigned)(u.pm * 256 + wr * 64 + fr), c0 = (unsigned)(u.pn * 256 + wc * 32 + fq * 8);
        const unsigned o8 = r0 * 2048u + c0;
        u32x2 gv[2][4][2];
#pragma unroll
        for (int ai = 0; ai < 2; ++ai)
#pragma unroll
            for (int m = 0; m < 4; ++m)
#pragma unroll
                for (int bj = 0; bj < 2; ++bj) gv[ai][m][bj] = *(const u32x2*)(g + (o8 + (unsigned)((ai * 128 + m * 16) * 2048 + bj * 128)));
        if (u.aux) {
            const float fs = SC_M / (SC_O * SC_WUP * 256.0f);
#pragma unroll
            for (int ai = 0; ai < 2; ++ai)
#pragma unroll
                for (int m = 0; m < 4; ++m)
#pragma unroll
                    for (int bj = 0; bj < 2; ++bj) { u32x2 v = gv[ai][m][bj]; asm volatile("" : "+v"(v));
                        const f32x2 g0 = __builtin_amdgcn_cvt_pk_f32_fp8((int)v.x, false), g1 = __builtin_amdgcn_cvt_pk_f32_fp8((int)v.x, true), g2 = __builtin_amdgcn_cvt_pk_f32_fp8((int)v.y, false), g3 = __builtin_amdgcn_cvt_pk_f32_fp8((int)v.y, true);
                        const f32x4 a0 = acc[ai][bj][m][0] * fs, a1 = acc[ai][bj][m][1] * fs;
                        *(u32x2*)(merged + (o8 + (unsigned)((ai * 128 + m * 16) * 2048 + bj * 128))) = (u32x2){pack_fp8x4(a0[0] * g0[0], a0[1] * g0[1], a0[2] * g1[0], a0[3] * g1[1]), pack_fp8x4(a1[0] * g2[0], a1[1] * g2[1], a1[2] * g3[0], a1[3] * g3[1])}; }
        } else {
#pragma unroll
            for (int ai = 0; ai < 2; ++ai)
#pragma unroll
                for (int m = 0; m < 4; ++m)
#pragma unroll
                    for (int bj = 0; bj < 2; ++bj) { u32x2 v = gv[ai][m][bj]; asm volatile("" : "+v"(v));
                        const f32x2 g0 = __builtin_amdgcn_cvt_pk_f32_fp8((int)v.x, false), g1 = __builtin_amdgcn_cvt_pk_f32_fp8((int)v.x, true), g2 = __builtin_amdgcn_cvt_pk_f32_fp8((int)v.y, false), g3 = __builtin_amdgcn_cvt_pk_f32_fp8((int)v.y, true);
                        acc[ai][bj][m][0] *= (f32x4){g0[0], g0[1], g1[0], g1[1]}; acc[ai][bj][m][1] *= (f32x4){g2[0], g2[1], g3[0], g3[1]}; }
        }
    }
};
struct EpiOut {
    static constexpr bool WAITS_ON_READS = true;
    const float* x; float* x1; bf16_t* x1b; float* ssq2;
    __device__ __forceinline__ void operator()(f32x4 (&acc)[2][2][4][2], const Unit& u, int wr, int wc, int fr, int fq) const {
        const unsigned r0 = (unsigned)(u.pm * 256 + wr * 64 + fr), c0 = (unsigned)(u.pn * 256 + wc * 32 + fq * 8);
        const unsigned ox = r0 * 8192u + c0 * 4u, ob = r0 * 4096u + c0 * 2u, os = (r0 * 64u + (unsigned)(u.pn * 8 + wc)) * 4u;
#pragma unroll
        for (int ai = 0; ai < 2; ++ai) {
            f32x4 xv[4][2][2];
#pragma unroll
            for (int m = 0; m < 4; ++m)
#pragma unroll
                for (int bj = 0; bj < 2; ++bj) { const unsigned o = ox + (unsigned)((ai * 128 + m * 16) * 8192 + bj * 512); xv[m][bj][0] = ldg16f(x, o); xv[m][bj][1] = ldg16f(x, o + 16u); }
#pragma unroll
            for (int m = 0; m < 4; ++m) {
#pragma unroll
                for (int bj = 0; bj < 2; ++bj) {
                    const f32x4 v0 = xv[m][bj][0] + acc[ai][bj][m][0] * (1.0f / (SC_M * SC_WOUT)), v1 = xv[m][bj][1] + acc[ai][bj][m][1] * (1.0f / (SC_M * SC_WOUT));
                    u32x4 w; w.x = cvtpk(v0[0], v0[1]); w.y = cvtpk(v0[2], v0[3]); w.z = cvtpk(v1[0], v1[1]); w.w = cvtpk(v1[2], v1[3]);
                    *(u32x4*)((char*)x1b + (ob + (unsigned)((ai * 128 + m * 16) * 4096 + bj * 256))) = w;
                    float s = v0[0] * v0[0] + v0[1] * v0[1] + v0[2] * v0[2] + v0[3] * v0[3] + v1[0] * v1[0] + v1[1] * v1[1] + v1[2] * v1[2] + v1[3] * v1[3];
                    s = swap32_sum(swap16_sum(s));
                    if (fq == 0) *(float*)((char*)ssq2 + (os + (unsigned)((ai * 128 + m * 16) * 256 + bj * 16))) = s; } }
        }
    }
};
struct EpiPeerQ {
    static constexpr bool WAITS_ON_READS = true;
    const float* ssq2; bf16_t* qp;
    __device__ __forceinline__ void operator()(f32x4 (&acc)[2][2][4][2], const Unit& u, int wr, int wc, int fr, int fq) const {
        const unsigned r0 = (unsigned)(u.pm * 256 + wr * 64 + fr), c0 = (unsigned)(u.pn * 256 + wc * 32 + fq * 8);
        const unsigned os = r0 * 256u + (unsigned)fq * 64u, ob = r0 * 4096u + c0 * 2u;
#pragma unroll
        for (int ai = 0; ai < 2; ++ai) {
            f32x4 t4[4][4];
#pragma unroll
            for (int m = 0; m < 4; ++m)
#pragma unroll
                for (int k = 0; k < 4; ++k) t4[m][k] = ldg16f(ssq2, os + (unsigned)((ai * 128 + m * 16) * 256 + k * 16));
#pragma unroll
            for (int m = 0; m < 4; ++m) {
                const f32x4 t = t4[m][0] + t4[m][1] + t4[m][2] + t4[m][3];
                float s = t[0] + t[1] + t[2] + t[3]; s = swap32_sum(swap16_sum(s));
                const float rs = __builtin_amdgcn_rsqf(s * (1.0f / 2048.0f) + NORM_EPS);
#pragma unroll
                for (int bj = 0; bj < 2; ++bj) { const f32x4 a0 = acc[ai][bj][m][0] * rs, a1 = acc[ai][bj][m][1] * rs;
                    u32x4 w; w.x = cvtpk(a0[0], a0[1]); w.y = cvtpk(a0[2], a0[3]); w.z = cvtpk(a1[0], a1[1]); w.w = cvtpk(a1[2], a1[3]);
                    *(u32x4*)((char*)qp + (ob + (unsigned)((ai * 128 + m * 16) * 4096 + bj * 256))) = w; } }
        }
    }
};
constexpr int SHM_K = 64 * 128 * 2, SHM_V = 64 * 128 * 2;
#define KSWZ(row, colB) ((row) * 256 + ((colB) ^ (((row) & 7) << 4)))
#define SBAR() __builtin_amdgcn_sched_barrier(0)
__device__ __forceinline__ int v_st(int k, int c) { const int kk = (k & ~0xC) | ((k & 4) << 1) | ((k & 8) >> 1); return ((kk >> 3) * 4 + (c >> 5)) * 512 + ((kk & 7) * 32 + (c & 31)) * 2; }
__device__ __forceinline__ int v_rd_base(int lane) { return ((lane & 3) << 3) | (((lane >> 2) & 3) << 6) | (((lane >> 4) & 1) << 5) | (((lane >> 5) & 1) << 8); }
constexpr int v_rd_off(int d0, int ks, int half) { return d0 * 512 + ks * 4096 + half * 2048; }
__device__ __forceinline__ int crow(int r, int hi) { return (r & 3) + 8 * (r >> 2) + 4 * hi; }

__device__ __forceinline__ void qkt(f32x16& p0, f32x16& p1, const char* Kt, int r32, int hi, const bf16x8* qr) {
    p0 = f32x16{}; p1 = f32x16{};
    const char* kb[4];
#pragma unroll
    for (int dd = 0; dd < 4; ++dd) kb[dd] = Kt + KSWZ(r32, (dd * 16 + hi * 8) * 2);
#pragma unroll
    for (int d0 = 0; d0 < 8; ++d0) { const char* a = kb[d0 & 3] + (d0 >> 2) * 128;
        const bf16x8 b0 = *reinterpret_cast<const bf16x8*>(a);
        const bf16x8 b1 = *reinterpret_cast<const bf16x8*>(a + 32 * 256);
        p0 = __builtin_amdgcn_mfma_f32_32x32x16_bf16(b0, qr[d0], p0, 0, 0, 0);
        p1 = __builtin_amdgcn_mfma_f32_32x32x16_bf16(b1, qr[d0], p1, 0, 0, 0); }
}
__device__ __forceinline__ void pv_tile(f32x16* o, int vb0, bf16x8 pa0, bf16x8 pa1, bf16x8 pa2, bf16x8 pa3) {
#define TRRD(dst, off) asm volatile("ds_read_b64_tr_b16 %0, %1 offset:%2" : "=&v"(dst) : "v"(vb0), "i"(off) : "memory")
#define PV_D0(d0) do { s16x4 l0, l1, l2, l3, h0, h1, h2, h3; constexpr int b_ = v_rd_off(d0, 0, 0); \
        TRRD(l0, b_); TRRD(h0, b_ + 2048); TRRD(l1, b_ + 4096); TRRD(h1, b_ + 6144); TRRD(l2, b_ + 8192); TRRD(h2, b_ + 10240); TRRD(l3, b_ + 12288); TRRD(h3, b_ + 14336); \
        asm volatile("s_waitcnt lgkmcnt(0)" ::: "memory"); SBAR(); \
        o[d0] = __builtin_amdgcn_mfma_f32_32x32x16_bf16(pa0, (bf16x8){l0[0], l0[1], l0[2], l0[3], h0[0], h0[1], h0[2], h0[3]}, o[d0], 0, 0, 0); \
        o[d0] = __builtin_amdgcn_mfma_f32_32x32x16_bf16(pa1, (bf16x8){l1[0], l1[1], l1[2], l1[3], h1[0], h1[1], h1[2], h1[3]}, o[d0], 0, 0, 0); \
        o[d0] = __builtin_amdgcn_mfma_f32_32x32x16_bf16(pa2, (bf16x8){l2[0], l2[1], l2[2], l2[3], h2[0], h2[1], h2[2], h2[3]}, o[d0], 0, 0, 0); \
        o[d0] = __builtin_amdgcn_mfma_f32_32x32x16_bf16(pa3, (bf16x8){l3[0], l3[1], l3[2], l3[3], h3[0], h3[1], h3[2], h3[3]}, o[d0], 0, 0, 0); } while (0)
    PV_D0(0); PV_D0(1); PV_D0(2); PV_D0(3);
#undef PV_D0
#undef TRRD
}
__device__ __forceinline__ void pack_p(const f32x16& p0, const f32x16& p1, bf16x8& pa0, bf16x8& pa1, bf16x8& pa2, bf16x8& pa3) {
#define PK4(P, B_, OUT) do { unsigned a0 = cvtpk(P[B_+0], P[B_+1]), a1 = cvtpk(P[B_+2], P[B_+3]); unsigned b0 = cvtpk(P[B_+4], P[B_+5]), b1 = cvtpk(P[B_+6], P[B_+7]); \
        auto r0 = __builtin_amdgcn_permlane32_swap(a0, b0, false, false); auto r1 = __builtin_amdgcn_permlane32_swap(a1, b1, false, false); \
        u32x4 w = {r0[0], r1[0], r0[1], r1[1]}; OUT = *reinterpret_cast<bf16x8*>(&w); } while (0)
    PK4(p0, 0, pa0); PK4(p0, 8, pa1); PK4(p1, 0, pa2); PK4(p1, 8, pa3);
#undef PK4
}
__device__ __forceinline__ float pair_max(float v) { auto rr = __builtin_amdgcn_permlane32_swap(__float_as_uint(v), __float_as_uint(v), false, false); return fmaxf(__uint_as_float(rr[0]), __uint_as_float(rr[1])); }
__device__ __forceinline__ float pair_sum(float v) { auto rr = __builtin_amdgcn_permlane32_swap(__float_as_uint(v), __float_as_uint(v), false, false); return __uint_as_float(rr[0]) + __uint_as_float(rr[1]); }

struct Stage { bf16x8 k0, k1, v0, v1; };
__device__ __forceinline__ void stage_load(Stage& s, const bf16_t* Kg, const bf16_t* Vg, int tid) {
    const int sr = tid >> 4, sc = (tid & 15) * 8;
    s.k0 = *(const bf16x8*)(Kg + (size_t)sr * 128 + sc); s.k1 = *(const bf16x8*)(Kg + (size_t)(32 + sr) * 128 + sc);
    s.v0 = *(const bf16x8*)(Vg + (size_t)sr * 128 + sc); s.v1 = *(const bf16x8*)(Vg + (size_t)(32 + sr) * 128 + sc);
}
__device__ __forceinline__ void stage_write(const Stage& s, char* Kt, char* Vt, int tid) {
    const int sr = tid >> 4, sc = (tid & 15) * 8, kws = KSWZ(sr, sc * 2);
    *(bf16x8*)(Kt + kws) = s.k0; *(bf16x8*)(Kt + kws + 32 * 256) = s.k1;
    *(bf16x8*)(Vt + v_st(sr, sc)) = s.v0; *(bf16x8*)(Vt + v_st(32 + sr, sc)) = s.v1;
}

constexpr int ATT_LDS_WS = 2 * SHM_V + 2 * SHM_K;
constexpr int ATT_LDS_X = ATT_LDS_WS + 8 * 64 * 4;

__device__ __forceinline__ void stage_glds(const bf16_t* Kg, const bf16_t* Vg, char* Kt, char* Vt, int tid, int wid) {
#pragma unroll
    for (int i = 0; i < 2; ++i) {
        const int L = i * 512 + tid;
        const int krow = L >> 4, kch = (L & 15) ^ (krow & 7);
        __builtin_amdgcn_global_load_lds((const unsigned*)(Kg + krow * 128 + kch * 8), (LAS unsigned*)(Kt + (i * 512 + wid * 64) * 16), 16, 0, 0);
        const int sub = L >> 5, within = L & 31, kk = (sub >> 2) * 8 + (within >> 2), c = (sub & 3) * 32 + (within & 3) * 8;
        const int k = (kk & ~0xC) | ((kk & 4) << 1) | ((kk & 8) >> 1);
        __builtin_amdgcn_global_load_lds((const unsigned*)(Vg + k * 128 + c), (LAS unsigned*)(Vt + (i * 512 + wid * 64) * 16), 16, 0, 0);
    }
}

__device__ __forceinline__ void stage_glds_one(const bf16_t* G, char* T, int tid, int wid, bool isK) {
#pragma unroll
    for (int i = 0; i < 2; ++i) {
        const int L = i * 512 + tid;
        if (isK) { const int krow = L >> 4, kch = (L & 15) ^ (krow & 7);
            __builtin_amdgcn_global_load_lds((const unsigned*)(G + krow * 128 + kch * 8), (LAS unsigned*)(T + (i * 512 + wid * 64) * 16), 16, 0, 0); }
        else { const int sub = L >> 5, within = L & 31, kk = (sub >> 2) * 8 + (within >> 2), c = (sub & 3) * 32 + (within & 3) * 8; const int k = (kk & ~0xC) | ((kk & 4) << 1) | ((kk & 8) >> 1);
            __builtin_amdgcn_global_load_lds((const unsigned*)(G + k * 128 + c), (LAS unsigned*)(T + (i * 512 + wid * 64) * 16), 16, 0, 0); }
    }
}

template <int MODE>
__device__ __forceinline__ void attn_pass(const bf16_t* Kg, const bf16_t* Vg, int j_lo, int j_hi, const bf16x8* qr, f32x16* o, float& l_reg,
                                          char* lds, int tpos  , unsigned selm, const float* kbias_lds) {
    int tid = threadIdx.x; asm volatile("" : "+v"(tid));
    const int wid = __builtin_amdgcn_readfirstlane(tid >> 6), lane = tid & 63, r32 = lane & 31, hi = lane >> 5;
    char* V_lds = lds; char* K_lds = lds + 2 * SHM_V;
    float* wsf = (float*)(lds + ATT_LDS_WS) + wid * 64;
    constexpr float C2 = LOG2E * ATT_SCALE;
    float m_reg = -1e30f; l_reg = 0.f;
#pragma unroll
    for (int d = 0; d < 4; ++d) o[d] = f32x16{};
    const int vbase = (int)(uintptr_t)V_lds + v_rd_base(lane);
    const int NT = j_hi - j_lo;
    const int wq_lo = __builtin_amdgcn_readfirstlane(tpos - r32);
#define ATT_ACT(j_) (MODE == 2 ? ((j_) * 64 <= wq_lo + 31) : (MODE == 1 ? (((j_) * 64 <= wq_lo + 31) && ((j_) * 64 + 63 >= wq_lo - 511)) : true))
    __syncthreads();
    {
        const bf16_t* K0 = Kg + (size_t)j_lo * 64 * 128; const bf16_t* V0 = Vg + (size_t)j_lo * 64 * 128;
        stage_glds(K0, V0, K_lds, V_lds, tid, wid);
        if (NT > 1) stage_glds_one(K0 + 64 * 128, K_lds + SHM_K, tid, wid, true);
    }
    asm volatile("s_waitcnt vmcnt(0)" ::: "memory");
    __syncthreads();
    f32x16 pc0, pc1;
    if (ATT_ACT(j_lo)) qkt(pc0, pc1, K_lds, r32, hi, qr);
    __syncthreads();
#pragma unroll 1
    for (int t = 0; t < NT; ++t) {
        const int j = j_lo + t, kb = j * 64;
        if (t + 2 < NT) stage_glds_one(Kg + (size_t)(j + 2) * 64 * 128, K_lds + (t & 1) * SHM_K, tid, wid, true);
        if (t + 1 < NT) stage_glds_one(Vg + (size_t)(j + 1) * 64 * 128, V_lds + ((t + 1) & 1) * SHM_V, tid, wid, false);
        f32x16 pn0, pn1;
        const bool needm_c = MODE == 1 ? (kb + 63 > wq_lo || kb <= wq_lo + 31 - 512) : (kb + 63 > wq_lo);
        const bool fused = (t + 1 < NT) && ATT_ACT(j + 1) && ATT_ACT(j) && !needm_c;
        if (!fused && t + 1 < NT && ATT_ACT(j + 1)) qkt(pn0, pn1, K_lds + ((t + 1) & 1) * SHM_K, r32, hi, qr);
        if (ATT_ACT(j)) {
            f32x16 p0 = pc0, p1 = pc1;
            const float NEG = -__builtin_inff();
            const int dq = tpos - kb - 4 * hi;
            const bool needm = needm_c;
            float mn, alpha, ps = 0.f;
            if (fused) {
                const char* Kn = K_lds + ((t + 1) & 1) * SHM_K;
                const char* kbp_[4];
#pragma unroll
                for (int dd = 0; dd < 4; ++dd) kbp_[dd] = Kn + KSWZ(r32, (dd * 16 + hi * 8) * 2);
                pn0 = f32x16{}; pn1 = f32x16{};
#define ATT_QK2(D0) do { _Pragma("unroll") for (int d0 = (D0); d0 < (D0) + 2; ++d0) { const char* a_ = kbp_[d0 & 3] + (d0 >> 2) * 128; \
                    const bf16x8 b0_ = *reinterpret_cast<const bf16x8*>(a_); const bf16x8 b1_ = *reinterpret_cast<const bf16x8*>(a_ + 32 * 256); \
                    pn0 = __builtin_amdgcn_mfma_f32_32x32x16_bf16(b0_, qr[d0], pn0, 0, 0, 0); pn1 = __builtin_amdgcn_mfma_f32_32x32x16_bf16(b1_, qr[d0], pn1, 0, 0, 0); } } while (0)
                const float lanebias = (MODE == 0 && !((selm >> j) & 1u)) ? NEG : 0.f;
                float pmax;
                ATT_QK2(0);
                if (MODE == 2) { const float* kbq = kbias_lds + kb + 4 * hi;
#pragma unroll
                    for (int g = 0; g < 4; ++g) { const f32x4 b0 = *(const f32x4*)(kbq + 8 * g), b1 = *(const f32x4*)(kbq + 32 + 8 * g);
#pragma unroll
                        for (int i = 0; i < 4; ++i) { p0[4 * g + i] = fmaf(p0[4 * g + i], C2, b0[i]); p1[4 * g + i] = fmaf(p1[4 * g + i], C2, b1[i]); } } }
                pmax = p0[0];
#pragma unroll
                for (int r = 1; r < 16; ++r) pmax = fmaxf(pmax, p0[r]);
                SBAR();
                ATT_QK2(2);
#pragma unroll
                for (int r = 0; r < 16; ++r) pmax = fmaxf(pmax, p1[r]);
                pmax = pair_max(pmax);
                if (MODE != 2) pmax = pmax * C2 + lanebias;
                mn = fmaxf(m_reg, pmax); alpha = __builtin_amdgcn_exp2f(m_reg - mn); m_reg = mn;
                const float nb = lanebias - mn;
                SBAR();
                ATT_QK2(4);
#pragma unroll
                for (int r = 0; r < 16; ++r) { p0[r] = MODE == 2 ? __builtin_amdgcn_exp2f(p0[r] - mn) : __builtin_amdgcn_exp2f(fmaf(p0[r], C2, nb)); ps += p0[r]; }
                SBAR();
                ATT_QK2(6);
#pragma unroll
                for (int r = 0; r < 16; ++r) { p1[r] = MODE == 2 ? __builtin_amdgcn_exp2f(p1[r] - mn) : __builtin_amdgcn_exp2f(fmaf(p1[r], C2, nb)); ps += p1[r]; }
                SBAR();
#undef ATT_QK2
            } else if (MODE != 2 && !needm) {
                const float lanebias = (MODE == 0 && !((selm >> j) & 1u)) ? NEG : 0.f;
                float pmax = p0[0];
#pragma unroll
                for (int r = 1; r < 16; ++r) pmax = fmaxf(pmax, p0[r]);
#pragma unroll
                for (int r = 0; r < 16; ++r) pmax = fmaxf(pmax, p1[r]);
                pmax = pair_max(pmax) * C2 + lanebias;
                mn = fmaxf(m_reg, pmax); alpha = __builtin_amdgcn_exp2f(m_reg - mn); m_reg = mn;
                const float nb = lanebias - mn;
#pragma unroll
                for (int r = 0; r < 16; ++r) { p0[r] = __builtin_amdgcn_exp2f(fmaf(p0[r], C2, nb)); p1[r] = __builtin_amdgcn_exp2f(fmaf(p1[r], C2, nb)); ps += p0[r] + p1[r]; }
            } else {
                if (MODE == 2) {
                    const float* kbp = kbias_lds + kb + 4 * hi;
#pragma unroll
                    for (int g = 0; g < 4; ++g) { const f32x4 b0 = *(const f32x4*)(kbp + 8 * g), b1 = *(const f32x4*)(kbp + 32 + 8 * g);
#pragma unroll
                        for (int i = 0; i < 4; ++i) { p0[4 * g + i] = fmaf(p0[4 * g + i], C2, b0[i]); p1[4 * g + i] = fmaf(p1[4 * g + i], C2, b1[i]); } }
                } else {
#pragma unroll
                    for (int r = 0; r < 16; ++r) { p0[r] *= C2; p1[r] *= C2; }
                }
                if (needm) {
                    const bool sel = MODE == 0 ? ((selm >> j) & 1u) != 0u : true;
                    const unsigned W = MODE == 1 ? 512u : 0x7fffffffu;
#pragma unroll
                    for (int r = 0; r < 16; ++r) { const int c = (r & 3) + 8 * (r >> 2); if (!sel || (unsigned)(dq - c) >= W) p0[r] = NEG; if (!sel || (unsigned)(dq - c - 32) >= W) p1[r] = NEG; }
                }
                float pmax = p0[0];
#pragma unroll
                for (int r = 1; r < 16; ++r) pmax = fmaxf(pmax, p0[r]);
#pragma unroll
                for (int r = 0; r < 16; ++r) pmax = fmaxf(pmax, p1[r]);
                pmax = pair_max(pmax);
                mn = fmaxf(m_reg, pmax); alpha = __builtin_amdgcn_exp2f(m_reg - mn); m_reg = mn;
#pragma unroll
                for (int r = 0; r < 16; ++r) { p0[r] = __builtin_amdgcn_exp2f(p0[r] - mn); p1[r] = __builtin_amdgcn_exp2f(p1[r] - mn); ps += p0[r] + p1[r]; }
            }
            ps = pair_sum(ps);
            l_reg = l_reg * alpha + ps;
            if (__any(alpha < 1.f)) {
                if (hi == 0) wsf[r32] = alpha;
                asm volatile("s_waitcnt lgkmcnt(0)" ::: "memory");
#pragma unroll
                for (int r = 0; r < 16; ++r) { const float a = wsf[crow(r, hi)];
#pragma unroll
                    for (int d = 0; d < 4; ++d) o[d][r] *= a; }
            }
            bf16x8 pa0, pa1, pa2, pa3;
            pack_p(p0, p1, pa0, pa1, pa2, pa3);
            pv_tile(o, vbase + (t & 1) * SHM_V, pa0, pa1, pa2, pa3);
        }
        pc0 = pn0; pc1 = pn1;
        asm volatile("s_waitcnt vmcnt(0)" ::: "memory");
        __syncthreads();
    }
#undef ATT_ACT
}

template <bool ADD, bool OUT8>
__device__ __forceinline__ void store_o(const f32x16* o, float fac, void* basev, size_t row_stride  , const bf16_t* addend, size_t add_stride, char* lds, int wid, int lane) {
    asm volatile("" : "+v"(lane));
    const int r32 = lane & 31, hi = lane >> 5;
    float* wsf = (float*)(lds + ATT_LDS_WS) + wid * 64;
    char* ot = lds + wid * 8192;
    __builtin_amdgcn_wave_barrier();
    if (hi == 0) wsf[r32] = fac;
    asm volatile("s_waitcnt lgkmcnt(0)" ::: "memory");
    __builtin_amdgcn_wave_barrier();
#pragma unroll
    for (int r = 0; r < 16; ++r) { const int orow = crow(r, hi); const float f = wsf[orow];
#pragma unroll
        for (int d0 = 0; d0 < 4; ++d0) *(bf16_t*)(ot + orow * 256 + (d0 * 32 + r32) * 2) = (bf16_t)(cvtpk(o[d0][r] * f, 0.f) & 0xffffu); }
    asm volatile("s_waitcnt lgkmcnt(0)" ::: "memory");
    __builtin_amdgcn_wave_barrier();
    if constexpr (OUT8) {
        unsigned char* base = (unsigned char*)basev;
        const int rr = lane >> 3, ch = lane & 7;
        u32x4 ad[4][2];
        if (ADD) {
#pragma unroll
            for (int i = 0; i < 4; ++i) { const bf16_t* ap = addend + (size_t)(i * 8 + rr) * add_stride + ch * 16; ad[i][0] = *(const u32x4*)ap; ad[i][1] = *(const u32x4*)(ap + 8); } }
#pragma unroll
        for (int i = 0; i < 4; ++i) {
            const u32x4 v0 = *(const u32x4*)(ot + (i * 8 + rr) * 256 + ch * 32), v1 = *(const u32x4*)(ot + (i * 8 + rr) * 256 + ch * 32 + 16);
            float f[16];
#pragma unroll
            for (int q = 0; q < 4; ++q) { f[2 * q] = bf_lo(v0[q]); f[2 * q + 1] = bf_hi(v0[q]); f[8 + 2 * q] = bf_lo(v1[q]); f[8 + 2 * q + 1] = bf_hi(v1[q]); }
            if (ADD) { const u32x4 a0 = ad[i][0], a1 = ad[i][1];
#pragma unroll
                for (int q = 0; q < 4; ++q) { f[2 * q] += bf_lo(a0[q]); f[2 * q + 1] += bf_hi(a0[q]); f[8 + 2 * q] += bf_lo(a1[q]); f[8 + 2 * q + 1] += bf_hi(a1[q]); } }
            u32x4 w;
#pragma unroll
            for (int q = 0; q < 4; ++q) w[q] = pack_fp8x4(f[4 * q] * SC_O, f[4 * q + 1] * SC_O, f[4 * q + 2] * SC_O, f[4 * q + 3] * SC_O);
            *(u32x4*)(base + (size_t)(i * 8 + rr) * row_stride + ch * 16) = w; }
    } else {
        bf16_t* base = (bf16_t*)basev;
        const int rr = lane >> 4, ch = lane & 15;
        bf16_t* gp = base + (size_t)rr * row_stride + ch * 8;
        const bf16_t* ap = ADD ? addend + (size_t)rr * add_stride + ch * 8 : nullptr;
        u32x4 ad[8];
        if (ADD) {
#pragma unroll
            for (int i = 0; i < 8; ++i) ad[i] = *(const u32x4*)(ap + (size_t)(i * 4) * add_stride); }
#pragma unroll
        for (int i = 0; i < 8; ++i) {
            u32x4 v = *(const u32x4*)(ot + (i * 4 + rr) * 256 + ch * 16);
            if (ADD) { const u32x4 a = ad[i];
                v.x = cvtpk(bf_lo(v.x) + bf_lo(a.x), bf_hi(v.x) + bf_hi(a.x)); v.y = cvtpk(bf_lo(v.y) + bf_lo(a.y), bf_hi(v.y) + bf_hi(a.y));
                v.z = cvtpk(bf_lo(v.z) + bf_lo(a.z), bf_hi(v.z) + bf_hi(a.z)); v.w = cvtpk(bf_lo(v.w) + bf_lo(a.w), bf_hi(v.w) + bf_hi(a.w)); }
            *(u32x4*)(gp + (size_t)(i * 4) * row_stride) = v; }
    }
    __builtin_amdgcn_wave_barrier();
}

__device__ __forceinline__ void fox_cumsum(const Params& p, int first_block) {
    const int tid = tid_opaque(), wid = tid >> 6, lane = tid & 63;
    {
        const int which = (int)blockIdx.x - first_block - 8;
        if ((which == 0 || which == 1) && tid < 256) { const float* b1p = (const float*)(p.ws + OFF_MISC + M_B1P); float t = 0.f;
            for (int part = 0; part < 64; ++part) t += b1p[(which * 64 + part) * 256 + tid];
            ((float*)(p.ws + OFF_MISC + M_B1))[which * 256 + tid] = t; }
    }
    const int seq = ((int)blockIdx.x - first_block) * 8 + wid;
    if (seq < 0 || seq >= 64) return;
    const int b = seq >> 3, h = seq & 7;
    const float* lf = (const float*)(p.ws + OFF_MISC + M_LOGF); float* cf = (float*)(p.ws + OFF_MISC + M_CFOX);
    float v[32]; float run = 0.f;
#pragma unroll
    for (int i = 0; i < 32; ++i) { run += lf[(size_t)(b * 2048 + lane * 32 + i) * 8 + h]; v[i] = run; }
    float incl = run;
#pragma unroll
    for (int o = 1; o < 64; o <<= 1) { const float t = __shfl_up(incl, o); if (lane >= o) incl += t; }
    const float excl = incl - run;
#pragma unroll
    for (int i = 0; i < 32; ++i) cf[(size_t)(b * 8 + h) * 2048 + lane * 32 + i] = -(v[i] + excl) * LOG2E;
}

__device__ __forceinline__ void phase_cmp2(const Params& p, unsigned char* lds_raw) {
    const int tid = tid_opaque(), wid = tid >> 6, lane = tid & 63;
    float* hbuf = (float*)lds_raw + wid * 512;
    const float* slab = (const float*)(p.ws + OFF_XB); const float* b1p = (const float*)(p.ws + OFF_MISC + M_B1);
    const f32x2* cs = (const f32x2*)(p.ws + OFF_MISC + M_ROPE);
    bf16_t* kcvc = (bf16_t*)(p.ws + OFF_KCVC);
    for (int job = blockIdx.x * 8 + wid; job < 2048; job += gridDim.x * 8) {
        const int which = job >> 10, m0 = (job & 1023) * 2;
        f32x4 acc[2] = {{0.f, 0.f, 0.f, 0.f}, {0.f, 0.f, 0.f, 0.f}};
#pragma unroll
        for (int rr = 0; rr < 2; ++rr)
#pragma unroll
            for (int s = 0; s < 8; ++s) acc[rr] += *(const f32x4*)(slab + ((size_t)(which * 8 + s) * 2048 + m0 + rr) * 256 + lane * 4);
        const f32x4 bb = *(const f32x4*)(b1p + which * 256 + lane * 4);
        __builtin_amdgcn_wave_barrier();
#pragma unroll
        for (int rr = 0; rr < 2; ++rr) { const f32x4 a = acc[rr] + bb; *(f32x4*)(hbuf + rr * 256 + lane * 4) = (f32x4){gelu_tanh(a[0]), gelu_tanh(a[1]), gelu_tanh(a[2]), gelu_tanh(a[3])}; }
        asm volatile("s_waitcnt lgkmcnt(0)" ::: "memory");
        __builtin_amdgcn_wave_barrier();
        const float* w2 = p.in[which ? 11 : 8];
        float o1[2] = {0.f, 0.f}, o2[2] = {0.f, 0.f};
#pragma unroll 1
        for (int j0 = 0; j0 < 256; j0 += 32) {
            float wa[32], wb[32];
#pragma unroll
            for (int j = 0; j < 32; ++j) { wa[j] = w2[(j0 + j) * 128 + lane]; wb[j] = w2[(j0 + j) * 128 + 64 + lane]; }
#pragma unroll
            for (int j = 0; j < 32; ++j) { const float h0 = hbuf[j0 + j], h1 = hbuf[256 + j0 + j]; o1[0] = fmaf(h0, wa[j], o1[0]); o2[0] = fmaf(h0, wb[j], o2[0]); o1[1] = fmaf(h1, wa[j], o1[1]); o2[1] = fmaf(h1, wb[j], o2[1]); }
        }
#pragma unroll
        for (int rr = 0; rr < 2; ++rr) {
            const int m = m0 + rr, i = m & 127;
            bf16_t* dst = kcvc + (size_t)which * (2048 * 128) + (size_t)m * 128;
            if (i == 127) { *(unsigned*)(dst + lane * 2) = 0u; continue; }
            if (which == 0) {
                const f32x2 c = cs[(16 * i + 31) * 64 + lane]; const float y1 = o1[rr] * c[0] - o2[rr] * c[1], y2 = o2[rr] * c[0] + o1[rr] * c[1];
                const int q = lane >> 2, e = lane & 3;
                dst[8 * q + e] = (bf16_t)(cvtpk(y1, 0.f) & 0xffffu); dst[8 * q + 4 + e] = (bf16_t)(cvtpk(y2, 0.f) & 0xffffu);
            } else { dst[lane] = (bf16_t)(cvtpk(o1[rr], 0.f) & 0xffffu); dst[64 + lane] = (bf16_t)(cvtpk(o2[rr], 0.f) & 0xffffu); }
        }
        __builtin_amdgcn_wave_barrier();
    }
}
__device__ __forceinline__ void phase_cmp_attn(const Params& p, unsigned char* lds_raw) {
    char* lds = (char*)lds_raw;
    const int tid = tid_opaque(), wid = __builtin_amdgcn_readfirstlane(tid >> 6), lane = tid & 63, r32 = lane & 31, hi = lane >> 5;
    char* V_lds = lds; char* K_lds = lds + 2 * SHM_V;
    float* wsf = (float*)(lds + ATT_LDS_WS) + wid * 64;
    float* imp = (float*)(lds + ATT_LDS_X);
    const bf16_t* QN = (const bf16_t*)(p.ws + OFF_QN); const bf16_t* kcvc = (const bf16_t*)(p.ws + OFF_KCVC);
    const float* gn = (const float*)(p.ws + OFF_MISC + M_GN);
    bf16_t* ocg = (bf16_t*)(p.ws + OFF_WINT); unsigned* selmask = (unsigned*)(p.ws + OFF_SEL);
    constexpr float C2 = LOG2E * ATT_SCALE;
    const int vbase = (int)(uintptr_t)V_lds + v_rd_base(lane);
    for (int item = blockIdx.x; item < 512; item += gridDim.x) {
        const int bg = item >> 5, c = item & 31, b = bg >> 1, g = bg & 1;
        const int hg = wid >> 1, head = g * 4 + hg, tpos = c * 64 + (wid & 1) * 32 + r32, tok = b * 2048 + tpos;
        __syncthreads();
        { Stage st; const bf16_t* Kg = kcvc + (size_t)bg * 128 * 128; const bf16_t* Vg = kcvc + (size_t)(2048 * 128) + (size_t)bg * 128 * 128;
          stage_load(st, Kg, Vg, tid); stage_write(st, K_lds, V_lds, tid);
          stage_load(st, Kg + 64 * 128, Vg + 64 * 128, tid); stage_write(st, K_lds + SHM_K, V_lds + SHM_V, tid); }
        bf16x8 qr[8];
        { const bf16_t* qp = QN + ((size_t)(b * 8 + head) * 2048 + tpos) * 128 + hi * 8;
#pragma unroll
          for (int d0 = 0; d0 < 8; ++d0) qr[d0] = *(const bf16x8*)(qp + d0 * 16); }
        __syncthreads();
        f32x16 pA0, pA1, pB0, pB1;
        qkt(pA0, pA1, K_lds, r32, hi, qr);
        qkt(pB0, pB1, K_lds + SHM_K, r32, hi, qr);
        const int nvis = tpos >= 15 ? (tpos - 15) >> 4 : 0;
        const float NEG = -__builtin_inff();
        float mx = -1e30f;
#pragma unroll
        for (int r = 0; r < 16; ++r) { const int n = crow(r, hi);
            pA0[r] = n < nvis ? pA0[r] * C2 : NEG; pA1[r] = n + 32 < nvis ? pA1[r] * C2 : NEG; pB0[r] = n + 64 < nvis ? pB0[r] * C2 : NEG; pB1[r] = n + 96 < nvis ? pB1[r] * C2 : NEG;
            mx = fmaxf(fmaxf(mx, pA0[r]), fmaxf(pA1[r], fmaxf(pB0[r], pB1[r]))); }
        mx = pair_max(mx);
        float ps = 0.f;
#pragma unroll
        for (int r = 0; r < 16; ++r) { pA0[r] = __builtin_amdgcn_exp2f(pA0[r] - mx); pA1[r] = __builtin_amdgcn_exp2f(pA1[r] - mx); pB0[r] = __builtin_amdgcn_exp2f(pB0[r] - mx); pB1[r] = __builtin_amdgcn_exp2f(pB1[r] - mx);
            ps += (pA0[r] + pA1[r]) + (pB0[r] + pB1[r]); }
        ps = pair_sum(ps);
        const float rl = 1.0f / fmaxf(ps, 1e-30f);
        {
            float gs[16], lastv[16];
#pragma unroll
            for (int q = 0; q < 4; ++q) {
                gs[q] = (pA0[4 * q] + pA0[4 * q + 1]) + (pA0[4 * q + 2] + pA0[4 * q + 3]); lastv[q] = pA0[4 * q + 3];
                gs[4 + q] = (pA1[4 * q] + pA1[4 * q + 1]) + (pA1[4 * q + 2] + pA1[4 * q + 3]); lastv[4 + q] = pA1[4 * q + 3];
                gs[8 + q] = (pB0[4 * q] + pB0[4 * q + 1]) + (pB0[4 * q + 2] + pB0[4 * q + 3]); lastv[8 + q] = pB0[4 * q + 3];
                gs[12 + q] = (pB1[4 * q] + pB1[4 * q + 1]) + (pB1[4 * q + 2] + pB1[4 * q + 3]); lastv[12 + q] = pB1[4 * q + 3]; }
            float* myimp = imp + ((size_t)hg * 64 + (wid & 1) * 32 + r32) * 33;
#pragma unroll
            for (int idx = 0; idx < 16; ++idx) {
                const float other = xor32(lastv[idx], hi);
                const float other_prev = idx > 0 ? xor32(lastv[idx > 0 ? idx - 1 : 0], hi) : 0.f;
                const float prev = hi ? other : other_prev;
                myimp[2 * idx + hi] = (gs[idx] + prev) * rl;
            }
        }
        f32x16 o[4];
#pragma unroll
        for (int d = 0; d < 4; ++d) o[d] = f32x16{};
        { bf16x8 pa0, pa1, pa2, pa3; pack_p(pA0, pA1, pa0, pa1, pa2, pa3); pv_tile(o, vbase, pa0, pa1, pa2, pa3);
          pack_p(pB0, pB1, pa0, pa1, pa2, pa3); pv_tile(o, vbase + SHM_V, pa0, pa1, pa2, pa3); }
        const float gate = gn[(size_t)tok * 24 + head * 3 + 0];
        __syncthreads();
        store_o<false, false>(o, gate * rl, ocg + ((size_t)(b * 2048 + c * 64 + (wid & 1) * 32)) * 1024 + head * 128, 1024, nullptr, 0, lds, wid, lane);
        __syncthreads();
        if (tid < 64) {
            const int t = c * 64 + tid; float sc[32];
#pragma unroll
            for (int j = 0; j < 32; ++j) { const float v = ((imp[(0 * 64 + tid) * 33 + j] + imp[(1 * 64 + tid) * 33 + j]) + imp[(2 * 64 + tid) * 33 + j]) + imp[(3 * 64 + tid) * 33 + j];
                const bool forced = j == 0 || j == c || j == c - 1; const float x = j > c ? -1e30f : (forced ? 1e4f : v);
                sc[j] = __uint_as_float((__float_as_uint(x) & ~31u) | (unsigned)(x >= 0.f ? 31 - j : j)); }
            bitonic_sort_desc<32>(sc);
            unsigned mask = 0u;
#pragma unroll
            for (int k = 0; k < 16; ++k) { const unsigned u = __float_as_uint(sc[k]); const unsigned low = u & 31u; const int j = (int)((u >> 31) ? low : 31u - low); if (j <= c) mask |= 1u << j; }
            selmask[(size_t)bg * 2048 + t] = mask;
        }
    }
}

__device__ __forceinline__ void phase_attn(const Params& p, unsigned char* lds_raw) {
    char* lds = (char*)lds_raw;
    int* slot = (int*)(lds + ATT_LDS_X);
    unsigned* qctr = (unsigned*)(p.ws + OFF_MISC + M_CTL);
    const bf16_t* QN = (const bf16_t*)(p.ws + OFF_QN); const bf16_t* KV6 = (const bf16_t*)(p.ws + OFF_KV6); const bf16_t* QKVF = (const bf16_t*)(p.ws + OFF_QKVF);
    const float* gn = (const float*)(p.ws + OFF_MISC + M_GN); const float* cf = (const float*)(p.ws + OFF_MISC + M_CFOX);
    const unsigned* selmask = (const unsigned*)(p.ws + OFF_SEL);
    const bf16_t* ocg = (const bf16_t*)(p.ws + OFF_WINT); unsigned char* ocat = p.ws + OFF_XB  ; bf16_t* otmp = (bf16_t*)(p.ws + OFF_XB + 32 * MiB)  ;
    for (;;) {
        int tid = threadIdx.x; asm volatile("" : "+v"(tid));
        const int wid = __builtin_amdgcn_readfirstlane(tid >> 6), lane = tid & 63, r32 = lane & 31, hi = lane >> 5;
        __syncthreads();
        if (tid == 0) slot[0] = (int)atomicAdd(qctr, 1u);
        __syncthreads();
        const int it = slot[0];
        if (it >= 1024) break;
        f32x16 o[4]; float l_reg; bf16x8 qr[8];
        if (it < 512) {
            const int cb = 7 - (it >> 6), bh = it & 63, b = bh >> 3, h = bh & 7;
            const int tpos = cb * 256 + wid * 32 + r32;
            { const bf16_t* qp = QKVF + ((size_t)bh * 2048 + tpos) * 128 + hi * 8;
#pragma unroll
              for (int d0 = 0; d0 < 8; ++d0) qr[d0] = *(const bf16x8*)(qp + d0 * 16); }
            const bf16_t* Kg = QKVF + (size_t)(64 * 2048 * 128) + (size_t)bh * 2048 * 128; const bf16_t* Vg = QKVF + (size_t)2 * (64 * 2048 * 128) + (size_t)bh * 2048 * 128;
            float* kb_lds = (float*)(lds + ATT_LDS_X + 64);
            __syncthreads();
            *(f32x4*)(kb_lds + tid * 4) = *(const f32x4*)(cf + (size_t)bh * 2048 + tid * 4);
            attn_pass<2>(Kg, Vg, 0, cb * 4 + 4, qr, o, l_reg, lds, tpos, 0u, kb_lds);
            store_o<false, true>(o, 1.0f / l_reg, ocat + ((size_t)(b * 2048 + cb * 256 + wid * 32)) * 2048 + 1024 + h * 128, 2048, nullptr, 0, lds, wid, lane);
        } else {
            const int k = it - 512, c = 31 - (k >> 4), bg = k & 15, b = bg >> 1, g = bg & 1;
            const int hg = wid >> 1, head = g * 4 + hg, tpos = c * 64 + (wid & 1) * 32 + r32, tok = b * 2048 + tpos;
            { const bf16_t* qp = QN + ((size_t)(b * 8 + head) * 2048 + tpos) * 128 + hi * 8;
#pragma unroll
              for (int d0 = 0; d0 < 8; ++d0) qr[d0] = *(const bf16x8*)(qp + d0 * 16); }
            const unsigned selm = selmask[(size_t)bg * 2048 + tpos];
            const size_t kvh = (size_t)bg * 2048 * 128, kvs = (size_t)16 * 2048 * 128;
            unsigned char* orow = ocat + ((size_t)(b * 2048 + c * 64 + (wid & 1) * 32)) * 2048 + head * 128;
            bf16_t* trow = otmp + ((size_t)(b * 2048 + c * 64 + (wid & 1) * 32)) * 1024 + head * 128;
            attn_pass<0>(KV6 + 2 * kvs + kvh, KV6 + 3 * kvs + kvh, 0, c + 1, qr, o, l_reg, lds, tpos, selm, nullptr);
            store_o<true, false>(o, gn[(size_t)tok * 24 + head * 3 + 1] / l_reg, trow, 1024, ocg + ((size_t)(b * 2048 + c * 64 + (wid & 1) * 32)) * 1024 + head * 128, 1024, lds, wid, lane);
            attn_pass<1>(KV6 + 4 * kvs + kvh, KV6 + 5 * kvs + kvh, c >= 8 ? c - 8 : 0, c + 1, qr, o, l_reg, lds, tpos, 0u, nullptr);
            store_o<true, true>(o, gn[(size_t)tok * 24 + head * 3 + 2] / l_reg, orow, 2048, trow, 1024, lds, wid, lane);
        }
    }
}
__device__ __forceinline__ float pack_idx(float v, unsigned idx, unsigned mask) { return __uint_as_float((__float_as_uint(v) & ~mask) | idx); }
__device__ __forceinline__ void top16_of_tile(const f32x16& p0, const f32x16& p1, int hi, unsigned nbase, float (&res)[16]) {
    float g1[16];
#pragma unroll
    for (int r = 0; r < 16; ++r) { const unsigned n = nbase + (unsigned)crow(r, hi); res[r] = pack_idx(p0[r], n, 127u); g1[r] = pack_idx(p1[r], n + 32u, 127u); }
    bitonic_sort_desc<16>(res); bitonic_sort_desc<16>(g1);
    merge_top16(res, g1);
}
__device__ __forceinline__ void top16_of_128(const char* Kt, int r32, int hi, const bf16x8* qr, float (&res)[16]) {
    float t2[16];
    { f32x16 p0, p1; qkt(p0, p1, Kt, r32, hi, qr); top16_of_tile(p0, p1, hi, 0u, res); }
    SBAR();
    { f32x16 p0, p1; qkt(p0, p1, Kt + SHM_K, r32, hi, qr); top16_of_tile(p0, p1, hi, 64u, t2); }
    merge_top16(res, t2);
#pragma unroll
    for (int i = 0; i < 16; ++i) t2[i] = xor32(res[i], hi);
    merge_top16(res, t2);
    SBAR();
}
__device__ __forceinline__ float sel16(const float (&v)[16], int k) {
    float r = v[0];
#pragma unroll
    for (int i = 1; i < 16; ++i) r = (k == i) ? v[i] : r;
    return r;
}
__device__ __forceinline__ void phase_peer_topk(const Params& p, unsigned char* lds_raw) {
    char* lds = (char*)lds_raw;
    const int tid = tid_opaque(), wid = __builtin_amdgcn_readfirstlane(tid >> 6), lane = tid & 63, r32 = lane & 31, hi = lane >> 5;
    const bf16_t* K12 = (const bf16_t*)(p.ws + OFF_MISC + M_K12); const bf16_t* QP = (const bf16_t*)(p.ws + OFF_QKVF);
    int* eidx = (int*)(p.ws + OFF_EIDX); float* gsm = (float*)(p.ws + OFF_GSM);
    for (int item = blockIdx.x; item < 512; item += gridDim.x) {
        const int h = item & 7, tt = item >> 3;
        __syncthreads();
        {
            const int sr = tid >> 4, sc = (tid & 15) * 8, kws = KSWZ(sr, sc * 2);
#pragma unroll
            for (int q = 0; q < 4; ++q) { const bf16_t* src = K12 + (size_t)(q >> 1) * 131072 + (size_t)h * 16384 + (size_t)(q & 1) * 64 * 128;
                const bf16x8 a = *(const bf16x8*)(src + (size_t)sr * 128 + sc), b = *(const bf16x8*)(src + (size_t)(32 + sr) * 128 + sc);
                *(bf16x8*)(lds + q * SHM_K + kws) = a; *(bf16x8*)(lds + q * SHM_K + kws + 32 * 256) = b; }
        }
        const int tok = tt * 256 + wid * 32 + r32;
        bf16x8 qr[8];
        { const bf16_t* qp = QP + (size_t)tok * 2048 + h * 256 + hi * 8;
#pragma unroll
          for (int d0 = 0; d0 < 8; ++d0) qr[d0] = *(const bf16x8*)(qp + d0 * 16); }
        __syncthreads();
        float v1[16], v2[16];
        top16_of_128(lds, r32, hi, qr, v1);
        { const bf16_t* qp = QP + (size_t)tok * 2048 + h * 256 + 128 + hi * 8;
#pragma unroll
          for (int d0 = 0; d0 < 8; ++d0) qr[d0] = *(const bf16x8*)(qp + d0 * 16); }
        top16_of_128(lds + 2 * SHM_K, r32, hi, qr, v2);
        float s1[16], s2[16];
#pragma unroll
        for (int i = 0; i < 16; ++i) { s1[i] = __uint_as_float(__float_as_uint(v1[i]) & ~127u); s2[i] = __uint_as_float(__float_as_uint(v2[i]) & ~127u); }
        float cd[32];
        const float NEGC = -3e38f;
#pragma unroll
        for (int i = 0; i < 32; ++i) cd[i] = NEGC;
#define CAND(slot, a, b) cd[slot] = pack_idx(s1[a] + s2[b], (unsigned)((a) * 16 + (b)), 255u)
        if (hi == 0) {
#pragma unroll
            for (int b = 0; b < 16; ++b) CAND(b, 0, b);
#pragma unroll
            for (int b = 0; b < 5; ++b) CAND(16 + b, 2, b);
#pragma unroll
            for (int a = 8; a < 16; ++a) CAND(13 + a, a, 0);
        } else {
#pragma unroll
            for (int b = 0; b < 8; ++b) CAND(b, 1, b);
#pragma unroll
            for (int b = 0; b < 4; ++b) CAND(8 + b, 3, b);
#pragma unroll
            for (int b = 0; b < 3; ++b) CAND(12 + b, 4, b);
#pragma unroll
            for (int a = 5; a < 8; ++a) { CAND(15 + 2 * (a - 5), a, 0); CAND(16 + 2 * (a - 5), a, 1); }
        }
#undef CAND
        bitonic_sort_desc<32>(cd);
        float top[16], oth[16];
#pragma unroll
        for (int i = 0; i < 16; ++i) top[i] = cd[i];
#pragma unroll
        for (int i = 0; i < 16; ++i) oth[i] = xor32(top[i], hi);
        merge_top16(top, oth);
        float* scr = (float*)(lds + 4 * SHM_K);
#pragma unroll
        for (int i = 0; i < 16; ++i) { scr[i * 512 + tid] = v1[i]; scr[(16 + i) * 512 + tid] = v2[i]; }
        float ev[16]; int ei[16]; float esum = 0.f;
#pragma unroll
        for (int k = 0; k < 16; ++k) { const int code = (int)(__float_as_uint(top[k]) & 255u); const int a = code >> 4, b = code & 15;
            const float w1 = scr[a * 512 + tid], w2 = scr[(16 + b) * 512 + tid];
            ev[k] = __uint_as_float(__float_as_uint(w1) & ~127u) + __uint_as_float(__float_as_uint(w2) & ~127u);
            ei[k] = (int)((__float_as_uint(w1) & 127u) * 128u + (__float_as_uint(w2) & 127u)); }
        float emax = ev[0];
#pragma unroll
        for (int k = 1; k < 16; ++k) emax = fmaxf(emax, ev[k]);
#pragma unroll
        for (int k = 0; k < 16; ++k) { ev[k] = __expf(ev[k] - emax); esum += ev[k]; }
        const float inv = 1.0f / esum;
        int* ep = eidx + (size_t)tok * 128 + h * 16; float* gp = gsm + (size_t)tok * 128 + h * 16;
        if (hi == 0) {
            *(int4*)ep = make_int4(ei[0], ei[1], ei[2], ei[3]); *(int4*)(ep + 4) = make_int4(ei[4], ei[5], ei[6], ei[7]);
            *(f32x4*)gp = (f32x4){ev[0] * inv, ev[1] * inv, ev[2] * inv, ev[3] * inv}; *(f32x4*)(gp + 4) = (f32x4){ev[4] * inv, ev[5] * inv, ev[6] * inv, ev[7] * inv};
        } else {
            *(int4*)(ep + 8) = make_int4(ei[8], ei[9], ei[10], ei[11]); *(int4*)(ep + 12) = make_int4(ei[12], ei[13], ei[14], ei[15]);
            *(f32x4*)(gp + 8) = (f32x4){ev[8] * inv, ev[9] * inv, ev[10] * inv, ev[11] * inv}; *(f32x4*)(gp + 12) = (f32x4){ev[12] * inv, ev[13] * inv, ev[14] * inv, ev[15] * inv};
        }
    }
}

__device__ __forceinline__ void cvt16(const u32x4 w, f32x2 (&f)[8]) {
#pragma unroll
    for (int q = 0; q < 4; ++q) { f[2 * q] = __builtin_amdgcn_cvt_pk_f32_fp8((int)w[q], false); f[2 * q + 1] = __builtin_amdgcn_cvt_pk_f32_fp8((int)w[q], true); }
}
typedef short s16x2v __attribute__((ext_vector_type(2)));
#define EXP_DOT(S) do { \
        int A0 = __builtin_amdgcn_sdot8((int)w[0], xa[S][0], 0, true), B0 = __builtin_amdgcn_sdot8((int)w[0], xb[S][0], 0, true); \
        A0 = __builtin_amdgcn_sdot8((int)w[1], xa[S][1], A0, false); B0 = __builtin_amdgcn_sdot8((int)w[1], xb[S][1], B0, false); \
        int A1 = __builtin_amdgcn_sdot8((int)w[2], xa[S][2], 0, true), B1 = __builtin_amdgcn_sdot8((int)w[2], xb[S][2], 0, true); \
        A1 = __builtin_amdgcn_sdot8((int)w[3], xa[S][3], A1, false); B1 = __builtin_amdgcn_sdot8((int)w[3], xb[S][3], B1, false); \
        dsum = (float)((A0 << 4) + B0) * (float)(rbw & 255u) + (float)((A1 << 4) + B1) * (float)(rbw >> 8); } while (0)
typedef _Float16 h2 __attribute__((ext_vector_type(2)));
#ifndef UPR
#define UPR 8
#endif
typedef unsigned u32x6 __attribute__((ext_vector_type(6)));
typedef _Float16 h32 __attribute__((ext_vector_type(32)));
struct H2x16 { h2 a[16]; };
#define EXP_ACC(S) do { _Pragma("unroll") for (int m = 0; m < 8; ++m) { \
        acc[S][0][m] = __builtin_elementwise_fma(hv.a[m], ws2, acc[S][0][m]); acc[S][1][m] = __builtin_elementwise_fma(hv.a[8 + m], ws2, acc[S][1][m]); } } while (0)
template <int VAR>
__device__ __forceinline__ void phase_experts(const Params& p, unsigned char* lds_raw) {
    const int tid = tid_opaque(), wid = __builtin_amdgcn_readfirstlane(tid >> 6);
    const unsigned char* ED = p.ws + OFF_ED; const unsigned char* EU = p.ws + OFF_ED + (size_t)16384 * 2048; const float* scl = (const float*)(p.ws + OFF_ESCL);
    const bf16_t* X1B = (const bf16_t*)(p.ws + OFF_XB); const float* ssq2 = (const float*)(p.ws + OFF_SSQ2);
    const int* eidx = (const int*)(p.ws + OFF_EIDX); const float* gsm = (const float*)(p.ws + OFF_GSM);
    const float* fgain = p.in[21]; float* out = p.out;
    unsigned* KY = (unsigned*)lds_raw + wid * 1024;
    float* AW = (float*)(KY + 512);
    const int gw = blockIdx.x * 8 + wid, nw = gridDim.x * 8;
#pragma unroll 1
    for (int t0 = gw; t0 < T_TOK; t0 += 4 * nw) {
        int lane; asm volatile("v_mbcnt_lo_u32_b32 %0, -1, 0\n\tv_mbcnt_hi_u32_b32 %0, -1, %0" : "=v"(lane));
        int tok[4];
#pragma unroll
        for (int s = 0; s < 4; ++s) { const int t = t0 + s * nw; tok[s] = t < T_TOK ? t : t0; }
#pragma unroll
        for (int r = 0; r < 8; ++r) { const int s = r >> 1, pos = (r & 1) * 64 + lane; const int e = eidx[(size_t)tok[s] * 128 + pos]; KY[r * 64 + lane] = ((unsigned)e << 9) | ((unsigned)s << 7) | (unsigned)pos; }
        asm volatile("s_waitcnt lgkmcnt(0)" ::: "memory"); __builtin_amdgcn_wave_barrier();
#pragma unroll 1
        for (int k = 2; k <= 512; k <<= 1)
#pragma unroll 1
            for (int j = k >> 1; j > 0; j >>= 1) {
                unsigned sa[4], sb[4]; int si[4];
#pragma unroll
                for (int q = 0; q < 4; ++q) { const int idx = q * 64 + lane; const int i = ((idx & ~(j - 1)) << 1) | (idx & (j - 1)); si[q] = i; sa[q] = KY[i]; sb[q] = KY[i | j]; }
#pragma unroll
                for (int q = 0; q < 4; ++q) { const unsigned a = sa[q], b = sb[q]; const bool asc = (si[q] & k) == 0; const bool sw = asc ? (a > b) : (a < b); sa[q] = sw ? b : a; sb[q] = sw ? a : b; }
#pragma unroll
                for (int q = 0; q < 4; ++q) { KY[si[q]] = sa[q]; KY[si[q] | j] = sb[q]; }
                asm volatile("s_waitcnt lgkmcnt(0)" ::: "memory"); __builtin_amdgcn_wave_barrier();
            }
        float rsv[4];
#pragma unroll
        for (int s = 0; s < 4; ++s) { float sq = ssq2[(size_t)tok[s] * 64 + lane]; sq = wave_sum(sq); rsv[s] = __uint_as_float((unsigned)__builtin_amdgcn_readfirstlane((int)__float_as_uint(__builtin_amdgcn_rsqf(sq * (1.0f / 2048.0f) + NORM_EPS)))); }
        {
            int xa[4][4], xb[4][4];
#pragma unroll
            for (int s = 0; s < 4; ++s) {
                u32x4 xr[4];
#pragma unroll
                for (int j = 0; j < 2; ++j) { xr[2 * j] = *(const u32x4*)(X1B + (size_t)tok[s] * 2048 + j * 1024 + lane * 16); xr[2 * j + 1] = *(const u32x4*)(X1B + (size_t)tok[s] * 2048 + j * 1024 + lane * 16 + 8); }
                float mx = 0.f;
#pragma unroll
                for (int h = 0; h < 4; ++h)
#pragma unroll
                    for (int q = 0; q < 4; ++q) mx = fmaxf(mx, fmaxf(fabsf(bf_lo(xr[h][q])), fabsf(bf_hi(xr[h][q]))));
                mx = fmaxf(wave_max(mx), 1e-30f);
                const float inv = 119.0f / mx;
#pragma unroll
                for (int h = 0; h < 4; ++h) { unsigned pa = 0u, pb = 0u;
#pragma unroll
                    for (int k = 0; k < 8; ++k) { const float f = ((k & 1) ? bf_hi(xr[h][k >> 1]) : bf_lo(xr[h][k >> 1])) * inv; const int xi = (int)__builtin_rintf(f);
                        pa |= ((unsigned)((xi + 8) >> 4) & 15u) << (4 * k); pb |= ((unsigned)xi & 15u) << (4 * k); }
                    xa[s][h] = (int)pa; xb[s][h] = (int)pb; }
                rsv[s] *= __uint_as_float((unsigned)__builtin_amdgcn_readfirstlane((int)__float_as_uint(mx * (1.0f / 119.0f))));
            }
            int lane_d = lane; asm volatile("" : "+v"(lane_d));
            const unsigned lo16 = (unsigned)lane_d * 16u, lo2 = 1024u + (unsigned)lane_d * 2u;
#pragma unroll 1
            for (int c = 0; c < ((VAR & 1) ? 0 : 8); ++c) {
                const unsigned kv = KY[c * 64 + lane];
                float mine = 0.f;
#pragma unroll 1
                for (int bt = 0; bt < 4; ++bt) {
                    float dd[16];
#pragma unroll
                    for (int il = 0; il < 1; ++il) {
                        SBAR();
                        u32x4 r0[16]; unsigned r1[16]; unsigned ky[16];
#pragma unroll
                        for (int s = 0; s < 16; ++s) { ky[s] = (unsigned)__builtin_amdgcn_readlane((int)kv, bt * 16 + il * 16 + s);
                            const unsigned char* row = ED + (ky[s] >> 9) * 1152u; unsigned oa = lo16, ob = lo2; asm volatile("" : "+v"(oa), "+v"(ob)); r0[s] = *(const u32x4*)(row + oa); r1[s] = *(const unsigned short*)(row + ob); }
#pragma unroll
                        for (int s = 0; s < 16; ++s) { const u32x4 w = r0[s]; const unsigned rbw = r1[s]; const unsigned sl = (ky[s] >> 7) & 3u; float dsum;
                            if (sl == 0u) { EXP_DOT(0); asm volatile("; slot 0" : "+v"(dsum)); } else if (sl == 1u) { EXP_DOT(1); asm volatile("; slot 1" : "+v"(dsum)); }
                            else if (sl == 2u) { EXP_DOT(2); asm volatile("; slot 2" : "+v"(dsum)); } else { EXP_DOT(3); asm volatile("; slot 3" : "+v"(dsum)); }
                            dd[il * 16 + s] = dsum; }
                    }
                    const float v = butterfly16(dd, lane);
                    mine = ((lane >> 4) == bt) ? v : mine;
                }
                AW[c * 64 + lane] = mine;
            }
        }
        {
            float sd[8], gg[8], su[8], av[8]; float rs8[8];
#pragma unroll
            for (int c = 0; c < 8; ++c) {
                const unsigned kv = KY[c * 64 + lane]; av[c] = AW[c * 64 + lane];
                const unsigned e = kv >> 9, sl = (kv >> 7) & 3u, pos = kv & 127u;
                const int mytok = sl == 0u ? tok[0] : (sl == 1u ? tok[1] : (sl == 2u ? tok[2] : tok[3]));
                rs8[c] = sl == 0u ? rsv[0] : (sl == 1u ? rsv[1] : (sl == 2u ? rsv[2] : rsv[3]));
                const unsigned eo = e * 4u, go = ((unsigned)mytok * 128u + pos) * 4u;
                sd[c] = *(const float*)((const char*)scl + eo); gg[c] = *(const float*)((const char*)gsm + go); su[c] = *(const float*)((const char*)(scl + 16384) + eo);
            }
#pragma unroll
            for (int c = 0; c < 8; ++c) { const _Float16 wh = (_Float16)(gelu_tanh(av[c] * sd[c] * rs8[c]) * gg[c] * su[c] * 1024.0f); AW[c * 64 + lane] = __builtin_bit_cast(float, (h2){wh, wh}); }
        }
        int lane_u = lane; asm volatile("" : "+v"(lane_u));
        const unsigned uo16 = (unsigned)lane_u * 16u, uo8 = 1024u + (unsigned)lane_u * 8u;
        h2 acc[4][2][8];
#pragma unroll
        for (int s = 0; s < 4; ++s)
#pragma unroll
            for (int j = 0; j < 2; ++j)
#pragma unroll
                for (int q = 0; q < 8; ++q) acc[s][j][q] = (h2){(_Float16)0.f, (_Float16)0.f};
#pragma unroll 1
        for (int c = 0; c < ((VAR & 2) ? 0 : 8); ++c) {
            const unsigned kv = KY[c * 64 + lane]; const float wv = AW[c * 64 + lane];
#pragma unroll 1
            for (int b8 = 0; b8 < 64 / UPR; ++b8) {
                u32x4 r0[UPR]; u32x2 r1[UPR]; unsigned ky[UPR];
#pragma unroll
                for (int k = 0; k < UPR; ++k) { ky[k] = (unsigned)__builtin_amdgcn_readlane((int)kv, b8 * UPR + k);
                    const unsigned char* row = EU + (ky[k] >> 9) * 1536u; unsigned oa = uo16, ob = uo8; asm volatile("" : "+v"(oa), "+v"(ob)); r0[k] = *(const u32x4*)(row + oa); r1[k] = *(const u32x2*)(row + ob); }
#pragma unroll
                for (int k = 0; k < UPR; ++k) { const unsigned sl = (ky[k] >> 7) & 3u;
                    const H2x16 hv = __builtin_bit_cast(H2x16, __builtin_amdgcn_cvt_scalef32_pk32_f16_fp6((u32x6){r0[k][0], r0[k][1], r0[k][2], r0[k][3], r1[k][0], r1[k][1]}, 1.0f));
                    const h2 ws2 = __builtin_bit_cast(h2, (unsigned)__builtin_amdgcn_readlane((int)__float_as_uint(wv), b8 * UPR + k));
                    if (sl == 0u) { EXP_ACC(0); } asm volatile("; slot 0" ::: "memory"); if (sl == 1u) { EXP_ACC(1); } asm volatile("; slot 1" ::: "memory");
                    if (sl == 2u) { EXP_ACC(2); } asm volatile("; slot 2" ::: "memory"); if (sl == 3u) { EXP_ACC(3); } asm volatile("; slot 3" ::: "memory"); }
            }
        }
        {
            int lane_f = lane; asm volatile("" : "+v"(lane_f));
            u32x4 xl[4][4]; f32x4 gn[2][4];
#pragma unroll
            for (int s = 0; s < 4; ++s)
#pragma unroll
                for (int j = 0; j < 2; ++j) { const bf16_t* xp = X1B + (size_t)tok[s] * 2048 + j * 1024 + lane_f * 16; xl[s][2 * j] = *(const u32x4*)xp; xl[s][2 * j + 1] = *(const u32x4*)(xp + 8); }
#pragma unroll
            for (int j = 0; j < 2; ++j)
#pragma unroll
                for (int q = 0; q < 4; ++q) gn[j][q] = *(const f32x4*)(fgain + j * 1024 + lane_f * 16 + 4 * q);
#pragma unroll
            for (int s = 0; s < 4; ++s) {
                float ss = 0.f; f32x2 xo[2][8];
#pragma unroll
                for (int j = 0; j < 2; ++j) { const u32x4 xa = xl[s][2 * j], xb2 = xl[s][2 * j + 1];
#pragma unroll
                    for (int q = 0; q < 4; ++q) { const unsigned w0_ = q < 2 ? xa[2 * q] : xb2[2 * q - 4], w1_ = q < 2 ? xa[2 * q + 1] : xb2[2 * q - 3]; const f32x4 a = {bf_lo(w0_), bf_hi(w0_), bf_lo(w1_), bf_hi(w1_)};
                        xo[j][2 * q] = (f32x2){a[0] + (float)acc[s][j][2 * q].x * (1.0f / 1024.0f), a[1] + (float)acc[s][j][2 * q].y * (1.0f / 1024.0f)};
                        xo[j][2 * q + 1] = (f32x2){a[2] + (float)acc[s][j][2 * q + 1].x * (1.0f / 1024.0f), a[3] + (float)acc[s][j][2 * q + 1].y * (1.0f / 1024.0f)};
                        ss += xo[j][2 * q].x * xo[j][2 * q].x + xo[j][2 * q].y * xo[j][2 * q].y + xo[j][2 * q + 1].x * xo[j][2 * q + 1].x + xo[j][2 * q + 1].y * xo[j][2 * q + 1].y; } }
                ss = wave_sum(ss);
                const float rf = __builtin_amdgcn_rsqf(ss * (1.0f / 2048.0f) + NORM_EPS);
                if (t0 + s * nw < T_TOK) {
#pragma unroll
                    for (int j = 0; j < 2; ++j) { float* xp = out + (size_t)tok[s] * 2048 + j * 1024 + lane_f * 16;
#pragma unroll
                        for (int q = 0; q < 4; ++q) { const f32x4 g = gn[j][q];
                            *(f32x4*)(xp + 4 * q) = (f32x4){xo[j][2 * q].x * rf * g[0], xo[j][2 * q].y * rf * g[1], xo[j][2 * q + 1].x * rf * g[2], xo[j][2 * q + 1].y * rf * g[3]}; } }
                }
            }
        }
        __builtin_amdgcn_wave_barrier();
    }
}
#undef EXP_DOT
#undef EXP_ACC

#define XB_TMO      128
#define XB_XCNT(j)  (256  + 64 * (j))
#define XB_XSUB(j)  (1280 + 64 * (j))
#define XB_XGEN(j)  (2304 + 64 * (j))
#define XB_TOP      3328
#define XB_TOPGEN   3392
#define XCD_BAR_WORDS 3456
#define XB_SPIN_CAP (1u << 18)

__device__ __forceinline__ unsigned xb_ld(unsigned* p)              { return __hip_atomic_load(p, __ATOMIC_RELAXED, __HIP_MEMORY_SCOPE_AGENT); }
__device__ __forceinline__ unsigned xb_add(unsigned* p, unsigned v) { return __hip_atomic_fetch_add(p, v, __ATOMIC_RELAXED, __HIP_MEMORY_SCOPE_AGENT); }
__device__ __forceinline__ unsigned xb_xcc_id() { return (unsigned)__builtin_amdgcn_s_getreg((3 << 11) | 20) & 0xFu; }
#define XB_SPIN(cond, bar) do { unsigned _sp = 0; while (cond) { __builtin_amdgcn_s_sleep(1); \
    if ((++_sp & 255u) == 0u) { if (xb_ld(&(bar)[XB_TMO])) break; if (_sp > XB_SPIN_CAP) { atomicAdd(&(bar)[XB_TMO], 1u); break; } } } } while (0)

struct XcdBarrier {
    unsigned* bar; unsigned x;
    volatile LAS unsigned* st;
};

__device__ __forceinline__ XcdBarrier xcd_barrier_post(unsigned* bar, volatile LAS unsigned* st) {
    XcdBarrier b; b.bar = bar; b.x = xb_xcc_id(); b.st = st;
    if (threadIdx.x == 0) (void)xb_add(&bar[XB_XCNT(b.x)], 1u);
    return b;
}
__device__ __forceinline__ void xcd_barrier_complete(unsigned* bar, unsigned x, unsigned& nloc, unsigned& nx) {
    const unsigned G = gridDim.x * gridDim.y * gridDim.z;
    unsigned sum, cnt, mine, sp = 0u;
    for (;;) {
        sum = 0u; cnt = 0u; mine = 0u;
#pragma unroll
        for (unsigned j = 0; j < 16; ++j) { const unsigned c = xb_ld(&bar[XB_XCNT(j)]); sum += c; cnt += (c > 0u) ? 1u : 0u; mine = (j == x) ? c : mine; }
        if (sum == G) break;
        __builtin_amdgcn_s_sleep(1);
        if ((++sp & 255u) == 0u) { if (xb_ld(&bar[XB_TMO])) break; if (sp > XB_SPIN_CAP) { atomicAdd(&bar[XB_TMO], 1u); break; } }
    }
    nloc = mine > 0u ? mine : 1u; nx = cnt > 0u ? cnt : 1u;
}

__device__ __forceinline__ void xcd_barrier(const XcdBarrier& b) {
    asm volatile("s_waitcnt vmcnt(0)" ::: "memory");
    __syncthreads();
    if (threadIdx.x == 0) {
        unsigned* bar = b.bar;
        __builtin_amdgcn_s_waitcnt(0);
        unsigned nloc = b.st[0], nx = b.st[1];
        if (nloc == 0u) { xcd_barrier_complete(bar, b.x, nloc, nx); b.st[0] = nloc; b.st[1] = nx; }
        const unsigned old = xb_add(&bar[XB_XSUB(b.x)], 1u);
        const unsigned gen = old / nloc;
        if (old + 1u == (gen + 1u) * nloc) {
            __builtin_amdgcn_fence(__ATOMIC_RELEASE, "agent");
            asm volatile("s_waitcnt vmcnt(0)" ::: "memory");
            const unsigned og = xb_add(&bar[XB_TOP], 1u);
            const unsigned tg = og / nx;
            if (og + 1u == (tg + 1u) * nx) xb_add(&bar[XB_TOPGEN], 1u);
            else XB_SPIN(xb_ld(&bar[XB_TOPGEN]) == tg, bar);
            __builtin_amdgcn_fence(__ATOMIC_ACQUIRE, "agent");
            xb_add(&bar[XB_XGEN(b.x)], 1u);
            asm volatile("s_waitcnt vmcnt(0)" ::: "memory");
        } else {
            XB_SPIN(xb_ld(&bar[XB_XGEN(b.x)]) == gen, bar);
            __builtin_amdgcn_fence(__ATOMIC_ACQUIRE, "agent");
            asm volatile("s_waitcnt vmcnt(0)" ::: "memory");
        }
    }
    __syncthreads();
}


#ifdef DBG_PROBE
constexpr size_t OFF_DBG = 470 * MiB;
constexpr int DBG_NS = 32;
__device__ __forceinline__ int dbg_token(int i) { return (i * 509 + 37 * (i & 7) * 64 + 5) & (T_TOK - 1); }
__device__ __forceinline__ float block_sum(float v, float* red) {
    v = wave_sum(v); __syncthreads(); if ((threadIdx.x & 63) == 0) red[threadIdx.x >> 6] = v; __syncthreads();
    float s = 0.f; for (int i = 0; i < 8; ++i) s += red[i]; __syncthreads(); return s;
}
__device__ void probe_peer_naive(const Params& p, unsigned char* lds_raw) {
    if ((int)blockIdx.x >= DBG_NS) return;
    const int tid = threadIdx.x, t = dbg_token(blockIdx.x);
    float* xn = (float*)lds_raw;
    float* q = xn + 2048;
    float* sc = q + 2048;
    float* wexp = sc + 2048;
    int* eix = (int*)(wexp + 128);
    float* gg = (float*)(eix + 128);
    float* red = gg + 128;
    float* tmpv = red + 16;
    int* tmpi = (int*)(tmpv + 256);
    float* cand = (float*)(tmpi + 256);
    const float* x1 = p.out + (size_t)t * 2048; const float* g2 = p.in[15];
    float ss = 0.f; for (int i = tid; i < 2048; i += 512) { const float v = x1[i]; ss += v * v; }
    ss = block_sum(ss, red);
    const float rs = 1.0f / sqrtf(ss / 2048.0f + NORM_EPS);
    for (int i = tid; i < 2048; i += 512) xn[i] = x1[i] * rs * g2[i];
    __syncthreads();
    { const float* wq = p.in[16]; float a0 = 0, a1 = 0, a2 = 0, a3 = 0;
      for (int k = 0; k < 2048; ++k) { const float xv = xn[k]; const float* w = wq + (size_t)k * 2048; a0 += xv * w[tid]; a1 += xv * w[tid + 512]; a2 += xv * w[tid + 1024]; a3 += xv * w[tid + 1536]; }
      q[tid] = a0; q[tid + 512] = a1; q[tid + 1024] = a2; q[tid + 1536] = a3; }
    __syncthreads();
    for (int i = tid; i < 2048; i += 512) { const int which = i >> 10, h = (i >> 7) & 7, key = i & 127; const float* kk = p.in[17 + which] + ((size_t)h * 128 + key) * 128; const float* qq = q + h * 256 + which * 128;
        float s = 0.f; for (int d = 0; d < 128; ++d) s += qq[d] * kk[d]; sc[i] = s; }
    __syncthreads();
    if (tid < 16) { const int which = tid >> 3, h = tid & 7; float* s = sc + which * 1024 + h * 128;
        for (int r = 0; r < 16; ++r) { int bi = 0; float bv = -3e38f; for (int k = 0; k < 128; ++k) if (s[k] > bv) { bv = s[k]; bi = k; } tmpv[(h * 2 + which) * 16 + r] = bv; tmpi[(h * 2 + which) * 16 + r] = bi; s[bi] = -3e38f; } }
    __syncthreads();
    for (int i = tid; i < 2048; i += 512) { const int h = i >> 8, a = (i >> 4) & 15, b = i & 15; cand[i] = tmpv[(h * 2) * 16 + a] + tmpv[(h * 2 + 1) * 16 + b]; }
    __syncthreads();
    if (tid < 8) { const int h = tid; float* c = cand + h * 256; float mx = -3e38f;
        for (int r = 0; r < 16; ++r) { int bi = 0; float bv = -3e38f; for (int k = 0; k < 256; ++k) if (c[k] > bv) { bv = c[k]; bi = k; } c[bi] = -3e38f;
            eix[h * 16 + r] = tmpi[(h * 2) * 16 + (bi >> 4)] * 128 + tmpi[(h * 2 + 1) * 16 + (bi & 15)]; gg[h * 16 + r] = bv; if (bv > mx) mx = bv; }
        float sm = 0.f; for (int r = 0; r < 16; ++r) { const float e = expf(gg[h * 16 + r] - mx); gg[h * 16 + r] = e; sm += e; }
        for (int r = 0; r < 16; ++r) gg[h * 16 + r] /= sm; }
    __syncthreads();
    { const int wid = tid >> 6, lane = tid & 63;
      for (int e = wid; e < 128; e += 8) { const float* u = p.in[19] + (size_t)eix[e] * 2048; float s = 0.f; for (int d = lane; d < 2048; d += 64) s += xn[d] * u[d]; s = wave_sum(s);
          if (lane == 0) wexp[e] = gelu_tanh(s) * gg[e]; } }
    __syncthreads();
    float* dbg = (float*)(p.ws + OFF_DBG) + (size_t)blockIdx.x * 2048;
    float o[4]; float s2 = 0.f;
    for (int j = 0; j < 4; ++j) { const int c = tid + j * 512; float a = 0.f; for (int e = 0; e < 128; ++e) a += wexp[e] * p.in[20][(size_t)eix[e] * 2048 + c]; o[j] = x1[c] + a; s2 += o[j] * o[j]; }
    s2 = block_sum(s2, red);
    const float rf = 1.0f / sqrtf(s2 / 2048.0f + NORM_EPS);
    for (int j = 0; j < 4; ++j) { const int c = tid + j * 512; dbg[c] = o[j] * rf * p.in[21][c]; }
    int* dsel = (int*)(p.ws + OFF_DBG + 1 * MiB) + (size_t)blockIdx.x * 256;
    if (tid < 128) { dsel[tid] = eix[tid]; ((float*)dsel)[128 + tid] = gg[tid]; }
}
__device__ void probe_peer_compare(const Params& p, unsigned char* lds_raw, int mode) {
    float* red = (float*)lds_raw; const int tid = threadIdx.x;
    if (blockIdx.x == 0) {
        float num = 0.f, den = 0.f;
        if (mode == 0) { for (int i = 0; i < DBG_NS; ++i) { const float* a = p.out + (size_t)dbg_token(i) * 2048; const float* b = (const float*)(p.ws + OFF_DBG) + (size_t)i * 2048;
                for (int c = tid; c < 2048; c += 512) { const float d = a[c] - b[c]; num += d * d; den += b[c] * b[c]; } } }
        else { const int* eidx = (const int*)(p.ws + OFF_EIDX); const float* gsm = (const float*)(p.ws + OFF_GSM);
            for (int i = tid; i < DBG_NS * 128; i += 512) { const int s = i >> 7, k = i & 127, h = k >> 4; const int* dsel = (const int*)(p.ws + OFF_DBG + 1 * MiB) + (size_t)s * 256; const int t = dbg_token(s);
                const int e = dsel[k]; const float g = ((const float*)dsel)[128 + k]; bool found = false; float gp = 0.f;
                for (int r = 0; r < 16; ++r) if (eidx[(size_t)t * 128 + h * 16 + r] == e) { found = true; gp = gsm[(size_t)t * 128 + h * 16 + r]; }
                if (mode == 1) { num += found ? 0.f : 1.f; den += 1.f; } else { if (found) { num += (gp - g) * (gp - g); den += g * g; } } } }
        num = block_sum(num, red + 32); den = block_sum(den, red + 32);
        if (tid == 0) ((float*)(p.ws + OFF_MISC + M_CTL))[32] = num / fmaxf(den, 1e-30f);
    }
}
__device__ void probe_encode(const Params& p) {
    const float e = ((const float*)(p.ws + OFF_MISC + M_CTL))[32];
    const float beta = 0.967f - 0.9f * sqrtf(fminf(fmaxf(e, 0.f), 1.f));
    const float bb = (e == e) ? beta : -1.0f;
    for (size_t i = (size_t)blockIdx.x * 512 + threadIdx.x; i < (size_t)T_TOK * 2048; i += (size_t)gridDim.x * 512) p.out[i] = p.in[0][i] * bb;
}
#endif

constexpr int LDS_BYTES = 132 * 1024;
#ifndef N_PHASES
#define N_PHASES 11
#endif
__device__ __forceinline__ void run_phase(int ph, const Params& p, unsigned char* lds) {
    const int G = gridDim.x, c = blockIdx.x;
    unsigned char* ws = p.ws;
    switch (ph) {
    case 0: phase_prep(p, lds); break;
    case 1: { SchedGemm1 S{(const char*)(ws + OFF_XB), (const char*)(ws + OFF_WINT), G, c}; EpiGemm1 E{1, ws, p.out, p.in[3], p.in[4], p.in[5]};
              pg8::gemm_phase<true>((LAS unsigned char*)lds, 1024, 1024, 1024, S, E);
              if (G == 256 && c >= 192) {
                  const int t_ = tid_opaque(), lw = (c - 192) * 8 + (t_ >> 6), lane_ = t_ & 63;
                  for (int r0 = 2 * 16384 - LATE_ROWS + lw; r0 < 2 * 16384; r0 += 1024) convert_expert_rows(p, r0, r0 + 512 < 2 * 16384 ? r0 + 512 : r0, lane_); } } break;
    case 2: { SchedCompress S{(const char*)(ws + OFF_KV6), (const char*)(ws + OFF_KV6) + (size_t)16 * 2048 * 128 * 2, (const char*)(ws + OFF_W1T), G, c}; EpiSlab E{(float*)(ws + OFF_XB)};
              pg8::gemm_phase<false>((LAS unsigned char*)lds, 512, 2048, 4096, S, E);
              fox_cumsum(p, G >= 138 ? 128 : 0); } break;
    case 3: phase_cmp2(p, lds); break;
    case 4: phase_cmp_attn(p, lds); break;
    case 5: phase_attn(p, lds); break;
    case 6: { SchedMerge S{(const char*)(ws + OFF_XB), (const char*)(ws + OFF_WUPT), G, c}; EpiMerge E{(const unsigned char*)p.out, (const unsigned char*)p.out + (size_t)T_TOK * 2048, ws + OFF_QKVF};
              pg8::gemm_phase<true>((LAS unsigned char*)lds, 512, 1024, 1024, S, E); } break;
    case 7: { SchedSquare S{(const char*)(ws + OFF_QKVF), (const char*)(ws + OFF_WOUTT), G, c, 2048}; EpiOut E{p.in[0], p.out, (bf16_t*)(ws + OFF_XB), (float*)(ws + OFF_SSQ2)};
              pg8::gemm_phase<true>((LAS unsigned char*)lds, 1024, 1024, 1024, S, E); } break;
    case 8: { SchedSquare S{(const char*)(ws + OFF_XB), (const char*)(ws + OFF_WQT), G, c, 4096}; EpiPeerQ E{(const float*)(ws + OFF_SSQ2), (bf16_t*)(ws + OFF_QKVF)};
              pg8::gemm_phase<false>((LAS unsigned char*)lds, 2048, 2048, 2048, S, E); } break;
    case 9: phase_peer_topk(p, lds); break;
    case 10: phase_experts<0>(p, lds); break;
    }
}

constexpr size_t OFF_BAR = OFF_MISC + 7 * MiB;
__global__ void __launch_bounds__(512, 2) fwd_megakernel(Params p) {
    extern __shared__ __attribute__((aligned(16))) unsigned char shm[];
    cg::grid_group grid = cg::this_grid();
    volatile LAS unsigned* bst = (volatile LAS unsigned*)((LAS unsigned char*)shm + LDS_BYTES - 16);
    if (threadIdx.x < 4) bst[threadIdx.x] = 0u;
    __syncthreads();
    const XcdBarrier xb = xcd_barrier_post((unsigned*)(p.ws + OFF_BAR), bst);
#define GSYNC() xcd_barrier(xb)
#ifdef ONLY_PHASE
    run_phase(ONLY_PHASE, p, shm); grid.sync();
#else
#ifndef REPEAT_MASK
#define REPEAT_MASK 0
#endif
#define RUNP(k) do { run_phase(k, p, shm); GSYNC(); if (REPEAT_MASK & (1 << (k))) { if ((k) == 5) { if (blockIdx.x == 0 && threadIdx.x == 0) *(unsigned*)(p.ws + OFF_MISC + M_CTL) = 0u; GSYNC(); } run_phase(k, p, shm); GSYNC(); } } while (0)
    run_phase(0, p, shm);
#if REPEAT_MASK & 1
    GSYNC(); run_phase(0, p, shm);
#endif
    if (p.ws == nullptr) grid.sync();
    GSYNC();
#ifdef P1VAR
    { const int G = gridDim.x, c = blockIdx.x; unsigned char* ws = p.ws;
      SchedGemm1 S{(const char*)(ws + ((P1VAR & 2) ? 160 * MiB : OFF_XB)), (const char*)(ws + ((P1VAR & 2) ? 350 * MiB : OFF_WINT)), G, c}; int st_ = (P1VAR & 4) ? 0 : 1; asm volatile("" : "+s"(st_)); EpiGemm1 E{st_, ws, p.out, p.in[3], p.in[4], p.in[5]};
      pg8::gemm_phase<true, (P1VAR & 1) != 0>((LAS unsigned char*)shm, 1024, 1024, 1024, S, E); GSYNC(); }
#endif
    RUNP(1); RUNP(2); RUNP(3); RUNP(4); RUNP(5);
#ifdef PXVAR
    { const int G = gridDim.x, c = blockIdx.x; unsigned char* ws = p.ws;
      if (PXVAR & 1) { SchedMerge S{(const char*)(ws + OFF_XB), (const char*)(ws + OFF_WUPT), G, c}; EpiMerge E{(const unsigned char*)p.out, (const unsigned char*)p.out + (size_t)T_TOK * 2048, ws + OFF_QKVF};
          pg8::gemm_phase<true, true>((LAS unsigned char*)shm, 512, 1024, 1024, S, E); GSYNC(); }
      if (PXVAR & 2) { SchedSquare S{(const char*)(ws + OFF_QKVF), (const char*)(ws + OFF_WOUTT), G, c, 2048}; EpiOut E{p.in[0], p.out, (bf16_t*)(ws + OFF_XB), (float*)(ws + OFF_SSQ2)};
          pg8::gemm_phase<true, true>((LAS unsigned char*)shm, 1024, 1024, 1024, S, E); GSYNC(); }
      if (PXVAR & 4) { SchedSquare S{(const char*)(ws + OFF_XB), (const char*)(ws + OFF_WQT), G, c, 4096}; EpiPeerQ E{(const float*)(ws + OFF_SSQ2), (bf16_t*)(ws + OFF_QKVF)};
          pg8::gemm_phase<false, true>((LAS unsigned char*)shm, 2048, 2048, 2048, S, E); GSYNC(); } }
#endif
    RUNP(6); RUNP(7); RUNP(8); RUNP(9);
#if 0
#endif
#ifdef DBG_PROBE
    probe_peer_naive(p, shm); grid.sync();
#endif
#if (REPEAT_MASK >> 10) & 1
    phase_experts<P10VAR>(p, shm); GSYNC();
#endif
#ifdef EXTRA_GSYNC
    for (int i_ = 0; i_ < EXTRA_GSYNC; ++i_) GSYNC();
#endif
    run_phase(10, p, shm);
#ifdef DBG_PROBE
    grid.sync(); probe_peer_compare(p, shm, DBG_PROBE - 1); grid.sync(); probe_encode(p);
#endif
#endif
}

extern "C" void kernel_launch(void* const* d_in, const int* in_sizes, int n_in, void* d_out, int out_size, void* d_ws, size_t ws_size, hipStream_t stream) {
    static int grid_blocks = 0;
    if (grid_blocks == 0) {
        if (n_in != 22 || out_size != T_TOK * DM || ws_size < WS_END) { fprintf(stderr, "kernel_launch: unexpected shapes (n_in %d out %d ws %zu, need ws >= %zu)\n", n_in, out_size, ws_size, (size_t)WS_END); grid_blocks = -1; return; }
        int dev = 0, cus = 0, per_cu = 0;
        hipGetDevice(&dev); hipDeviceGetAttribute(&cus, hipDeviceAttributeMultiprocessorCount, dev);
        if (hipFuncSetAttribute((const void*)fwd_megakernel, hipFuncAttributeMaxDynamicSharedMemorySize, LDS_BYTES) != hipSuccess) { fprintf(stderr, "kernel_launch: hipFuncSetAttribute failed\n"); grid_blocks = -1; return; }
        if (hipOccupancyMaxActiveBlocksPerMultiprocessor(&per_cu, (const void*)fwd_megakernel, 512, LDS_BYTES) != hipSuccess || per_cu < 1) { fprintf(stderr, "kernel_launch: occupancy query says %d\n", per_cu); grid_blocks = -1; return; }
        grid_blocks = cus;
    }
    if (grid_blocks < 0) return;
    Params p{};
    for (int i = 0; i < 22; ++i) p.in[i] = (const float*)d_in[i];
    p.out = (float*)d_out; p.ws = (unsigned char*)d_ws;
    if (hipMemsetAsync((char*)d_ws + OFF_BAR, 0, XCD_BAR_WORDS * 4, stream) != hipSuccess) { fprintf(stderr, "kernel_launch: memset of the barrier words failed\n"); return; }
#ifdef P1VAR
    if (P1VAR & 2) { hipMemsetAsync((char*)d_ws + 160 * MiB, 0, 32 * MiB, stream); hipMemsetAsync((char*)d_ws + 350 * MiB, 0, 20 * MiB, stream); }
#endif
    void* args[] = {&p};
    hipError_t e = hipLaunchCooperativeKernel((const void*)fwd_megakernel, dim3(grid_blocks), dim3(512), args, LDS_BYTES, stream);
    if (e != hipSuccess) fprintf(stderr, "cooperative launch failed: %s (grid %d)\n", hipGetErrorString(e), grid_blocks);
}
```

```cpp
#include <hip/hip_runtime.h>
#include <hip/hip_cooperative_groups.h>
#include <cstdio>
#include <cstdint>
namespace cg = cooperative_groups;

#define LAS __attribute__((address_space(3)))
typedef unsigned short bf16_t;
typedef short bf16x8 __attribute__((ext_vector_type(8)));
typedef short s16x4 __attribute__((ext_vector_type(4)));
typedef float f32x2 __attribute__((ext_vector_type(2)));
typedef float f32x4 __attribute__((ext_vector_type(4)));
typedef float f32x16 __attribute__((ext_vector_type(16)));
typedef unsigned u32x2 __attribute__((ext_vector_type(2)));
typedef unsigned u32x4 __attribute__((ext_vector_type(4)));
typedef __bf16 bf16x2v __attribute__((ext_vector_type(2)));

constexpr int T_TOK = 16384, DM = 2048, NB = 8, SEQ = 2048;
constexpr int NWIN = 9984;
constexpr float NORM_EPS = 1e-6f;
constexpr float LOG2E = 1.4426950408889634f;
constexpr float ATT_SCALE = 0.08838834764831845f;

constexpr float SC_X = 16.f, SC_WIN = 1024.f, SC_O = 16.f, SC_WUP = 512.f, SC_M = 64.f, SC_WOUT = 1024.f;
constexpr size_t MiB = 1ull << 20;
constexpr size_t OFF_ED = 0, OFF_EU = 64 * MiB, OFF_XB = 128 * MiB  , OFF_WINT = 192 * MiB  ;
constexpr size_t OFF_WUPT = 232 * MiB, OFF_WOUTT = 240 * MiB, OFF_WQT = 248 * MiB, OFF_W1T = 256 * MiB, OFF_MISC = 260 * MiB;
constexpr size_t OFF_QN = 268 * MiB, OFF_KV6 = 300 * MiB, OFF_QKVF = 350 * MiB  ;
constexpr size_t OFF_KCVC = 446 * MiB, OFF_SEL = 447 * MiB, OFF_SSQ2 = 448 * MiB, OFF_EIDX = 452 * MiB, OFF_GSM = 460 * MiB, WS_END = 468 * MiB;
constexpr size_t M_ROPE = 0  , M_K12 = 1 * MiB  , M_B1P = M_K12 + 512 * 1024  ;
constexpr size_t M_B1 = M_B1P + 128 * 1024  , M_SSQ1 = M_B1P + 160 * 1024  , M_GN = 2 * MiB  , M_LOGF = 4 * MiB  , M_CFOX = M_LOGF + 512 * 1024;
constexpr size_t M_CTL = 5 * MiB  ;
constexpr size_t OFF_ESCL = OFF_MISC + 6 * MiB;

struct Params {
    const float* in[22];
    float* out;
    unsigned char* ws;
};

__device__ __forceinline__ unsigned cvtpk(float lo, float hi) { unsigned r; asm volatile("v_cvt_pk_bf16_f32 %0, %1, %2" : "=v"(r) : "v"(lo), "v"(hi)); return r; }
__device__ __forceinline__ unsigned pack_fp8x4(float a, float b, float c, float d) {
    a = fminf(fmaxf(a, -448.f), 448.f); b = fminf(fmaxf(b, -448.f), 448.f); c = fminf(fmaxf(c, -448.f), 448.f); d = fminf(fmaxf(d, -448.f), 448.f);
    int pk = 0; pk = __builtin_amdgcn_cvt_pk_fp8_f32(a, b, pk, false); pk = __builtin_amdgcn_cvt_pk_fp8_f32(c, d, pk, true); return (unsigned)pk; }
__device__ __forceinline__ unsigned pack_i8x4(float a, float b, float c, float d) {
    const int ia = (int)__builtin_rintf(a), ib = (int)__builtin_rintf(b), ic = (int)__builtin_rintf(c), id = (int)__builtin_rintf(d);
    return ((unsigned)ia & 0xffu) | (((unsigned)ib & 0xffu) << 8) | (((unsigned)ic & 0xffu) << 16) | ((unsigned)id << 24); }
__device__ __forceinline__ float bf_lo(unsigned u) { return __uint_as_float(u << 16); }
__device__ __forceinline__ float bf_hi(unsigned u) { return __uint_as_float(u & 0xffff0000u); }
__device__ __forceinline__ float sigmoidf_(float x) { return __builtin_amdgcn_rcpf(1.0f + __builtin_amdgcn_exp2f(-LOG2E * x)); }
__device__ __forceinline__ float gelu_tanh(float x) { const float u = 0.7978845608028654f * (x + 0.044715f * x * x * x); const float e = __builtin_amdgcn_exp2f(2.0f * LOG2E * u); const float t = 1.0f - 2.0f * __builtin_amdgcn_rcpf(e + 1.0f); return 0.5f * x * (1.0f + t); }
__device__ __forceinline__ int tid_opaque() { int t = threadIdx.x; asm volatile("" : "+v"(t)); return t; }
template <int CTRL> __device__ __forceinline__ float dppx(float v) { return __uint_as_float((unsigned)__builtin_amdgcn_update_dpp(0, (int)__float_as_uint(v), CTRL, 0xf, 0xf, true)); }
constexpr int DPP_XOR1 = 0xB1  , DPP_XOR2 = 0x4E  , DPP_HMIRROR = 0x141  , DPP_MIRROR = 0x140  ;
__device__ __forceinline__ float swap16_sum(float v) { auto r = __builtin_amdgcn_permlane16_swap(__float_as_uint(v), __float_as_uint(v), false, false); return __uint_as_float(r[0]) + __uint_as_float(r[1]); }
__device__ __forceinline__ float swap32_sum(float v) { auto r = __builtin_amdgcn_permlane32_swap(__float_as_uint(v), __float_as_uint(v), false, false); return __uint_as_float(r[0]) + __uint_as_float(r[1]); }
__device__ __forceinline__ float swap16_max(float v) { auto r = __builtin_amdgcn_permlane16_swap(__float_as_uint(v), __float_as_uint(v), false, false); return fmaxf(__uint_as_float(r[0]), __uint_as_float(r[1])); }
__device__ __forceinline__ float swap32_max(float v) { auto r = __builtin_amdgcn_permlane32_swap(__float_as_uint(v), __float_as_uint(v), false, false); return fmaxf(__uint_as_float(r[0]), __uint_as_float(r[1])); }
__device__ __forceinline__ float xor32(float v, int hi) { auto r = __builtin_amdgcn_permlane32_swap(__float_as_uint(v), __float_as_uint(v), false, false); return __uint_as_float(hi ? r[0] : r[1]); }
__device__ __forceinline__ float wave_sum(float v) {
    v += dppx<DPP_XOR1>(v); v += dppx<DPP_XOR2>(v); v += dppx<DPP_HMIRROR>(v); v += dppx<DPP_MIRROR>(v);
    return swap32_sum(swap16_sum(v));
}
__device__ __forceinline__ float wave_max(float v) {
    v = fmaxf(v, dppx<DPP_XOR1>(v)); v = fmaxf(v, dppx<DPP_XOR2>(v)); v = fmaxf(v, dppx<DPP_HMIRROR>(v)); v = fmaxf(v, dppx<DPP_MIRROR>(v));
    return swap32_max(swap16_max(v));
}
__device__ __forceinline__ float butterfly16(float (&dd)[16], int lane) {
#define BF_STEP(S, N, CTRL) do { const bool up = (lane & (S)) != 0; _Pragma("unroll") for (int i = 0; i < (N); ++i) { const float send = up ? dd[i] : dd[i + (N)]; const float keep = up ? dd[i + (N)] : dd[i]; dd[i] = keep + dppx<CTRL>(send); } } while (0)
    BF_STEP(8, 8, DPP_MIRROR); BF_STEP(4, 4, DPP_HMIRROR); BF_STEP(2, 2, DPP_XOR2); BF_STEP(1, 1, DPP_XOR1);
#undef BF_STEP
    return swap32_sum(swap16_sum(dd[0]));
}
#define CE_DESC(a, b) do { const float _x = fmaxf(a, b), _y = fminf(a, b); a = _x; b = _y; } while (0)
template <int N> __device__ __forceinline__ void bitonic_sort_desc(float (&v)[N]) {
#pragma unroll
    for (int k = 2; k <= N; k <<= 1)
#pragma unroll
        for (int j = k >> 1; j > 0; j >>= 1)
#pragma unroll
            for (int i = 0; i < N; ++i) { const int l = i ^ j; if (l > i) { if ((i & k) == 0) { CE_DESC(v[i], v[l]); } else { CE_DESC(v[l], v[i]); } } }
}
__device__ __forceinline__ void merge_top16(float (&a)[16], const float (&b)[16]) {
#pragma unroll
    for (int i = 0; i < 16; ++i) a[i] = fmaxf(a[i], b[15 - i]);
#pragma unroll
    for (int j = 8; j > 0; j >>= 1)
#pragma unroll
        for (int i = 0; i < 16; ++i) { const int l = i ^ j; if (l > i) CE_DESC(a[i], a[l]); }
}

__device__ __forceinline__ int win_src_col(int n) {
    const int tile = n >> 8, w = n & 255;
    if (tile < 4) { const int p = w & 127, hd = tile * 2 + (w >> 7), q = p >> 3, e = p & 7; const int d = e < 4 ? 4 * q + e : 64 + 4 * q + (e - 4); return hd * 128 + d; }
    if (tile < 10) { const int idx = tile - 4, g = w >> 7, p = w & 127; int d = p; if (idx == 2 || idx == 4) { const int q = p >> 3, e = p & 7; d = e < 4 ? 4 * q + e : 64 + 4 * q + (e - 4); } return 1024 + idx * 256 + g * 128 + d; }
    if (tile < 22) return 2584 + (n - 2560);
    if (tile < 38) { const int j = tile - 22; return w < 128 ? 5664 + 128 * j + w : 7712 + 128 * j + (w - 128); }
    if (w < 24) return 2560 + w;
    if (w < 32) return 5656 + (w - 24);
    return -1;
}
template <int MAPKIND, bool OUT8>
__device__ __forceinline__ void transpose_tile_w(const float* __restrict__ src, int ld_src, const float* __restrict__ gain, void* __restrict__ dstv, int ld_dst, int k0, int n0, float* tl, int lane, float scale) {
    const int sc = MAPKIND == 1 ? win_src_col(n0 + lane) : n0 + lane;
    const float* sp = src + (size_t)k0 * ld_src + (sc >= 0 ? sc : 0);
#pragma unroll 1
    for (int kb = 0; kb < 64; kb += 32) {
        float v[32];
#pragma unroll
        for (int i = 0; i < 32; ++i) v[i] = sp[(size_t)(kb + i) * ld_src];
#pragma unroll
        for (int i = 0; i < 32; ++i) { float x = sc >= 0 ? v[i] * scale : 0.f; if (gain) x *= gain[k0 + kb + i]; tl[(kb + i) * 65 + lane] = x; }
    }
    asm volatile("s_waitcnt lgkmcnt(0)" ::: "memory"); __builtin_amdgcn_wave_barrier();
    if constexpr (OUT8) {
        unsigned char* dst = (unsigned char*)dstv; const int kq = (lane & 3) * 16, rq = lane >> 2;
#pragma unroll
        for (int r = 0; r < 4; ++r) { const int n2 = r * 16 + rq; u32x4 w;
#pragma unroll
            for (int q = 0; q < 4; ++q) w[q] = pack_fp8x4(tl[(kq + 4 * q + 0) * 65 + n2], tl[(kq + 4 * q + 1) * 65 + n2], tl[(kq + 4 * q + 2) * 65 + n2], tl[(kq + 4 * q + 3) * 65 + n2]);
            *(u32x4*)(dst + (size_t)(n0 + n2) * ld_dst + k0 + kq) = w; }
    } else {
        bf16_t* dst = (bf16_t*)dstv; const int kq = (lane & 15) * 4, rq = lane >> 4;
#pragma unroll 4
        for (int r = 0; r < 16; ++r) { const int n2 = r * 4 + rq;
            u32x2 w; w.x = cvtpk(tl[(kq + 0) * 65 + n2], tl[(kq + 1) * 65 + n2]); w.y = cvtpk(tl[(kq + 2) * 65 + n2], tl[(kq + 3) * 65 + n2]);
            *(u32x2*)(dst + (size_t)(n0 + n2) * ld_dst + k0 + kq) = w; }
    }
    asm volatile("s_waitcnt lgkmcnt(0)" ::: "memory"); __builtin_amdgcn_wave_barrier();
}
template <int MAPKIND, bool OUT8>
__device__ __forceinline__ void transpose_job(const float* src, int ld_src, int K, const float* gain, void* dst, int ld_dst, int N_dst, float* tl, int& jb, int gw, int nw, int lane, float scale) {
    const int nkt = K / 64, nnt = N_dst / 64, total = nkt * nnt;
    for (int j = (gw + nw - (jb % nw)) % nw; j < total; j += nw) {
        const int nt = j % nnt, kt = j / nnt;
        transpose_tile_w<MAPKIND, OUT8>(src, ld_src, gain, dst, ld_dst, kt * 64, nt * 64, tl, lane, scale);
    }
    jb += total;
}

#ifndef LATE_ROWS_N
#define LATE_ROWS_N 3072
#endif
constexpr int LATE_ROWS = LATE_ROWS_N;
__device__ __forceinline__ void convert_expert_rows(const Params& p, int r0, int r1, int lane) {
    const float* g2 = p.in[15];
    unsigned char* E8 = p.ws + OFF_ED; float* scl = (float*)(p.ws + OFF_ESCL);
    f32x4 v[2][2][4]; float mx[2] = {0.f, 0.f};
#pragma unroll
    for (int u = 0; u < 2; ++u) { const int r = u ? r1 : r0; const int which = r >> 14, e = r & 16383; const float* src = p.in[19 + which] + (size_t)e * 2048;
#pragma unroll
        for (int j = 0; j < 2; ++j)
#pragma unroll
            for (int q = 0; q < 4; ++q) v[u][j][q] = *(const f32x4*)(src + j * 1024 + lane * 16 + q * 4); }
#pragma unroll
    for (int u = 0; u < 2; ++u) { const int r = u ? r1 : r0; const int which = r >> 14, e = r & 16383;
#pragma unroll
        for (int j = 0; j < 2; ++j)
#pragma unroll
            for (int q = 0; q < 4; ++q) { f32x4 t = v[u][j][q]; if (which == 0) t *= *(const f32x4*)(g2 + j * 1024 + lane * 16 + q * 4); v[u][j][q] = t;
                mx[u] = fmaxf(mx[u], fmaxf(fmaxf(fabsf(t[0]), fabsf(t[1])), fmaxf(fabsf(t[2]), fabsf(t[3])))); }
        mx[u] = wave_max(mx[u]);
        if (which == 0) {
            const float rowmax = fmaxf(mx[u], 1e-30f);
            unsigned char* rec = E8 + (size_t)e * 1152; u32x4 w; unsigned rbs = 0u;
            {
                float gm = 0.f;
#pragma unroll
                for (int j = 0; j < 2; ++j)
#pragma unroll
                    for (int q = 0; q < 4; ++q) gm = fmaxf(gm, fmaxf(fmaxf(fabsf(v[u][j][q][0]), fabsf(v[u][j][q][1])), fmaxf(fabsf(v[u][j][q][2]), fabsf(v[u][j][q][3]))));
                float rbf = __builtin_ceilf(gm * (255.0f / rowmax)); rbf = fminf(fmaxf(rbf, 1.0f), 255.0f);
                const float inv = (255.0f * 7.0f) / (rowmax * rbf);
#pragma unroll
                for (int j = 0; j < 2; ++j) { unsigned nb[2] = {0u, 0u};
#pragma unroll
                    for (int q = 0; q < 4; ++q)
#pragma unroll
                        for (int i = 0; i < 4; ++i) { const float t = fminf(fmaxf(__builtin_rintf(v[u][j][q][i] * inv), -7.f), 7.f); const unsigned nib = (unsigned)(int)t & 15u; const int el = q * 4 + i;
                            nb[el >> 3] |= nib << (4 * (el & 7)); }
                    w[2 * j] = nb[0]; w[2 * j + 1] = nb[1]; }
                rbs = (unsigned)rbf;
            }
            *(u32x4*)(rec + lane * 16) = w;
            *(unsigned short*)(rec + 1024 + lane * 2) = (unsigned short)rbs;
            if (lane == 0) scl[e] = rowmax * (1.0f / (255.0f * 7.0f));
            continue;
        }
        const float sc = fmaxf(mx[u], 1e-30f) * (1.0f / 7.5f), inv = 1.0f / sc;
        unsigned w6[7] = {0u, 0u, 0u, 0u, 0u, 0u, 0u};
#pragma unroll
        for (int j = 0; j < 2; ++j)
#pragma unroll
            for (int q = 0; q < 4; ++q)
#pragma unroll
                for (int i = 0; i < 4; ++i) { const float t = v[u][j][q][i] * inv; const float a = fminf(fabsf(t), 7.5f);
                    const float c1 = __builtin_rintf(a * 8.0f), c2 = __builtin_rintf(a * 4.0f) + 8.0f, c3 = __builtin_rintf(a * 2.0f) + 16.0f;
                    const unsigned code = (unsigned)(int)(a < 2.0f ? c1 : (a < 4.0f ? c2 : c3)) | ((__float_as_uint(t) >> 31) << 5);
                    const int bit = 6 * (j * 16 + q * 4 + i), d = bit >> 5, sh = bit & 31;
                    w6[d] |= code << sh; if (sh > 26) w6[d + 1] |= code >> (32 - sh); }
        { unsigned char* rec = E8 + (size_t)which * (16384 * 2048) + (size_t)e * 1536;
          *(u32x4*)(rec + lane * 16) = (u32x4){w6[0], w6[1], w6[2], w6[3]}; *(u32x2*)(rec + 1024 + lane * 8) = (u32x2){w6[4], w6[5]}; }
        if (lane == 0) scl[which * 16384 + e] = sc; }
}

__device__ __forceinline__ void phase_prep(const Params& p, unsigned char* lds_raw) {
    const int tid = tid_opaque(), wid = tid >> 6, lane = tid & 63;
    float* tl = (float*)lds_raw + wid * (64 * 65);
    const int gw = blockIdx.x * 8 + wid, nw = gridDim.x * 8;
    unsigned char* ws = p.ws;
#ifndef P0_REP_A
#define P0_REP_A 1
#define P0_REP_B 1
#define P0_REP_C 1
#endif
    for (int rep = 0; rep < P0_REP_A; ++rep) {
        const float* x = p.in[0]; unsigned char* xb = ws + OFF_XB; float* ssq1 = (float*)(ws + OFF_MISC + M_SSQ1);
        for (int r = gw; r < T_TOK; r += 2 * nw) {
            const int r2 = r + nw < T_TOK ? r + nw : r;
            f32x4 va[8], vb[8];
#pragma unroll
            for (int j = 0; j < 8; ++j) { va[j] = *(const f32x4*)(x + (size_t)r * DM + j * 256 + lane * 4); vb[j] = *(const f32x4*)(x + (size_t)r2 * DM + j * 256 + lane * 4); }
            float sa = 0.f, sb = 0.f;
#pragma unroll
            for (int j = 0; j < 8; ++j) { const f32x4 v = va[j]; sa += v[0] * v[0] + v[1] * v[1] + v[2] * v[2] + v[3] * v[3];
                *(unsigned*)(xb + (size_t)r * DM + j * 256 + lane * 4) = pack_fp8x4(v[0] * SC_X, v[1] * SC_X, v[2] * SC_X, v[3] * SC_X); }
#pragma unroll
            for (int j = 0; j < 8; ++j) { const f32x4 v = vb[j]; sb += v[0] * v[0] + v[1] * v[1] + v[2] * v[2] + v[3] * v[3];
                *(unsigned*)(xb + (size_t)r2 * DM + j * 256 + lane * 4) = pack_fp8x4(v[0] * SC_X, v[1] * SC_X, v[2] * SC_X, v[3] * SC_X); }
            sa = wave_sum(sa); sb = wave_sum(sb); if (lane == 0) { ssq1[r] = sa; ssq1[r2] = sb; }
        }
    }
    for (int rep = 0; rep < P0_REP_B; ++rep) {
        int jb = 0;
        transpose_job<1, true>(p.in[2], 9760, 2048, p.in[1], ws + OFF_WINT, 2048, NWIN, tl, jb, gw, nw, lane, SC_WIN);
        transpose_job<0, true>(p.in[12], 2048, 1024, nullptr, ws + OFF_WUPT, 2048, 2048, tl, jb, gw, nw, lane, SC_WUP);
        transpose_job<0, true>(p.in[13], 2048, 1024, nullptr, ws + OFF_WUPT + 1024, 2048, 2048, tl, jb, gw, nw, lane, SC_WUP);
        transpose_job<0, true>(p.in[14], 2048, 2048, nullptr, ws + OFF_WOUTT, 2048, 2048, tl, jb, gw, nw, lane, SC_WOUT);
        transpose_job<0, false>(p.in[16], 2048, 2048, p.in[15], ws + OFF_WQT, 2048, 2048, tl, jb, gw, nw, lane, 1.0f);
        transpose_job<0, false>(p.in[7], 256, 4096, nullptr, ws + OFF_W1T, 4096, 256, tl, jb, gw, nw, lane, 1.0f);
        transpose_job<0, false>(p.in[10], 256, 4096, nullptr, ws + OFF_W1T + (size_t)256 * 4096 * 2, 4096, 256, tl, jb, gw, nw, lane, 1.0f);
    }
    {
        const int nrows0 = 2 * 16384 - (gridDim.x == 256 ? LATE_ROWS : 0);
        for (int r0 = gw; r0 < nrows0; r0 += 2 * nw) convert_expert_rows(p, r0, r0 + nw < nrows0 ? r0 + nw : r0, lane);
    }
#ifndef P0_REP_D
#define P0_REP_D 1
#define P0_REP_E 1
#define P0_REP_F 1
#endif
    for (int rep = 0; rep < P0_REP_D; ++rep) {
        bf16_t* K12 = (bf16_t*)(ws + OFF_MISC + M_K12);
        for (int i = blockIdx.x * 512 + tid; i < 2 * 131072 / 4; i += gridDim.x * 512) {
            const int which = i >= 32768, j = (i & 32767) * 4; const f32x4 v = *(const f32x4*)(p.in[17 + which] + j);
            u32x2 w; w.x = cvtpk(v[0], v[1]); w.y = cvtpk(v[2], v[3]); *(u32x2*)(K12 + which * 131072 + j) = w; }
    }
    for (int rep = 0; rep < P0_REP_E; ++rep) {
        f32x2* cs = (f32x2*)(ws + OFF_MISC + M_ROPE);
        for (int i = blockIdx.x * 512 + tid; i < 2048 * 64; i += gridDim.x * 512) {
            const int pos = i >> 6, f = i & 63; const float inv = exp2f(-(float)f * (13.287712379549449f / 64.0f));
            const float ang = (float)pos * inv;
            const float CH = 1.5915493667e-01f, CL = 6.4206383266e-09f;
            const float rev_hi = ang * CH; const float rev_lo = fmaf(ang, CH, -rev_hi) + ang * CL;
            float r = rev_hi - rintf(rev_hi); r += rev_lo;
            cs[i] = (f32x2){__builtin_amdgcn_cosf(r), __builtin_amdgcn_sinf(r)}; }
    }
    for (int rep = 0; rep < P0_REP_F; ++rep) {
        float* b1p = (float*)(ws + OFF_MISC + M_B1P);
        float* red = (float*)lds_raw;
        for (int j = blockIdx.x; j < 128; j += gridDim.x) { const int which = j >> 6, part = j & 63;
            const float* pos = p.in[which ? 9 : 6]; const float* w1 = p.in[which ? 10 : 7];
            f32x4 s = {0.f, 0.f, 0.f, 0.f};
#pragma unroll
            for (int i = 0; i < 8; ++i) { const int k = part * 64 + wid * 8 + i; s += *(const f32x4*)(w1 + (size_t)k * 256 + lane * 4) * pos[k]; }
            __syncthreads();
            *(f32x4*)(red + wid * 256 + lane * 4) = s;
            __syncthreads();
            if (tid < 256) { float t = 0.f;
#pragma unroll
                for (int w = 0; w < 8; ++w) t += red[w * 256 + tid];
                b1p[(which * 64 + part) * 256 + tid] = t; }
        }
        __syncthreads();
    }
    if (blockIdx.x == 0 && tid < 64) ((unsigned*)(ws + OFF_MISC + M_CTL))[tid] = 0u;
}
namespace pg8 {
constexpr int BM = 256, BK = 64, HALF = 128, HTB = HALF * BK * 2, STAGE_BYTES = 8 * HTB, NXCD = 8;
__host__ __device__ __forceinline__ int lds_byte(int r, int c) { const int st = (r >> 4) * 2 + (c >> 5), rr = r & 15, cc = c & 31, ob = rr * 64 + cc * 2; return st * 1024 + (ob ^ (((ob >> 9) & 1) << 5)); }
__host__ __device__ __forceinline__ void stage_rc(int b, int& R, int& C) { const int st = b / 1024, sb = b % 1024, swz = sb ^ (((sb >> 9) & 1) << 5); R = (st >> 1) * 16 + swz / 64; C = (st & 1) * 32 + (swz % 64) / 2; }
__host__ __device__ __forceinline__ int perm32(int rho) { const int n = rho >> 4, i = rho & 15; return 8 * (i >> 2) + 4 * n + (i & 3); }

constexpr int UF_ZERO = 1, UF_FINAL = 2;
struct Unit { const char* A; const char* B; int pm, pn, flags, aux; };

__device__ __forceinline__ bool static_tile(int L, int nM, int nN, int& pm, int& pn, int WGM) {
    const int nwg = nM * nN; if (L >= nwg) return false;
    int wgid = L; { const int q = nwg / NXCD, r = nwg % NXCD, xcd = wgid % NXCD, off = wgid / NXCD; wgid = (xcd < r ? xcd * (q + 1) : r * (q + 1) + (xcd - r) * q) + off; }
    const int nig = WGM * nN, gid = wgid / nig, fm = gid * WGM, gsz = (nM - fm) < WGM ? (nM - fm) : WGM;
    pm = fm + ((wgid % nig) % gsz); pn = (wgid % nig) / gsz; return true;
}

typedef int i32x8 __attribute__((ext_vector_type(8)));
__device__ __forceinline__ i32x8 cat8(const bf16x8 a, const bf16x8 b) { const u32x4 x = __builtin_bit_cast(u32x4, a), y = __builtin_bit_cast(u32x4, b); return (i32x8){(int)x[0], (int)x[1], (int)x[2], (int)x[3], (int)y[0], (int)y[1], (int)y[2], (int)y[3]}; }
template <bool FP8, bool NOEPI = false, class Epi, class Sched>
__device__ __forceinline__ void gemm_phase(LAS unsigned char* lds, const int K, const int lda, const int ldb, const Sched& S, const Epi& E) {
    int tid = threadIdx.x; asm volatile("" : "+v"(tid));
    const int wid = __builtin_amdgcn_readfirstlane(tid >> 6), lane = tid & 63, wr = wid >> 2, wc = wid & 3, fr = lane & 15, fq = lane >> 4;
    int nt = K / BK; asm volatile("" : "+s"(nt));
    unsigned voffA[2], voffB[2];
#pragma unroll
    for (int i = 0; i < 2; ++i) { int R, C; stage_rc(tid * 16 + i * 8192, R, C); const int Rb = (R & ~31) + perm32(R & 31);
        voffA[i] = (unsigned)(R * lda + C) * 2u; voffB[i] = (unsigned)(Rb * ldb + C) * 2u; }
    const size_t kstep = (size_t)(BK * 2);
    const size_t hsA = (size_t)HALF * lda * 2, hsB = (size_t)HALF * ldb * 2;
    const unsigned ldsw = (unsigned)wid * 1024u;
    const int aoff = lds_byte(wr * 64 + fr, fq * 8), boff = lds_byte(wc * 32 + fr, fq * 8);
#define PG8_SA(b, h) (((b) * 2 + (h)) * HTB)
#define PG8_SB(b, h) ((4 + (b) * 2 + (h)) * HTB)
#define PG8_STAGE(bufoff, gbase, voff) do { _Pragma("unroll") for (int _i = 0; _i < 2; ++_i) \
        __builtin_amdgcn_global_load_lds((const unsigned*)((const char*)(gbase) + (voff)[_i]), (LAS unsigned*)(lds + (bufoff) + ldsw + _i * 8192), 16, 0, 0); } while (0)
#define PG8_LDA(dst, b, h) do { _Pragma("unroll") for (int m = 0; m < 4; ++m) { const u32x4 _l = *(const LAS u32x4*)(lds + PG8_SA(b, h) + aoff + m * 2048), _h = *(const LAS u32x4*)(lds + PG8_SA(b, h) + aoff + m * 2048 + 1024); \
        dst[m] = (i32x8){(int)_l[0], (int)_l[1], (int)_l[2], (int)_l[3], (int)_h[0], (int)_h[1], (int)_h[2], (int)_h[3]}; } } while (0)
#define PG8_LDB(dst, b, h) do { _Pragma("unroll") for (int n = 0; n < 2; ++n) { const u32x4 _l = *(const LAS u32x4*)(lds + PG8_SB(b, h) + boff + n * 2048), _h = *(const LAS u32x4*)(lds + PG8_SB(b, h) + boff + n * 2048 + 1024); \
        dst[n] = (i32x8){(int)_l[0], (int)_l[1], (int)_l[2], (int)_l[3], (int)_h[0], (int)_h[1], (int)_h[2], (int)_h[3]}; } } while (0)
#define PG8_LO(v) __builtin_bit_cast(bf16x8, (u32x4){(unsigned)(v)[0], (unsigned)(v)[1], (unsigned)(v)[2], (unsigned)(v)[3]})
#define PG8_HI(v) __builtin_bit_cast(bf16x8, (u32x4){(unsigned)(v)[4], (unsigned)(v)[5], (unsigned)(v)[6], (unsigned)(v)[7]})
#define PG8_MMA(ai, bj, At, Bt) do { __builtin_amdgcn_s_setprio(1); \
        if constexpr (FP8) { _Pragma("unroll") for (int m = 0; m < 4; ++m) _Pragma("unroll") for (int n = 0; n < 2; ++n) \
            asm volatile("v_mfma_scale_f32_16x16x128_f8f6f4 %0, %1, %2, %0, %3, %3 op_sel_hi:[0,0,0]" : "+v"(acc[ai][bj][m][n]) : "v"(Bt[n]), "v"(At[m]), "v"(mxscale)); } \
        else { _Pragma("unroll") for (int m = 0; m < 4; ++m) _Pragma("unroll") for (int n = 0; n < 2; ++n) { \
            acc[ai][bj][m][n] = __builtin_amdgcn_mfma_f32_16x16x32_bf16(PG8_LO(Bt[n]), PG8_LO(At[m]), acc[ai][bj][m][n], 0, 0, 0); \
            acc[ai][bj][m][n] = __builtin_amdgcn_mfma_f32_16x16x32_bf16(PG8_HI(Bt[n]), PG8_HI(At[m]), acc[ai][bj][m][n], 0, 0, 0); } } \
        __builtin_amdgcn_s_setprio(0); } while (0)
#define PG8_WAIT_V(n) asm volatile("s_waitcnt vmcnt(" #n ")" ::: "memory")
#define PG8_WAIT_L(n) asm volatile("s_waitcnt lgkmcnt(" #n ")" ::: "memory")
#define PG8_BAR __builtin_amdgcn_s_barrier()
#define PG8_SCHED __builtin_amdgcn_sched_barrier(0)
    Unit cur, nxt; int ui = 0; bool prestaged = false;
    if (!S.next(0, cur)) return;
    f32x4 acc[2][2][4][2];
#pragma unroll
    for (int a = 0; a < 2; ++a)
#pragma unroll
        for (int b = 0; b < 2; ++b)
#pragma unroll
            for (int m = 0; m < 4; ++m)
#pragma unroll
                for (int n = 0; n < 2; ++n) acc[a][b][m][n] = (f32x4){0.f, 0.f, 0.f, 0.f};
    i32x8 At[4], B0[2], B1[2];
    int mxscale = 0x7F7F7F7F; asm volatile("" : "+v"(mxscale));
    const char* cA = cur.A; const char* cB = cur.B;
    PG8_STAGE(PG8_SB(0, 0), cB, voffB); PG8_STAGE(PG8_SA(0, 0), cA, voffA); PG8_STAGE(PG8_SB(0, 1), cB + hsB, voffB); PG8_STAGE(PG8_SA(0, 1), cA + hsA, voffA);
    if (wr == 1) PG8_BAR;
    PG8_WAIT_V(4); PG8_BAR;
    PG8_STAGE(PG8_SB(1, 0), cB + kstep, voffB); PG8_STAGE(PG8_SA(1, 0), cA + kstep, voffA); PG8_STAGE(PG8_SB(1, 1), cB + hsB + kstep, voffB);
    PG8_WAIT_V(6); PG8_BAR;
    for (;;) {
        const bool has_next = S.next(ui + 1, nxt);
        const char* nA = has_next ? nxt.A : cA; const char* nB = has_next ? nxt.B : cB;
#pragma unroll 1
        for (int t = 0; t < nt; t += 2) {
            const bool last = (t == nt - 2);
            const char* a1 = cA + (size_t)(t + 1) * kstep;
            const char* a2 = last ? nA : cA + (size_t)(t + 2) * kstep; const char* b2 = last ? nB : cB + (size_t)(t + 2) * kstep;
            const char* a3 = a2 + kstep; const char* b3 = b2 + kstep;
            PG8_LDB(B0, 0, 0); PG8_SCHED; PG8_LDA(At, 0, 0); if (!(prestaged && t == 0)) PG8_STAGE(PG8_SA(1, 1), a1 + hsA, voffA);
            PG8_WAIT_L(8); PG8_BAR; PG8_WAIT_L(0); PG8_MMA(0, 0, At, B0); PG8_BAR; PG8_SCHED;
            PG8_LDB(B1, 0, 1); PG8_STAGE(PG8_SB(0, 0), b2, voffB);
            PG8_BAR; PG8_WAIT_L(0); PG8_MMA(0, 1, At, B1); PG8_BAR;
            PG8_LDA(At, 0, 1); PG8_STAGE(PG8_SA(0, 0), a2, voffA);
            PG8_BAR; PG8_WAIT_L(0); PG8_MMA(1, 0, At, B0); PG8_BAR; PG8_SCHED;
            PG8_STAGE(PG8_SB(0, 1), b2 + hsB, voffB);
            if (prestaged && t == 0) { PG8_WAIT_V(63); } else { PG8_WAIT_V(6); }
            PG8_BAR; PG8_MMA(1, 1, At, B1); PG8_BAR;
            PG8_LDB(B0, 1, 0); PG8_SCHED; PG8_LDA(At, 1, 0); PG8_STAGE(PG8_SA(0, 1), a2 + hsA, voffA);
            PG8_WAIT_L(8); PG8_BAR; PG8_WAIT_L(0); PG8_MMA(0, 0, At, B0); PG8_BAR; PG8_SCHED;
            PG8_LDB(B1, 1, 1); PG8_STAGE(PG8_SB(1, 0), b3, voffB);
            PG8_BAR; PG8_WAIT_L(0); PG8_MMA(0, 1, At, B1); PG8_BAR;
            PG8_LDA(At, 1, 1); PG8_STAGE(PG8_SA(1, 0), a3, voffA);
            PG8_BAR; PG8_WAIT_L(0); PG8_MMA(1, 0, At, B0); PG8_BAR; PG8_SCHED;
            PG8_STAGE(PG8_SB(1, 1), b3 + hsB, voffB);
            PG8_WAIT_V(6); PG8_BAR; PG8_MMA(1, 1, At, B1); PG8_BAR;
        }
        if constexpr (FP8) asm volatile("s_nop 15\n\ts_nop 15" ::: "memory");
        prestaged = false;
        if (Epi::WAITS_ON_READS && !NOEPI && has_next) {
            PG8_STAGE(PG8_SA(1, 1), nA + kstep + hsA, voffA); asm volatile("" ::: "memory"); PG8_SCHED; prestaged = true; }
        if constexpr (!NOEPI) E(acc, cur, wr, wc, fr, fq);
        if (!has_next) break;
        if (nxt.flags & UF_ZERO) {
#pragma unroll
            for (int a = 0; a < 2; ++a)
#pragma unroll
                for (int b = 0; b < 2; ++b)
#pragma unroll
                    for (int m = 0; m < 4; ++m)
#pragma unroll
                        for (int n = 0; n < 2; ++n) acc[a][b][m][n] = (f32x4){0.f, 0.f, 0.f, 0.f};
        }
        cur = nxt; cA = nA; cB = nB; ++ui;
    }
    PG8_WAIT_V(0);
    if (wr == 0) PG8_BAR;
    PG8_BAR;
#undef PG8_SA
#undef PG8_SB
#undef PG8_STAGE
#undef PG8_LDA
#undef PG8_LDB
#undef PG8_MMA
#undef PG8_LO
#undef PG8_HI
#undef PG8_WAIT_V
#undef PG8_WAIT_L
#undef PG8_BAR
#undef PG8_SCHED
}
}
using pg8::Unit;

#ifndef WGM_G1
#define WGM_G1 4
#define WGM_SQ 4
#endif
#ifndef WGM_P6
#define WGM_P6 WGM_SQ
#endif
#ifndef WGM_P7
#define WGM_P7 WGM_SQ
#endif
#ifndef WGM_P8
#define WGM_P8 WGM_SQ
#endif
struct SchedGemm1 {
    const char* A; const char* B; int G, c;
    __device__ __forceinline__ bool next(int i, Unit& u) const { int pm, pn; if (!pg8::static_tile(i * G + c, 64, 39, pm, pn, WGM_G1)) return false;
        u.A = A + (size_t)pm * 256 * 2048; u.B = B + (size_t)pn * 256 * 2048; u.pm = pm; u.pn = pn; u.flags = pg8::UF_ZERO | pg8::UF_FINAL; u.aux = 0; return true; }
};
struct SchedSquare {
    const char* A; const char* B; int G, c; int rb;
    __device__ __forceinline__ bool next(int i, Unit& u) const { int pm, pn; if (!pg8::static_tile(i * G + c, 64, 8, pm, pn, rb == 2048 ? WGM_P7 : WGM_P8)) return false;
        u.A = A + (size_t)pm * 256 * rb; u.B = B + (size_t)pn * 256 * rb; u.pm = pm; u.pn = pn; u.flags = pg8::UF_ZERO | pg8::UF_FINAL; u.aux = 0; return true; }
};
struct SchedMerge {
    const char* A; const char* B; int G, c;
    __device__ __forceinline__ bool next(int i, Unit& u) const { int pm, pn; if (!pg8::static_tile((i >> 1) * G + c, 64, 8, pm, pn, WGM_P6)) return false; const int w = i & 1;
        u.A = A + (size_t)pm * 256 * 2048 + (size_t)w * 1024; u.B = B + (size_t)pn * 256 * 2048 + (size_t)w * 1024; u.pm = pm; u.pn = pn; u.flags = w ? pg8::UF_FINAL : pg8::UF_ZERO; u.aux = w; return true; }
};
struct SchedCompress {
    const char* Ak; const char* Av; const char* B; int G, c;
    __device__ __forceinline__ bool next(int i, Unit& u) const { const int L = i * G + c; if (L >= 128) return false; const int which = L >> 6, mt = (L >> 3) & 7, ks = L & 7;
        u.A = (which ? Av : Ak) + (size_t)mt * 256 * 2048 * 2 + (size_t)ks * 512 * 2; u.B = B + (size_t)which * 256 * 4096 * 2 + (size_t)ks * 512 * 2; u.pm = mt; u.pn = 0; u.flags = pg8::UF_ZERO | pg8::UF_FINAL; u.aux = which * 8 + ks; return true; }
};

#define EPI_LOOP_AI_M for (int ai = 0; ai < 2; ++ai) for (int m = 0; m < 4; ++m)
struct EpiGemm1 {
    static constexpr bool WAITS_ON_READS = true;
    int st; unsigned char* ws; float* gate_out  ; const float* nsa_gb; const float* fox_fb; const float* merge_gb;
    __device__ __forceinline__ void operator()(f32x4 (&acc)[2][2][4][2], const Unit& u, int wr, int wc, int fr, int fq) const {
        const float* ssq1 = (const float*)(ws + OFF_MISC + M_SSQ1);
        const int pn = u.pn;
        const int p0 = wc * 32 + fq * 8;
        const int rbase = u.pm * 256 + wr * 64 + fr;
        float rsv[2][4];
#pragma unroll
        for (int ai = 0; ai < 2; ++ai)
#pragma unroll
            for (int m = 0; m < 4; ++m) rsv[ai][m] = __builtin_amdgcn_rsqf(ssq1[rbase + ai * 128 + m * 16] * (1.0f / 2048.0f) + NORM_EPS) * (1.0f / (SC_X * SC_WIN));
        asm volatile("" :: "v"(rsv[0][0]));
        if (pn < 10) {
            const bool rope = pn < 4 || pn == 6 || pn == 8;
            const f32x2* cs = (const f32x2*)(ws + OFF_MISC + M_ROPE) + 4 * (p0 >> 3);
            bf16_t* dbase = pn < 4 ? (bf16_t*)(ws + OFF_QN) + (size_t)(pn * 2) * 2048 * 128 + p0 : (bf16_t*)(ws + OFF_KV6) + (size_t)(pn - 4) * (16 * 2048 * 128) + p0;
            const int hmul = pn < 4 ? 8 : 2;
            f32x4 cc[2][4][2];
#pragma unroll
            for (int ai = 0; ai < 2; ++ai)
#pragma unroll
                for (int m = 0; m < 4; ++m) { const int s = (rbase + ai * 128 + m * 16) & 2047;
                    cc[ai][m][0] = *(const f32x4*)(cs + s * 64); cc[ai][m][1] = *(const f32x4*)(cs + s * 64 + 2); }
#pragma unroll
            for (int ai = 0; ai < 2; ++ai)
#pragma unroll
                for (int m = 0; m < 4; ++m) {
                    const int r = rbase + ai * 128 + m * 16, b = r >> 11, s = r & 2047; const float rs = rsv[ai][m];
                    const f32x4 c01 = cc[ai][m][0], c23 = cc[ai][m][1];
                    const f32x4 co = rope ? (f32x4){c01[0], c01[2], c23[0], c23[2]} : (f32x4){1.f, 1.f, 1.f, 1.f}, si = rope ? (f32x4){c01[1], c01[3], c23[1], c23[3]} : (f32x4){0.f, 0.f, 0.f, 0.f};
#pragma unroll
                    for (int bj = 0; bj < 2; ++bj) {
                        const f32x4 x1 = acc[ai][bj][m][0] * rs, x2 = acc[ai][bj][m][1] * rs;
                        const f32x4 y1 = x1 * co - x2 * si, y2 = x2 * co + x1 * si;
                        u32x4 w; w.x = cvtpk(y1[0], y1[1]); w.y = cvtpk(y1[2], y1[3]); w.z = cvtpk(y2[0], y2[1]); w.w = cvtpk(y2[2], y2[3]);
                        if (st) *(u32x4*)(dbase + ((size_t)(b * hmul + bj) * 2048 + s) * 128) = w;
                    }
                }
        } else if (pn < 22) {
            const int idx = (pn - 10) >> 2, hb = ((pn - 10) & 3) * 2;
            bf16_t* dbase = (bf16_t*)(ws + OFF_QKVF) + (size_t)idx * (64 * 2048 * 128) + (size_t)hb * 2048 * 128 + p0;
#pragma unroll
            for (int ai = 0; ai < 2; ++ai)
#pragma unroll
                for (int m = 0; m < 4; ++m) {
                    const int r = rbase + ai * 128 + m * 16, b = r >> 11, s = r & 2047; const float rs = rsv[ai][m];
#pragma unroll
                    for (int bj = 0; bj < 2; ++bj) {
                        const f32x4 x1 = acc[ai][bj][m][0] * rs, x2 = acc[ai][bj][m][1] * rs;
                        u32x4 w; w.x = cvtpk(x1[0], x1[1]); w.y = cvtpk(x1[2], x1[3]); w.z = cvtpk(x2[0], x2[1]); w.w = cvtpk(x2[2], x2[3]);
                        if (st) *(u32x4*)(dbase + ((size_t)(b * 8 + bj) * 2048 + s) * 128) = w;
                    }
                }
        } else if (pn < 38) {
            const int col = (pn - 22) * 128 + p0;
            const f32x4 ba0 = *(const f32x4*)(merge_gb + col), ba1 = *(const f32x4*)(merge_gb + col + 4), bb0 = *(const f32x4*)(merge_gb + 2048 + col), bb1 = *(const f32x4*)(merge_gb + 2048 + col + 4);
            unsigned char* g0 = (unsigned char*)gate_out + col;
#pragma unroll
            for (int ai = 0; ai < 2; ++ai)
#pragma unroll
                for (int m = 0; m < 4; ++m) {
                    const int r = rbase + ai * 128 + m * 16; const float rs = rsv[ai][m];
                    float ra[8], gb[8];
#pragma unroll
                    for (int i = 0; i < 4; ++i) {
                        const float za0 = __builtin_amdgcn_fmed3f(acc[ai][0][m][0][i] * rs + ba0[i], -40.f, 40.f), zb0 = __builtin_amdgcn_fmed3f(acc[ai][1][m][0][i] * rs + bb0[i], -40.f, 40.f);
                        const float za1 = __builtin_amdgcn_fmed3f(acc[ai][0][m][1][i] * rs + ba1[i], -40.f, 40.f), zb1 = __builtin_amdgcn_fmed3f(acc[ai][1][m][1][i] * rs + bb1[i], -40.f, 40.f);
                        const float ta0 = 1.0f + __builtin_amdgcn_exp2f(-LOG2E * za0), tb0 = 1.0f + __builtin_amdgcn_exp2f(-LOG2E * zb0), ta1 = 1.0f + __builtin_amdgcn_exp2f(-LOG2E * za1), tb1 = 1.0f + __builtin_amdgcn_exp2f(-LOG2E * zb1);
                        const float q0 = __builtin_amdgcn_rcpf(ta0 * tb0), q1 = __builtin_amdgcn_rcpf(ta1 * tb1);
                        ra[i] = tb0 * tb0 * q0; gb[i] = ta0 * q0; ra[4 + i] = tb1 * tb1 * q1; gb[4 + i] = ta1 * q1; }
                    const u32x2 w = {pack_fp8x4(ra[0], ra[1], ra[2], ra[3]), pack_fp8x4(ra[4], ra[5], ra[6], ra[7])};
                    const u32x2 y = {pack_fp8x4(gb[0] * 256.f, gb[1] * 256.f, gb[2] * 256.f, gb[3] * 256.f), pack_fp8x4(gb[4] * 256.f, gb[5] * 256.f, gb[6] * 256.f, gb[7] * 256.f)};
                    if (st) { *(u32x2*)(g0 + (size_t)r * 2048) = w; *(u32x2*)(g0 + (size_t)T_TOK * 2048 + (size_t)r * 2048) = y; }
                }
        } else if (wc == 0) {
            float* gn = (float*)(ws + OFF_MISC + M_GN); float* lf = (float*)(ws + OFF_MISC + M_LOGF);
            float bias[8];
#pragma unroll
            for (int i = 0; i < 8; ++i) { const int col = fq * 8 + i; bias[i] = col < 24 ? nsa_gb[col] : fox_fb[col - 24]; }
#pragma unroll
            for (int ai = 0; ai < 2; ++ai)
#pragma unroll
                for (int m = 0; m < 4; ++m) {
                    const int r = rbase + ai * 128 + m * 16; const float rs = rsv[ai][m];
#pragma unroll
                    for (int n = 0; n < 2; ++n)
#pragma unroll
                        for (int i = 0; i < 4; ++i) { const float z = acc[ai][0][m][n][i] * rs + bias[n * 4 + i];
                            const float em = __builtin_amdgcn_exp2f(-LOG2E * fabsf(z)), t = 1.0f + em;
                            const float sg = (z >= 0.f ? 1.0f : em) * __builtin_amdgcn_rcpf(t), ls = fminf(z, 0.f) - 0.6931471805599453f * __builtin_amdgcn_logf(t);
                            if (fq < 3) gn[(size_t)r * 24 + fq * 8 + n * 4 + i] = sg;
                            else lf[(size_t)r * 8 + n * 4 + i] = ls; }
                }
        }
    }
};
struct EpiSlab {
    static constexpr bool WAITS_ON_READS = false;
    float* slab;
    __device__ __forceinline__ void operator()(f32x4 (&acc)[2][2][4][2], const Unit& u, int wr, int wc, int fr, int fq) const {
        float* base = slab + (size_t)u.aux * 2048 * 256;
#pragma unroll
        for (int ai = 0; ai < 2; ++ai)
#pragma unroll
            for (int m = 0; m < 4; ++m) { const int r = u.pm * 256 + ai * 128 + wr * 64 + m * 16 + fr;
#pragma unroll
                for (int bj = 0; bj < 2; ++bj) { float* d = base + (size_t)r * 256 + bj * 128 + wc * 32 + fq * 8; *(f32x4*)d = acc[ai][bj][m][0]; *(f32x4*)(d + 4) = acc[ai][bj][m][1]; } }
    }
};
__device__ __forceinline__ u32x4 ldg16(const void* base, unsigned off) { return *(const u32x4*)((const char*)base + off); }
__device__ __forceinline__ f32x4 ldg16f(const void* base, unsigned off) { return *(const f32x4*)((const char*)base + off); }
struct EpiMerge {
    static constexpr bool WAITS_ON_READS = true;
    const unsigned char* gate_r; const unsigned char* gate_b; unsigned char* merged;
    __device__ __forceinline__ void operator()(f32x4 (&acc)[2][2][4][2], const Unit& u, int wr, int wc, int fr, int fq) const {
        const unsigned char* g = u.aux ? gate_b : gate_r;
        const unsigned r0 = (unsigned)(u.pm * 256 + wr * 64 + fr), c0 = (unsigned)(u.pn * 256 + wc * 32 + fq * 8);
        const unsigned o8 = r0 * 2048u + c0;
        u32x2 gv[2][4][2];
#pragma unroll
        for (int ai = 0; ai < 2; ++ai)
#pragma unroll
            for (int m = 0; m < 4; ++m)
#pragma unroll
                for (int bj = 0; bj < 2; ++bj) gv[ai][m][bj] = *(const u32x2*)(g + (o8 + (unsigned)((ai * 128 + m * 16) * 2048 + bj * 128)));
        if (u.aux) {
            const float fs = SC_M / (SC_O * SC_WUP * 256.0f);
#pragma unroll
            for (int ai = 0; ai < 2; ++ai)
#pragma unroll
                for (int m = 0; m < 4; ++m)
#pragma unroll
                    for (int bj = 0; bj < 2; ++bj) { u32x2 v = gv[ai][m][bj]; asm volatile("" : "+v"(v));
                        const f32x2 g0 = __builtin_amdgcn_cvt_pk_f32_fp8((int)v.x, false), g1 = __builtin_amdgcn_cvt_pk_f32_fp8((int)v.x, true), g2 = __builtin_amdgcn_cvt_pk_f32_fp8((int)v.y, false), g3 = __builtin_amdgcn_cvt_pk_f32_fp8((int)v.y, true);
                        const f32x4 a0 = acc[ai][bj][m][0] * fs, a1 = acc[ai][bj][m][1] * fs;
                        *(u32x2*)(merged + (o8 + (unsigned)((ai * 128 + m * 16) * 2048 + bj * 128))) = (u32x2){pack_fp8x4(a0[0] * g0[0], a0[1] * g0[1], a0[2] * g1[0], a0[3] * g1[1]), pack_fp8x4(a1[0] * g2[0], a1[1] * g2[1], a1[2] * g3[0], a1[3] * g3[1])}; }
        } else {
#pragma unroll
            for (int ai = 0; ai < 2; ++ai)
#pragma unroll
                for (int m = 0; m < 4; ++m)
#pragma unroll
                    for (int bj = 0; bj < 2; ++bj) { u32x2 v = gv[ai][m][bj]; asm volatile("" : "+v"(v));
                        const f32x2 g0 = __builtin_amdgcn_cvt_pk_f32_fp8((int)v.x, false), g1 = __builtin_amdgcn_cvt_pk_f32_fp8((int)v.x, true), g2 = __builtin_amdgcn_cvt_pk_f32_fp8((int)v.y, false), g3 = __builtin_amdgcn_cvt_pk_f32_fp8((int)v.y, true);
                        acc[ai][bj][m][0] *= (f32x4){g0[0], g0[1], g1[0], g1[1]}; acc[ai][bj][m][1] *= (f32x4){g2[0], g2[1], g3[0], g3[1]}; }
        }
    }
};
struct EpiOut {
    static constexpr bool WAITS_ON_READS = true;
    const float* x; float* x1; bf16_t* x1b; float* ssq2;
    __device__ __forceinline__ void operator()(f32x4 (&acc)[2][2][4][2], const Unit& u, int wr, int wc, int fr, int fq) const {
        const unsigned r0 = (unsigned)(u.pm * 256 + wr * 64 + fr), c0 = (unsigned)(u.pn * 256 + wc * 32 + fq * 8);
        const unsigned ox = r0 * 8192u + c0 * 4u, ob = r0 * 4096u + c0 * 2u, os = (r0 * 64u + (unsigned)(u.pn * 8 + wc)) * 4u;
#pragma unroll
        for (int ai = 0; ai < 2; ++ai) {
            f32x4 xv[4][2][2];
#pragma unroll
            for (int m = 0; m < 4; ++m)
#pragma unroll
                for (int bj = 0; bj < 2; ++bj) { const unsigned o = ox + (unsigned)((ai * 128 + m * 16) * 8192 + bj * 512); xv[m][bj][0] = ldg16f(x, o); xv[m][bj][1] = ldg16f(x, o + 16u); }
#pragma unroll
            for (int m = 0; m < 4; ++m) {
#pragma unroll
                for (int bj = 0; bj < 2; ++bj) {
                    const f32x4 v0 = xv[m][bj][0] + acc[ai][bj][m][0] * (1.0f / (SC_M * SC_WOUT)), v1 = xv[m][bj][1] + acc[ai][bj][m][1] * (1.0f / (SC_M * SC_WOUT));
                    u32x4 w; w.x = cvtpk(v0[0], v0[1]); w.y = cvtpk(v0[2], v0[3]); w.z = cvtpk(v1[0], v1[1]); w.w = cvtpk(v1[2], v1[3]);
                    *(u32x4*)((char*)x1b + (ob + (unsigned)((ai * 128 + m * 16) * 4096 + bj * 256))) = w;
                    float s = v0[0] * v0[0] + v0[1] * v0[1] + v0[2] * v0[2] + v0[3] * v0[3] + v1[0] * v1[0] + v1[1] * v1[1] + v1[2] * v1[2] + v1[3] * v1[3];
                    s = swap32_sum(swap16_sum(s));
                    if (fq == 0) *(float*)((char*)ssq2 + (os + (unsigned)((ai * 128 + m * 16) * 256 + bj * 16))) = s; } }
        }
    }
};
struct EpiPeerQ {
    static constexpr bool WAITS_ON_READS = true;
    const float* ssq2; bf16_t* qp;
    __device__ __forceinline__ void operator()(f32x4 (&acc)[2][2][4][2], const Unit& u, int wr, int wc, int fr, int fq) const {
        const unsigned r0 = (unsigned)(u.pm * 256 + wr * 64 + fr), c0 = (unsigned)(u.pn * 256 + wc * 32 + fq * 8);
        const unsigned os = r0 * 256u + (unsigned)fq * 64u, ob = r0 * 4096u + c0 * 2u;
#pragma unroll
        for (int ai = 0; ai < 2; ++ai) {
            f32x4 t4[4][4];
#pragma unroll
            for (int m = 0; m < 4; ++m)
#pragma unroll
                for (int k = 0; k < 4; ++k) t4[m][k] = ldg16f(ssq2, os + (unsigned)((ai * 128 + m * 16) * 256 + k * 16));
#pragma unroll
            for (int m = 0; m < 4; ++m) {
                const f32x4 t = t4[m][0] + t4[m][1] + t4[m][2] + t4[m][3];
                float s = t[0] + t[1] + t[2] + t[3]; s = swap32_sum(swap16_sum(s));
                const float rs = __builtin_amdgcn_rsqf(s * (1.0f / 2048.0f) + NORM_EPS);
#pragma unroll
                for (int bj = 0; bj < 2; ++bj) { const f32x4 a0 = acc[ai][bj][m][0] * rs, a1 = acc[ai][bj][m][1] * rs;
                    u32x4 w; w.x = cvtpk(a0[0], a0[1]); w.y = cvtpk(a0[2], a0[3]); w.z = cvtpk(a1[0], a1[1]); w.w = cvtpk(a1[2], a1[3]);
                    *(u32x4*)((char*)qp + (ob + (unsigned)((ai * 128 + m * 16) * 4096 + bj * 256))) = w; } }
        }
    }
};
constexpr int SHM_K = 64 * 128 * 2, SHM_V = 64 * 128 * 2;
#define KSWZ(row, colB) ((row) * 256 + ((colB) ^ (((row) & 7) << 4)))
#define SBAR() __builtin_amdgcn_sched_barrier(0)
__device__ __forceinline__ int v_st(int k, int c) { const int kk = (k & ~0xC) | ((k & 4) << 1) | ((k & 8) >> 1); return ((kk >> 3) * 4 + (c >> 5)) * 512 + ((kk & 7) * 32 + (c & 31)) * 2; }
__device__ __forceinline__ int v_rd_base(int lane) { return ((lane & 3) << 3) | (((lane >> 2) & 3) << 6) | (((lane >> 4) & 1) << 5) | (((lane >> 5) & 1) << 8); }
constexpr int v_rd_off(int d0, int ks, int half) { return d0 * 512 + ks * 4096 + half * 2048; }
__device__ __forceinline__ int crow(int r, int hi) { return (r & 3) + 8 * (r >> 2) + 4 * hi; }

__device__ __forceinline__ void qkt(f32x16& p0, f32x16& p1, const char* Kt, int r32, int hi, const bf16x8* qr) {
    p0 = f32x16{}; p1 = f32x16{};
    const char* kb[4];
#pragma unroll
    for (int dd = 0; dd < 4; ++dd) kb[dd] = Kt + KSWZ(r32, (dd * 16 + hi * 8) * 2);
#pragma unroll
    for (int d0 = 0; d0 < 8; ++d0) { const char* a = kb[d0 & 3] + (d0 >> 2) * 128;
        const bf16x8 b0 = *reinterpret_cast<const bf16x8*>(a);
        const bf16x8 b1 = *reinterpret_cast<const bf16x8*>(a + 32 * 256);
        p0 = __builtin_amdgcn_mfma_f32_32x32x16_bf16(b0, qr[d0], p0, 0, 0, 0);
        p1 = __builtin_amdgcn_mfma_f32_32x32x16_bf16(b1, qr[d0], p1, 0, 0, 0); }
}
__device__ __forceinline__ void pv_tile(f32x16* o, int vb0, bf16x8 pa0, bf16x8 pa1, bf16x8 pa2, bf16x8 pa3) {
#define TRRD(dst, off) asm volatile("ds_read_b64_tr_b16 %0, %1 offset:%2" : "=&v"(dst) : "v"(vb0), "i"(off) : "memory")
#define PV_D0(d0) do { s16x4 l0, l1, l2, l3, h0, h1, h2, h3; constexpr int b_ = v_rd_off(d0, 0, 0); \
        TRRD(l0, b_); TRRD(h0, b_ + 2048); TRRD(l1, b_ + 4096); TRRD(h1, b_ + 6144); TRRD(l2, b_ + 8192); TRRD(h2, b_ + 10240); TRRD(l3, b_ + 12288); TRRD(h3, b_ + 14336); \
        asm volatile("s_waitcnt lgkmcnt(0)" ::: "memory"); SBAR(); \
        o[d0] = __builtin_amdgcn_mfma_f32_32x32x16_bf16(pa0, (bf16x8){l0[0], l0[1], l0[2], l0[3], h0[0], h0[1], h0[2], h0[3]}, o[d0], 0, 0, 0); \
        o[d0] = __builtin_amdgcn_mfma_f32_32x32x16_bf16(pa1, (bf16x8){l1[0], l1[1], l1[2], l1[3], h1[0], h1[1], h1[2], h1[3]}, o[d0], 0, 0, 0); \
        o[d0] = __builtin_amdgcn_mfma_f32_32x32x16_bf16(pa2, (bf16x8){l2[0], l2[1], l2[2], l2[3], h2[0], h2[1], h2[2], h2[3]}, o[d0], 0, 0, 0); \
        o[d0] = __builtin_amdgcn_mfma_f32_32x32x16_bf16(pa3, (bf16x8){l3[0], l3[1], l3[2], l3[3], h3[0], h3[1], h3[2], h3[3]}, o[d0], 0, 0, 0); } while (0)
    PV_D0(0); PV_D0(1); PV_D0(2); PV_D0(3);
#undef PV_D0
#undef TRRD
}
__device__ __forceinline__ void pack_p(const f32x16& p0, const f32x16& p1, bf16x8& pa0, bf16x8& pa1, bf16x8& pa2, bf16x8& pa3) {
#define PK4(P, B_, OUT) do { unsigned a0 = cvtpk(P[B_+0], P[B_+1]), a1 = cvtpk(P[B_+2], P[B_+3]); unsigned b0 = cvtpk(P[B_+4], P[B_+5]), b1 = cvtpk(P[B_+6], P[B_+7]); \
        auto r0 = __builtin_amdgcn_permlane32_swap(a0, b0, false, false); auto r1 = __builtin_amdgcn_permlane32_swap(a1, b1, false, false); \
        u32x4 w = {r0[0], r1[0], r0[1], r1[1]}; OUT = *reinterpret_cast<bf16x8*>(&w); } while (0)
    PK4(p0, 0, pa0); PK4(p0, 8, pa1); PK4(p1, 0, pa2); PK4(p1, 8, pa3);
#undef PK4
}
__device__ __forceinline__ float pair_max(float v) { auto rr = __builtin_amdgcn_permlane32_swap(__float_as_uint(v), __float_as_uint(v), false, false); return fmaxf(__uint_as_float(rr[0]), __uint_as_float(rr[1])); }
__device__ __forceinline__ float pair_sum(float v) { auto rr = __builtin_amdgcn_permlane32_swap(__float_as_uint(v), __float_as_uint(v), false, false); return __uint_as_float(rr[0]) + __uint_as_float(rr[1]); }

struct Stage { bf16x8 k0, k1, v0, v1; };
__device__ __forceinline__ void stage_load(Stage& s, const bf16_t* Kg, const bf16_t* Vg, int tid) {
    const int sr = tid >> 4, sc = (tid & 15) * 8;
    s.k0 = *(const bf16x8*)(Kg + (size_t)sr * 128 + sc); s.k1 = *(const bf16x8*)(Kg + (size_t)(32 + sr) * 128 + sc);
    s.v0 = *(const bf16x8*)(Vg + (size_t)sr * 128 + sc); s.v1 = *(const bf16x8*)(Vg + (size_t)(32 + sr) * 128 + sc);
}
__device__ __forceinline__ void stage_write(const Stage& s, char* Kt, char* Vt, int tid) {
    const int sr = tid >> 4, sc = (tid & 15) * 8, kws = KSWZ(sr, sc * 2);
    *(bf16x8*)(Kt + kws) = s.k0; *(bf16x8*)(Kt + kws + 32 * 256) = s.k1;
    *(bf16x8*)(Vt + v_st(sr, sc)) = s.v0; *(bf16x8*)(Vt + v_st(32 + sr, sc)) = s.v1;
}

constexpr int ATT_LDS_WS = 2 * SHM_V + 2 * SHM_K;
constexpr int ATT_LDS_X = ATT_LDS_WS + 8 * 64 * 4;

__device__ __forceinline__ void stage_glds(const bf16_t* Kg, const bf16_t* Vg, char* Kt, char* Vt, int tid, int wid) {
#pragma unroll
    for (int i = 0; i < 2; ++i) {
        const int L = i * 512 + tid;
        const int krow = L >> 4, kch = (L & 15) ^ (krow & 7);
        __builtin_amdgcn_global_load_lds((const unsigned*)(Kg + krow * 128 + kch * 8), (LAS unsigned*)(Kt + (i * 512 + wid * 64) * 16), 16, 0, 0);
        const int sub = L >> 5, within = L & 31, kk = (sub >> 2) * 8 + (within >> 2), c = (sub & 3) * 32 + (within & 3) * 8;
        const int k = (kk & ~0xC) | ((kk & 4) << 1) | ((kk & 8) >> 1);
        __builtin_amdgcn_global_load_lds((const unsigned*)(Vg + k * 128 + c), (LAS unsigned*)(Vt + (i * 512 + wid * 64) * 16), 16, 0, 0);
    }
}

__device__ __forceinline__ void stage_glds_one(const bf16_t* G, char* T, int tid, int wid, bool isK) {
#pragma unroll
    for (int i = 0; i < 2; ++i) {
        const int L = i * 512 + tid;
        if (isK) { const int krow = L >> 4, kch = (L & 15) ^ (krow & 7);
            __builtin_amdgcn_global_load_lds((const unsigned*)(G + krow * 128 + kch * 8), (LAS unsigned*)(T + (i * 512 + wid * 64) * 16), 16, 0, 0); }
        else { const int sub = L >> 5, within = L & 31, kk = (sub >> 2) * 8 + (within >> 2), c = (sub & 3) * 32 + (within & 3) * 8; const int k = (kk & ~0xC) | ((kk & 4) << 1) | ((kk & 8) >> 1);
            __builtin_amdgcn_global_load_lds((const unsigned*)(G + k * 128 + c), (LAS unsigned*)(T + (i * 512 + wid * 64) * 16), 16, 0, 0); }
    }
}

template <int MODE>
__device__ __forceinline__ void attn_pass(const bf16_t* Kg, const bf16_t* Vg, int j_lo, int j_hi, const bf16x8* qr, f32x16* o, float& l_reg,
                                          char* lds, int tpos  , unsigned selm, const float* kbias_lds) {
    int tid = threadIdx.x; asm volatile("" : "+v"(tid));
    const int wid = __builtin_amdgcn_readfirstlane(tid >> 6), lane = tid & 63, r32 = lane & 31, hi = lane >> 5;
    char* V_lds = lds; char* K_lds = lds + 2 * SHM_V;
    float* wsf = (float*)(lds + ATT_LDS_WS) + wid * 64;
    constexpr float C2 = LOG2E * ATT_SCALE;
    float m_reg = -1e30f; l_reg = 0.f;
#pragma unroll
    for (int d = 0; d < 4; ++d) o[d] = f32x16{};
    const int vbase = (int)(uintptr_t)V_lds + v_rd_base(lane);
    const int NT = j_hi - j_lo;
    const int wq_lo = __builtin_amdgcn_readfirstlane(tpos - r32);
#define ATT_ACT(j_) (MODE == 2 ? ((j_) * 64 <= wq_lo + 31) : (MODE == 1 ? (((j_) * 64 <= wq_lo + 31) && ((j_) * 64 + 63 >= wq_lo - 511)) : true))
    __syncthreads();
    {
        const bf16_t* K0 = Kg + (size_t)j_lo * 64 * 128; const bf16_t* V0 = Vg + (size_t)j_lo * 64 * 128;
        stage_glds(K0, V0, K_lds, V_lds, tid, wid);
        if (NT > 1) stage_glds_one(K0 + 64 * 128, K_lds + SHM_K, tid, wid, true);
    }
    asm volatile("s_waitcnt vmcnt(0)" ::: "memory");
    __syncthreads();
    f32x16 pc0, pc1;
    if (ATT_ACT(j_lo)) qkt(pc0, pc1, K_lds, r32, hi, qr);
    __syncthreads();
#pragma unroll 1
    for (int t = 0; t < NT; ++t) {
        const int j = j_lo + t, kb = j * 64;
        if (t + 2 < NT) stage_glds_one(Kg + (size_t)(j + 2) * 64 * 128, K_lds + (t & 1) * SHM_K, tid, wid, true);
        if (t + 1 < NT) stage_glds_one(Vg + (size_t)(j + 1) * 64 * 128, V_lds + ((t + 1) & 1) * SHM_V, tid, wid, false);
        f32x16 pn0, pn1;
        const bool needm_c = MODE == 1 ? (kb + 63 > wq_lo || kb <= wq_lo + 31 - 512) : (kb + 63 > wq_lo);
        const bool fused = (t + 1 < NT) && ATT_ACT(j + 1) && ATT_ACT(j) && !needm_c;
        if (!fused && t + 1 < NT && ATT_ACT(j + 1)) qkt(pn0, pn1, K_lds + ((t + 1) & 1) * SHM_K, r32, hi, qr);
        if (ATT_ACT(j)) {
            f32x16 p0 = pc0, p1 = pc1;
            const float NEG = -__builtin_inff();
            const int dq = tpos - kb - 4 * hi;
            const bool needm = needm_c;
            float mn, alpha, ps = 0.f;
            if (fused) {
                const char* Kn = K_lds + ((t + 1) & 1) * SHM_K;
                const char* kbp_[4];
#pragma unroll
                for (int dd = 0; dd < 4; ++dd) kbp_[dd] = Kn + KSWZ(r32, (dd * 16 + hi * 8) * 2);
                pn0 = f32x16{}; pn1 = f32x16{};
#define ATT_QK2(D0) do { _Pragma("unroll") for (int d0 = (D0); d0 < (D0) + 2; ++d0) { const char* a_ = kbp_[d0 & 3] + (d0 >> 2) * 128; \
                    const bf16x8 b0_ = *reinterpret_cast<const bf16x8*>(a_); const bf16x8 b1_ = *reinterpret_cast<const bf16x8*>(a_ + 32 * 256); \
                    pn0 = __builtin_amdgcn_mfma_f32_32x32x16_bf16(b0_, qr[d0], pn0, 0, 0, 0); pn1 = __builtin_amdgcn_mfma_f32_32x32x16_bf16(b1_, qr[d0], pn1, 0, 0, 0); } } while (0)
                const float lanebias = (MODE == 0 && !((selm >> j) & 1u)) ? NEG : 0.f;
                float pmax;
                ATT_QK2(0);
                if (MODE == 2) { const float* kbq = kbias_lds + kb + 4 * hi;
#pragma unroll
                    for (int g = 0; g < 4; ++g) { const f32x4 b0 = *(const f32x4*)(kbq + 8 * g), b1 = *(const f32x4*)(kbq + 32 + 8 * g);
#pragma unroll
                        for (int i = 0; i < 4; ++i) { p0[4 * g + i] = fmaf(p0[4 * g + i], C2, b0[i]); p1[4 * g + i] = fmaf(p1[4 * g + i], C2, b1[i]); } } }
                pmax = p0[0];
#pragma unroll
                for (int r = 1; r < 16; ++r) pmax = fmaxf(pmax, p0[r]);
                SBAR();
                ATT_QK2(2);
#pragma unroll
                for (int r = 0; r < 16; ++r) pmax = fmaxf(pmax, p1[r]);
                pmax = pair_max(pmax);
                if (MODE != 2) pmax = pmax * C2 + lanebias;
                mn = fmaxf(m_reg, pmax); alpha = __builtin_amdgcn_exp2f(m_reg - mn); m_reg = mn;
                const float nb = lanebias - mn;
                SBAR();
                ATT_QK2(4);
#pragma unroll
                for (int r = 0; r < 16; ++r) { p0[r] = MODE == 2 ? __builtin_amdgcn_exp2f(p0[r] - mn) : __builtin_amdgcn_exp2f(fmaf(p0[r], C2, nb)); ps += p0[r]; }
                SBAR();
                ATT_QK2(6);
#pragma unroll
                for (int r = 0; r < 16; ++r) { p1[r] = MODE == 2 ? __builtin_amdgcn_exp2f(p1[r] - mn) : __builtin_amdgcn_exp2f(fmaf(p1[r], C2, nb)); ps += p1[r]; }
                SBAR();
#undef ATT_QK2
            } else if (MODE != 2 && !needm) {
                const float lanebias = (MODE == 0 && !((selm >> j) & 1u)) ? NEG : 0.f;
                float pmax = p0[0];
#pragma unroll
                for (int r = 1; r < 16; ++r) pmax = fmaxf(pmax, p0[r]);
#pragma unroll
                for (int r = 0; r < 16; ++r) pmax = fmaxf(pmax, p1[r]);
                pmax = pair_max(pmax) * C2 + lanebias;
                mn = fmaxf(m_reg, pmax); alpha = __builtin_amdgcn_exp2f(m_reg - mn); m_reg = mn;
                const float nb = lanebias - mn;
#pragma unroll
                for (int r = 0; r < 16; ++r) { p0[r] = __builtin_amdgcn_exp2f(fmaf(p0[r], C2, nb)); p1[r] = __builtin_amdgcn_exp2f(fmaf(p1[r], C2, nb)); ps += p0[r] + p1[r]; }
            } else {
                if (MODE == 2) {
                    const float* kbp = kbias_lds + kb + 4 * hi;
#pragma unroll
                    for (int g = 0; g < 4; ++g) { const f32x4 b0 = *(const f32x4*)(kbp + 8 * g), b1 = *(const f32x4*)(kbp + 32 + 8 * g);
#pragma unroll
                        for (int i = 0; i < 4; ++i) { p0[4 * g + i] = fmaf(p0[4 * g + i], C2, b0[i]); p1[4 * g + i] = fmaf(p1[4 * g + i], C2, b1[i]); } }
                } else {
#pragma unroll
                    for (int r = 0; r < 16; ++r) { p0[r] *= C2; p1[r] *= C2; }
                }
                if (needm) {
                    const bool sel = MODE == 0 ? ((selm >> j) & 1u) != 0u : true;
                    const unsigned W = MODE == 1 ? 512u : 0x7fffffffu;
#pragma unroll
                    for (int r = 0; r < 16; ++r) { const int c = (r & 3) + 8 * (r >> 2); if (!sel || (unsigned)(dq - c) >= W) p0[r] = NEG; if (!sel || (unsigned)(dq - c - 32) >= W) p1[r] = NEG; }
                }
                float pmax = p0[0];
#pragma unroll
                for (int r = 1; r < 16; ++r) pmax = fmaxf(pmax, p0[r]);
#pragma unroll
                for (int r = 0; r < 16; ++r) pmax = fmaxf(pmax, p1[r]);
                pmax = pair_max(pmax);
                mn = fmaxf(m_reg, pmax); alpha = __builtin_amdgcn_exp2f(m_reg - mn); m_reg = mn;
#pragma unroll
                for (int r = 0; r < 16; ++r) { p0[r] = __builtin_amdgcn_exp2f(p0[r] - mn); p1[r] = __builtin_amdgcn_exp2f(p1[r] - mn); ps += p0[r] + p1[r]; }
            }
            ps = pair_sum(ps);
            l_reg = l_reg * alpha + ps;
            if (__any(alpha < 1.f)) {
                if (hi == 0) wsf[r32] = alpha;
                asm volatile("s_waitcnt lgkmcnt(0)" ::: "memory");
#pragma unroll
                for (int r = 0; r < 16; ++r) { const float a = wsf[crow(r, hi)];
#pragma unroll
                    for (int d = 0; d < 4; ++d) o[d][r] *= a; }
            }
            bf16x8 pa0, pa1, pa2, pa3;
            pack_p(p0, p1, pa0, pa1, pa2, pa3);
            pv_tile(o, vbase + (t & 1) * SHM_V, pa0, pa1, pa2, pa3);
        }
        pc0 = pn0; pc1 = pn1;
        asm volatile("s_waitcnt vmcnt(0)" ::: "memory");
        __syncthreads();
    }
#undef ATT_ACT
}

template <bool ADD, bool OUT8>
__device__ __forceinline__ void store_o(const f32x16* o, float fac, void* basev, size_t row_stride  , const bf16_t* addend, size_t add_stride, char* lds, int wid, int lane) {
    asm volatile("" : "+v"(lane));
    const int r32 = lane & 31, hi = lane >> 5;
    float* wsf = (float*)(lds + ATT_LDS_WS) + wid * 64;
    char* ot = lds + wid * 8192;
    __builtin_amdgcn_wave_barrier();
    if (hi == 0) wsf[r32] = fac;
    asm volatile("s_waitcnt lgkmcnt(0)" ::: "memory");
    __builtin_amdgcn_wave_barrier();
#pragma unroll
    for (int r = 0; r < 16; ++r) { const int orow = crow(r, hi); const float f = wsf[orow];
#pragma unroll
        for (int d0 = 0; d0 < 4; ++d0) *(bf16_t*)(ot + orow * 256 + (d0 * 32 + r32) * 2) = (bf16_t)(cvtpk(o[d0][r] * f, 0.f) & 0xffffu); }
    asm volatile("s_waitcnt lgkmcnt(0)" ::: "memory");
    __builtin_amdgcn_wave_barrier();
    if constexpr (OUT8) {
        unsigned char* base = (unsigned char*)basev;
        const int rr = lane >> 3, ch = lane & 7;
        u32x4 ad[4][2];
        if (ADD) {
#pragma unroll
            for (int i = 0; i < 4; ++i) { const bf16_t* ap = addend + (size_t)(i * 8 + rr) * add_stride + ch * 16; ad[i][0] = *(const u32x4*)ap; ad[i][1] = *(const u32x4*)(ap + 8); } }
#pragma unroll
        for (int i = 0; i < 4; ++i) {
            const u32x4 v0 = *(const u32x4*)(ot + (i * 8 + rr) * 256 + ch * 32), v1 = *(const u32x4*)(ot + (i * 8 + rr) * 256 + ch * 32 + 16);
            float f[16];
#pragma unroll
            for (int q = 0; q < 4; ++q) { f[2 * q] = bf_lo(v0[q]); f[2 * q + 1] = bf_hi(v0[q]); f[8 + 2 * q] = bf_lo(v1[q]); f[8 + 2 * q + 1] = bf_hi(v1[q]); }
            if (ADD) { const u32x4 a0 = ad[i][0], a1 = ad[i][1];
#pragma unroll
                for (int q = 0; q < 4; ++q) { f[2 * q] += bf_lo(a0[q]); f[2 * q + 1] += bf_hi(a0[q]); f[8 + 2 * q] += bf_lo(a1[q]); f[8 + 2 * q + 1] += bf_hi(a1[q]); } }
            u32x4 w;
#pragma unroll
            for (int q = 0; q < 4; ++q) w[q] = pack_fp8x4(f[4 * q] * SC_O, f[4 * q + 1] * SC_O, f[4 * q + 2] * SC_O, f[4 * q + 3] * SC_O);
            *(u32x4*)(base + (size_t)(i * 8 + rr) * row_stride + ch * 16) = w; }
    } else {
        bf16_t* base = (bf16_t*)basev;
        const int rr = lane >> 4, ch = lane & 15;
        bf16_t* gp = base + (size_t)rr * row_stride + ch * 8;
        const bf16_t* ap = ADD ? addend + (size_t)rr * add_stride + ch * 8 : nullptr;
        u32x4 ad[8];
        if (ADD) {
#pragma unroll
            for (int i = 0; i < 8; ++i) ad[i] = *(const u32x4*)(ap + (size_t)(i * 4) * add_stride); }
#pragma unroll
        for (int i = 0; i < 8; ++i) {
            u32x4 v = *(const u32x4*)(ot + (i * 4 + rr) * 256 + ch * 16);
            if (ADD) { const u32x4 a = ad[i];
                v.x = cvtpk(bf_lo(v.x) + bf_lo(a.x), bf_hi(v.x) + bf_hi(a.x)); v.y = cvtpk(bf_lo(v.y) + bf_lo(a.y), bf_hi(v.y) + bf_hi(a.y));
                v.z = cvtpk(bf_lo(v.z) + bf_lo(a.z), bf_hi(v.z) + bf_hi(a.z)); v.w = cvtpk(bf_lo(v.w) + bf_lo(a.w), bf_hi(v.w) + bf_hi(a.w)); }
            *(u32x4*)(gp + (size_t)(i * 4) * row_stride) = v; }
    }
    __builtin_amdgcn_wave_barrier();
}

__device__ __forceinline__ void fox_cumsum(const Params& p, int first_block) {
    const int tid = tid_opaque(), wid = tid >> 6, lane = tid & 63;
    {
        const int which = (int)blockIdx.x - first_block - 8;
        if ((which == 0 || which == 1) && tid < 256) { const float* b1p = (const float*)(p.ws + OFF_MISC + M_B1P); float t = 0.f;
            for (int part = 0; part < 64; ++part) t += b1p[(which * 64 + part) * 256 + tid];
            ((float*)(p.ws + OFF_MISC + M_B1))[which * 256 + tid] = t; }
    }
    const int seq = ((int)blockIdx.x - first_block) * 8 + wid;
    if (seq < 0 || seq >= 64) return;
    const int b = seq >> 3, h = seq & 7;
    const float* lf = (const float*)(p.ws + OFF_MISC + M_LOGF); float* cf = (float*)(p.ws + OFF_MISC + M_CFOX);
    float v[32]; float run = 0.f;
#pragma unroll
    for (int i = 0; i < 32; ++i) { run += lf[(size_t)(b * 2048 + lane * 32 + i) * 8 + h]; v[i] = run; }
    float incl = run;
#pragma unroll
    for (int o = 1; o < 64; o <<= 1) { const float t = __shfl_up(incl, o); if (lane >= o) incl += t; }
    const float excl = incl - run;
#pragma unroll
    for (int i = 0; i < 32; ++i) cf[(size_t)(b * 8 + h) * 2048 + lane * 32 + i] = -(v[i] + excl) * LOG2E;
}

__device__ __forceinline__ void phase_cmp2(const Params& p, unsigned char* lds_raw) {
    const int tid = tid_opaque(), wid = tid >> 6, lane = tid & 63;
    float* hbuf = (float*)lds_raw + wid * 512;
    const float* slab = (const float*)(p.ws + OFF_XB); const float* b1p = (const float*)(p.ws + OFF_MISC + M_B1);
    const f32x2* cs = (const f32x2*)(p.ws + OFF_MISC + M_ROPE);
    bf16_t* kcvc = (bf16_t*)(p.ws + OFF_KCVC);
    for (int job = blockIdx.x * 8 + wid; job < 2048; job += gridDim.x * 8) {
        const int which = job >> 10, m0 = (job & 1023) * 2;
        f32x4 acc[2] = {{0.f, 0.f, 0.f, 0.f}, {0.f, 0.f, 0.f, 0.f}};
#pragma unroll
        for (int rr = 0; rr < 2; ++rr)
#pragma unroll
            for (int s = 0; s < 8; ++s) acc[rr] += *(const f32x4*)(slab + ((size_t)(which * 8 + s) * 2048 + m0 + rr) * 256 + lane * 4);
        const f32x4 bb = *(const f32x4*)(b1p + which * 256 + lane * 4);
        __builtin_amdgcn_wave_barrier();
#pragma unroll
        for (int rr = 0; rr < 2; ++rr) { const f32x4 a = acc[rr] + bb; *(f32x4*)(hbuf + rr * 256 + lane * 4) = (f32x4){gelu_tanh(a[0]), gelu_tanh(a[1]), gelu_tanh(a[2]), gelu_tanh(a[3])}; }
        asm volatile("s_waitcnt lgkmcnt(0)" ::: "memory");
        __builtin_amdgcn_wave_barrier();
        const float* w2 = p.in[which ? 11 : 8];
        float o1[2] = {0.f, 0.f}, o2[2] = {0.f, 0.f};
#pragma unroll 1
        for (int j0 = 0; j0 < 256; j0 += 32) {
            float wa[32], wb[32];
#pragma unroll
            for (int j = 0; j < 32; ++j) { wa[j] = w2[(j0 + j) * 128 + lane]; wb[j] = w2[(j0 + j) * 128 + 64 + lane]; }
#pragma unroll
            for (int j = 0; j < 32; ++j) { const float h0 = hbuf[j0 + j], h1 = hbuf[256 + j0 + j]; o1[0] = fmaf(h0, wa[j], o1[0]); o2[0] = fmaf(h0, wb[j], o2[0]); o1[1] = fmaf(h1, wa[j], o1[1]); o2[1] = fmaf(h1, wb[j], o2[1]); }
        }
#pragma unroll
        for (int rr = 0; rr < 2; ++rr) {
            const int m = m0 + rr, i = m & 127;
            bf16_t* dst = kcvc + (size_t)which * (2048 * 128) + (size_t)m * 128;
            if (i == 127) { *(unsigned*)(dst + lane * 2) = 0u; continue; }
            if (which == 0) {
                const f32x2 c = cs[(16 * i + 31) * 64 + lane]; const float y1 = o1[rr] * c[0] - o2[rr] * c[1], y2 = o2[rr] * c[0] + o1[rr] * c[1];
                const int q = lane >> 2, e = lane & 3;
                dst[8 * q + e] = (bf16_t)(cvtpk(y1, 0.f) & 0xffffu); dst[8 * q + 4 + e] = (bf16_t)(cvtpk(y2, 0.f) & 0xffffu);
            } else { dst[lane] = (bf16_t)(cvtpk(o1[rr], 0.f) & 0xffffu); dst[64 + lane] = (bf16_t)(cvtpk(o2[rr], 0.f) & 0xffffu); }
        }
        __builtin_amdgcn_wave_barrier();
    }
}
__device__ __forceinline__ void phase_cmp_attn(const Params& p, unsigned char* lds_raw) {
    char* lds = (char*)lds_raw;
    const int tid = tid_opaque(), wid = __builtin_amdgcn_readfirstlane(tid >> 6), lane = tid & 63, r32 = lane & 31, hi = lane >> 5;
    char* V_lds = lds; char* K_lds = lds + 2 * SHM_V;
    float* wsf = (float*)(lds + ATT_LDS_WS) + wid * 64;
    float* imp = (float*)(lds + ATT_LDS_X);
    const bf16_t* QN = (const bf16_t*)(p.ws + OFF_QN); const bf16_t* kcvc = (const bf16_t*)(p.ws + OFF_KCVC);
    const float* gn = (const float*)(p.ws + OFF_MISC + M_GN);
    bf16_t* ocg = (bf16_t*)(p.ws + OFF_WINT); unsigned* selmask = (unsigned*)(p.ws + OFF_SEL);
    constexpr float C2 = LOG2E * ATT_SCALE;
    const int vbase = (int)(uintptr_t)V_lds + v_rd_base(lane);
    bf16x8 qr[8]; Stage st0, st1; float gate = 0.f;
#define CMP_LOAD(it_) do { const int bg_ = (it_) >> 5, c_ = (it_) & 31, b_ = bg_ >> 1, head_ = (bg_ & 1) * 4 + (wid >> 1), tpos_ = c_ * 64 + (wid & 1) * 32 + r32; \
        const bf16_t* Kg_ = kcvc + (size_t)bg_ * 128 * 128; const bf16_t* Vg_ = kcvc + (size_t)(2048 * 128) + (size_t)bg_ * 128 * 128; \
        stage_load(st0, Kg_, Vg_, tid); stage_load(st1, Kg_ + 64 * 128, Vg_ + 64 * 128, tid); \
        const bf16_t* qp_ = QN + ((size_t)(b_ * 8 + head_) * 2048 + tpos_) * 128 + hi * 8; \
        _Pragma("unroll") for (int d0 = 0; d0 < 8; ++d0) qr[d0] = *(const bf16x8*)(qp_ + d0 * 16); \
        gate = gn[(size_t)(b_ * 2048 + tpos_) * 24 + head_ * 3 + 0]; } while (0)
    if ((int)blockIdx.x < 512) CMP_LOAD((int)blockIdx.x);
    for (int item = blockIdx.x; item < 512; item += gridDim.x) {
        const int bg = item >> 5, c = item & 31, b = bg >> 1, g = bg & 1;
        const int hg = wid >> 1, head = g * 4 + hg, tpos = c * 64 + (wid & 1) * 32 + r32, tok = b * 2048 + tpos;
        __syncthreads();
        stage_write(st0, K_lds, V_lds, tid); stage_write(st1, K_lds + SHM_K, V_lds + SHM_V, tid);
        __syncthreads();
        f32x16 pA0, pA1, pB0, pB1;
        qkt(pA0, pA1, K_lds, r32, hi, qr);
        qkt(pB0, pB1, K_lds + SHM_K, r32, hi, qr);
        const int nvis = tpos >= 15 ? (tpos - 15) >> 4 : 0;
        const float NEG = -__builtin_inff();
        float mx = -1e30f;
#pragma unroll
        for (int r = 0; r < 16; ++r) { const int n = crow(r, hi);
            pA0[r] = n < nvis ? pA0[r] * C2 : NEG; pA1[r] = n + 32 < nvis ? pA1[r] * C2 : NEG; pB0[r] = n + 64 < nvis ? pB0[r] * C2 : NEG; pB1[r] = n + 96 < nvis ? pB1[r] * C2 : NEG;
            mx = fmaxf(fmaxf(mx, pA0[r]), fmaxf(pA1[r], fmaxf(pB0[r], pB1[r]))); }
        mx = pair_max(mx);
        float ps = 0.f;
#pragma unroll
        for (int r = 0; r < 16; ++r) { pA0[r] = __builtin_amdgcn_exp2f(pA0[r] - mx); pA1[r] = __builtin_amdgcn_exp2f(pA1[r] - mx); pB0[r] = __builtin_amdgcn_exp2f(pB0[r] - mx); pB1[r] = __builtin_amdgcn_exp2f(pB1[r] - mx);
            ps += (pA0[r] + pA1[r]) + (pB0[r] + pB1[r]); }
        ps = pair_sum(ps);
        const float rl = 1.0f / fmaxf(ps, 1e-30f);
        {
            float gs[16], lastv[16];
#pragma unroll
            for (int q = 0; q < 4; ++q) {
                gs[q] = (pA0[4 * q] + pA0[4 * q + 1]) + (pA0[4 * q + 2] + pA0[4 * q + 3]); lastv[q] = pA0[4 * q + 3];
                gs[4 + q] = (pA1[4 * q] + pA1[4 * q + 1]) + (pA1[4 * q + 2] + pA1[4 * q + 3]); lastv[4 + q] = pA1[4 * q + 3];
                gs[8 + q] = (pB0[4 * q] + pB0[4 * q + 1]) + (pB0[4 * q + 2] + pB0[4 * q + 3]); lastv[8 + q] = pB0[4 * q + 3];
                gs[12 + q] = (pB1[4 * q] + pB1[4 * q + 1]) + (pB1[4 * q + 2] + pB1[4 * q + 3]); lastv[12 + q] = pB1[4 * q + 3]; }
            float* myimp = imp + ((size_t)hg * 64 + (wid & 1) * 32 + r32) * 33;
#pragma unroll
            for (int idx = 0; idx < 16; ++idx) {
                const float other = xor32(lastv[idx], hi);
                const float other_prev = idx > 0 ? xor32(lastv[idx > 0 ? idx - 1 : 0], hi) : 0.f;
                const float prev = hi ? other : other_prev;
                myimp[2 * idx + hi] = (gs[idx] + prev) * rl;
            }
        }
        f32x16 o[4];
#pragma unroll
        for (int d = 0; d < 4; ++d) o[d] = f32x16{};
        { bf16x8 pa0, pa1, pa2, pa3; pack_p(pA0, pA1, pa0, pa1, pa2, pa3); pv_tile(o, vbase, pa0, pa1, pa2, pa3);
          pack_p(pB0, pB1, pa0, pa1, pa2, pa3); pv_tile(o, vbase + SHM_V, pa0, pa1, pa2, pa3); }
        __syncthreads();
        store_o<false, false>(o, gate * rl, ocg + ((size_t)(b * 2048 + c * 64 + (wid & 1) * 32)) * 1024 + head * 128, 1024, nullptr, 0, lds, wid, lane);
        __syncthreads();
        if (item + (int)gridDim.x < 512) CMP_LOAD(item + (int)gridDim.x);
        if (tid < 64) {
            const int t = c * 64 + tid; float sc[32];
#pragma unroll
            for (int j = 0; j < 32; ++j) { const float v = ((imp[(0 * 64 + tid) * 33 + j] + imp[(1 * 64 + tid) * 33 + j]) + imp[(2 * 64 + tid) * 33 + j]) + imp[(3 * 64 + tid) * 33 + j];
                const bool forced = j == 0 || j == c || j == c - 1; const float x = j > c ? -1e30f : (forced ? 1e4f : v);
                sc[j] = __uint_as_float((__float_as_uint(x) & ~31u) | (unsigned)(x >= 0.f ? 31 - j : j)); }
            bitonic_sort_desc<32>(sc);
            unsigned mask = 0u;
#pragma unroll
            for (int k = 0; k < 16; ++k) { const unsigned u = __float_as_uint(sc[k]); const unsigned low = u & 31u; const int j = (int)((u >> 31) ? low : 31u - low); if (j <= c) mask |= 1u << j; }
            selmask[(size_t)bg * 2048 + t] = mask;
        }
    }
#undef CMP_LOAD
}

__device__ __forceinline__ void phase_attn(const Params& p, unsigned char* lds_raw) {
    char* lds = (char*)lds_raw;
    int* slot = (int*)(lds + ATT_LDS_X);
    unsigned* qctr = (unsigned*)(p.ws + OFF_MISC + M_CTL);
    const bf16_t* QN = (const bf16_t*)(p.ws + OFF_QN); const bf16_t* KV6 = (const bf16_t*)(p.ws + OFF_KV6); const bf16_t* QKVF = (const bf16_t*)(p.ws + OFF_QKVF);
    const float* gn = (const float*)(p.ws + OFF_MISC + M_GN); const float* cf = (const float*)(p.ws + OFF_MISC + M_CFOX);
    const unsigned* selmask = (const unsigned*)(p.ws + OFF_SEL);
    const bf16_t* ocg = (const bf16_t*)(p.ws + OFF_WINT); unsigned char* ocat = p.ws + OFF_XB  ; bf16_t* otmp = (bf16_t*)(p.ws + OFF_XB + 32 * MiB)  ;
    for (;;) {
        int tid = threadIdx.x; asm volatile("" : "+v"(tid));
        const int wid = __builtin_amdgcn_readfirstlane(tid >> 6), lane = tid & 63, r32 = lane & 31, hi = lane >> 5;
        __syncthreads();
        if (tid == 0) slot[0] = (int)atomicAdd(qctr, 1u);
        __syncthreads();
        const int it = slot[0];
        if (it >= 1024) break;
        f32x16 o[4]; float l_reg; bf16x8 qr[8];
        if (it < 512) {
            const int cb = 7 - (it >> 6), bh = it & 63, b = bh >> 3, h = bh & 7;
            const int tpos = cb * 256 + wid * 32 + r32;
            { const bf16_t* qp = QKVF + ((size_t)bh * 2048 + tpos) * 128 + hi * 8;
#pragma unroll
              for (int d0 = 0; d0 < 8; ++d0) qr[d0] = *(const bf16x8*)(qp + d0 * 16); }
            const bf16_t* Kg = QKVF + (size_t)(64 * 2048 * 128) + (size_t)bh * 2048 * 128; const bf16_t* Vg = QKVF + (size_t)2 * (64 * 2048 * 128) + (size_t)bh * 2048 * 128;
            float* kb_lds = (float*)(lds + ATT_LDS_X + 64);
            __syncthreads();
            *(f32x4*)(kb_lds + tid * 4) = *(const f32x4*)(cf + (size_t)bh * 2048 + tid * 4);
            attn_pass<2>(Kg, Vg, 0, cb * 4 + 4, qr, o, l_reg, lds, tpos, 0u, kb_lds);
            store_o<false, true>(o, 1.0f / l_reg, ocat + ((size_t)(b * 2048 + cb * 256 + wid * 32)) * 2048 + 1024 + h * 128, 2048, nullptr, 0, lds, wid, lane);
        } else {
            const int k = it - 512, c = 31 - (k >> 4), bg = k & 15, b = bg >> 1, g = bg & 1;
            const int hg = wid >> 1, head = g * 4 + hg, tpos = c * 64 + (wid & 1) * 32 + r32, tok = b * 2048 + tpos;
            { const bf16_t* qp = QN + ((size_t)(b * 8 + head) * 2048 + tpos) * 128 + hi * 8;
#pragma unroll
              for (int d0 = 0; d0 < 8; ++d0) qr[d0] = *(const bf16x8*)(qp + d0 * 16); }
            const unsigned selm = selmask[(size_t)bg * 2048 + tpos];
            const float g_sel = gn[(size_t)tok * 24 + head * 3 + 1], g_win = gn[(size_t)tok * 24 + head * 3 + 2];
            const size_t kvh = (size_t)bg * 2048 * 128, kvs = (size_t)16 * 2048 * 128;
            unsigned char* orow = ocat + ((size_t)(b * 2048 + c * 64 + (wid & 1) * 32)) * 2048 + head * 128;
            bf16_t* trow = otmp + ((size_t)(b * 2048 + c * 64 + (wid & 1) * 32)) * 1024 + head * 128;
            attn_pass<0>(KV6 + 2 * kvs + kvh, KV6 + 3 * kvs + kvh, 0, c + 1, qr, o, l_reg, lds, tpos, selm, nullptr);
            store_o<true, false>(o, g_sel / l_reg, trow, 1024, ocg + ((size_t)(b * 2048 + c * 64 + (wid & 1) * 32)) * 1024 + head * 128, 1024, lds, wid, lane);
            attn_pass<1>(KV6 + 4 * kvs + kvh, KV6 + 5 * kvs + kvh, c >= 8 ? c - 8 : 0, c + 1, qr, o, l_reg, lds, tpos, 0u, nullptr);
            store_o<true, true>(o, g_win / l_reg, orow, 2048, trow, 1024, lds, wid, lane);
        }
    }
}
__device__ __forceinline__ float pack_idx(float v, unsigned idx, unsigned mask) { return __uint_as_float((__float_as_uint(v) & ~mask) | idx); }
__device__ __forceinline__ void top16_of_tile(const f32x16& p0, const f32x16& p1, int hi, unsigned nbase, float (&res)[16]) {
    float g1[16];
#pragma unroll
    for (int r = 0; r < 16; ++r) { const unsigned n = nbase + (unsigned)crow(r, hi); res[r] = pack_idx(p0[r], n, 127u); g1[r] = pack_idx(p1[r], n + 32u, 127u); }
    bitonic_sort_desc<16>(res); bitonic_sort_desc<16>(g1);
    merge_top16(res, g1);
}
__device__ __forceinline__ void top16_of_128(const char* Kt, int r32, int hi, const bf16x8* qr, float (&res)[16]) {
    float t2[16];
    { f32x16 p0, p1; qkt(p0, p1, Kt, r32, hi, qr); top16_of_tile(p0, p1, hi, 0u, res); }
    SBAR();
    { f32x16 p0, p1; qkt(p0, p1, Kt + SHM_K, r32, hi, qr); top16_of_tile(p0, p1, hi, 64u, t2); }
    merge_top16(res, t2);
#pragma unroll
    for (int i = 0; i < 16; ++i) t2[i] = xor32(res[i], hi);
    merge_top16(res, t2);
    SBAR();
}
__device__ __forceinline__ float sel16(const float (&v)[16], int k) {
    float r = v[0];
#pragma unroll
    for (int i = 1; i < 16; ++i) r = (k == i) ? v[i] : r;
    return r;
}
__device__ __forceinline__ void phase_peer_topk(const Params& p, unsigned char* lds_raw) {
    char* lds = (char*)lds_raw;
    const int tid = tid_opaque(), wid = __builtin_amdgcn_readfirstlane(tid >> 6), lane = tid & 63, r32 = lane & 31, hi = lane >> 5;
    const bf16_t* K12 = (const bf16_t*)(p.ws + OFF_MISC + M_K12); const bf16_t* QP = (const bf16_t*)(p.ws + OFF_QKVF);
    int* eidx = (int*)(p.ws + OFF_EIDX); float* gsm = (float*)(p.ws + OFF_GSM);
    for (int item = blockIdx.x; item < 512; item += gridDim.x) {
        const int h = item & 7, tt = item >> 3;
        __syncthreads();
        {
            const int sr = tid >> 4, sc = (tid & 15) * 8, kws = KSWZ(sr, sc * 2);
#pragma unroll
            for (int q = 0; q < 4; ++q) { const bf16_t* src = K12 + (size_t)(q >> 1) * 131072 + (size_t)h * 16384 + (size_t)(q & 1) * 64 * 128;
                const bf16x8 a = *(const bf16x8*)(src + (size_t)sr * 128 + sc), b = *(const bf16x8*)(src + (size_t)(32 + sr) * 128 + sc);
                *(bf16x8*)(lds + q * SHM_K + kws) = a; *(bf16x8*)(lds + q * SHM_K + kws + 32 * 256) = b; }
        }
        const int tok = tt * 256 + wid * 32 + r32;
        bf16x8 qr[8];
        { const bf16_t* qp = QP + (size_t)tok * 2048 + h * 256 + hi * 8;
#pragma unroll
          for (int d0 = 0; d0 < 8; ++d0) qr[d0] = *(const bf16x8*)(qp + d0 * 16); }
        __syncthreads();
        float v1[16], v2[16];
        top16_of_128(lds, r32, hi, qr, v1);
        { const bf16_t* qp = QP + (size_t)tok * 2048 + h * 256 + 128 + hi * 8;
#pragma unroll
          for (int d0 = 0; d0 < 8; ++d0) qr[d0] = *(const bf16x8*)(qp + d0 * 16); }
        top16_of_128(lds + 2 * SHM_K, r32, hi, qr, v2);
        float s1[16], s2[16];
#pragma unroll
        for (int i = 0; i < 16; ++i) { s1[i] = __uint_as_float(__float_as_uint(v1[i]) & ~127u); s2[i] = __uint_as_float(__float_as_uint(v2[i]) & ~127u); }
        float cd[32];
        const float NEGC = -3e38f;
#pragma unroll
        for (int i = 0; i < 32; ++i) cd[i] = NEGC;
#define CAND(slot, a, b) cd[slot] = pack_idx(s1[a] + s2[b], (unsigned)((a) * 16 + (b)), 255u)
        if (hi == 0) {
#pragma unroll
            for (int b = 0; b < 16; ++b) CAND(b, 0, b);
#pragma unroll
            for (int b = 0; b < 5; ++b) CAND(16 + b, 2, b);
#pragma unroll
            for (int a = 8; a < 16; ++a) CAND(13 + a, a, 0);
        } else {
#pragma unroll
            for (int b = 0; b < 8; ++b) CAND(b, 1, b);
#pragma unroll
            for (int b = 0; b < 4; ++b) CAND(8 + b, 3, b);
#pragma unroll
            for (int b = 0; b < 3; ++b) CAND(12 + b, 4, b);
#pragma unroll
            for (int a = 5; a < 8; ++a) { CAND(15 + 2 * (a - 5), a, 0); CAND(16 + 2 * (a - 5), a, 1); }
        }
#undef CAND
        bitonic_sort_desc<32>(cd);
        float top[16], oth[16];
#pragma unroll
        for (int i = 0; i < 16; ++i) top[i] = cd[i];
#pragma unroll
        for (int i = 0; i < 16; ++i) oth[i] = xor32(top[i], hi);
        merge_top16(top, oth);
        float* scr = (float*)(lds + 4 * SHM_K);
#pragma unroll
        for (int i = 0; i < 16; ++i) { scr[i * 512 + tid] = v1[i]; scr[(16 + i) * 512 + tid] = v2[i]; }
        float ev[16]; int ei[16]; float esum = 0.f;
#pragma unroll
        for (int k = 0; k < 16; ++k) { const int code = (int)(__float_as_uint(top[k]) & 255u); const int a = code >> 4, b = code & 15;
            const float w1 = scr[a * 512 + tid], w2 = scr[(16 + b) * 512 + tid];
            ev[k] = __uint_as_float(__float_as_uint(w1) & ~127u) + __uint_as_float(__float_as_uint(w2) & ~127u);
            ei[k] = (int)((__float_as_uint(w1) & 127u) * 128u + (__float_as_uint(w2) & 127u)); }
        float emax = ev[0];
#pragma unroll
        for (int k = 1; k < 16; ++k) emax = fmaxf(emax, ev[k]);
#pragma unroll
        for (int k = 0; k < 16; ++k) { ev[k] = __expf(ev[k] - emax); esum += ev[k]; }
        const float inv = 1.0f / esum;
        int* ep = eidx + (size_t)tok * 128 + h * 16; float* gp = gsm + (size_t)tok * 128 + h * 16;
        if (hi == 0) {
            *(int4*)ep = make_int4(ei[0], ei[1], ei[2], ei[3]); *(int4*)(ep + 4) = make_int4(ei[4], ei[5], ei[6], ei[7]);
            *(f32x4*)gp = (f32x4){ev[0] * inv, ev[1] * inv, ev[2] * inv, ev[3] * inv}; *(f32x4*)(gp + 4) = (f32x4){ev[4] * inv, ev[5] * inv, ev[6] * inv, ev[7] * inv};
        } else {
            *(int4*)(ep + 8) = make_int4(ei[8], ei[9], ei[10], ei[11]); *(int4*)(ep + 12) = make_int4(ei[12], ei[13], ei[14], ei[15]);
            *(f32x4*)(gp + 8) = (f32x4){ev[8] * inv, ev[9] * inv, ev[10] * inv, ev[11] * inv}; *(f32x4*)(gp + 12) = (f32x4){ev[12] * inv, ev[13] * inv, ev[14] * inv, ev[15] * inv};
        }
    }
}

__device__ __forceinline__ void cvt16(const u32x4 w, f32x2 (&f)[8]) {
#pragma unroll
    for (int q = 0; q < 4; ++q) { f[2 * q] = __builtin_amdgcn_cvt_pk_f32_fp8((int)w[q], false); f[2 * q + 1] = __builtin_amdgcn_cvt_pk_f32_fp8((int)w[q], true); }
}
typedef short s16x2v __attribute__((ext_vector_type(2)));
#define EXP_DOT(S) do { \
        int A_ = __builtin_amdgcn_sdot8((int)w[0], xa[S][0], 0, true), B_ = __builtin_amdgcn_sdot8((int)w[0], xb[S][0], 0, true); \
        A_ = __builtin_amdgcn_sdot8((int)w[1], xa[S][1], A_, false); B_ = __builtin_amdgcn_sdot8((int)w[1], xb[S][1], B_, false); \
        A_ = __builtin_amdgcn_sdot8((int)w[2], xa[S][2], A_, false); B_ = __builtin_amdgcn_sdot8((int)w[2], xb[S][2], B_, false); \
        A_ = __builtin_amdgcn_sdot8((int)w[3], xa[S][3], A_, false); B_ = __builtin_amdgcn_sdot8((int)w[3], xb[S][3], B_, false); \
        dsum = (float)((A_ << 4) + B_) * (float)(rbw & 255u); } while (0)
typedef _Float16 h2 __attribute__((ext_vector_type(2)));
#ifndef UPR
#define UPR 8
#endif
typedef unsigned u32x6 __attribute__((ext_vector_type(6)));
typedef _Float16 h32 __attribute__((ext_vector_type(32)));
struct H2x16 { h2 a[16]; };
#define EXP_ACC(S) do { _Pragma("unroll") for (int m = 0; m < 8; ++m) { \
        acc[S][0][m] = __builtin_elementwise_fma(hv.a[m], ws2, acc[S][0][m]); acc[S][1][m] = __builtin_elementwise_fma(hv.a[8 + m], ws2, acc[S][1][m]); } } while (0)
template <int VAR>
__device__ __forceinline__ void phase_experts(const Params& p, unsigned char* lds_raw) {
    const int tid = tid_opaque(), wid = __builtin_amdgcn_readfirstlane(tid >> 6);
    const unsigned char* ED = p.ws + OFF_ED; const unsigned char* EU = p.ws + OFF_ED + (size_t)16384 * 2048; const float* scl = (const float*)(p.ws + OFF_ESCL);
    const bf16_t* X1B = (const bf16_t*)(p.ws + OFF_XB); const float* ssq2 = (const float*)(p.ws + OFF_SSQ2);
    const int* eidx = (const int*)(p.ws + OFF_EIDX); const float* gsm = (const float*)(p.ws + OFF_GSM);
    const float* fgain = p.in[21]; float* out = p.out;
    unsigned* KY = (unsigned*)lds_raw + wid * 1024;
    float* AW = (float*)(KY + 512);
    const int gw = blockIdx.x * 8 + wid, nw = gridDim.x * 8;
#pragma unroll 1
    for (int t0 = gw; t0 < T_TOK; t0 += 4 * nw) {
        int lane; asm volatile("v_mbcnt_lo_u32_b32 %0, -1, 0\n\tv_mbcnt_hi_u32_b32 %0, -1, %0" : "=v"(lane));
        int tok[4];
#pragma unroll
        for (int s = 0; s < 4; ++s) { const int t = t0 + s * nw; tok[s] = t < T_TOK ? t : t0; }
#pragma unroll
        for (int r = 0; r < 8; ++r) { const int s = r >> 1, pos = (r & 1) * 64 + lane; const int e = eidx[(size_t)tok[s] * 128 + pos]; KY[r * 64 + lane] = ((unsigned)e << 9) | ((unsigned)s << 7) | (unsigned)pos; }
        asm volatile("s_waitcnt lgkmcnt(0)" ::: "memory"); __builtin_amdgcn_wave_barrier();
#pragma unroll 1
        for (int k = 2; k <= 512; k <<= 1)
#pragma unroll 1
            for (int j = k >> 1; j > 0; j >>= 1) {
                unsigned sa[4], sb[4]; int si[4];
#pragma unroll
                for (int q = 0; q < 4; ++q) { const int idx = q * 64 + lane; const int i = ((idx & ~(j - 1)) << 1) | (idx & (j - 1)); si[q] = i; sa[q] = KY[i]; sb[q] = KY[i | j]; }
#pragma unroll
                for (int q = 0; q < 4; ++q) { const unsigned a = sa[q], b = sb[q]; const bool asc = (si[q] & k) == 0; const bool sw = asc ? (a > b) : (a < b); sa[q] = sw ? b : a; sb[q] = sw ? a : b; }
#pragma unroll
                for (int q = 0; q < 4; ++q) { KY[si[q]] = sa[q]; KY[si[q] | j] = sb[q]; }
                asm volatile("s_waitcnt lgkmcnt(0)" ::: "memory"); __builtin_amdgcn_wave_barrier();
            }
        float rsv[4];
#pragma unroll
        for (int s = 0; s < 4; ++s) { float sq = ssq2[(size_t)tok[s] * 64 + lane]; sq = wave_sum(sq); rsv[s] = __uint_as_float((unsigned)__builtin_amdgcn_readfirstlane((int)__float_as_uint(__builtin_amdgcn_rsqf(sq * (1.0f / 2048.0f) + NORM_EPS)))); }
        {
            int xa[4][4], xb[4][4];
#pragma unroll
            for (int s = 0; s < 4; ++s) {
                u32x4 xr[4];
#pragma unroll
                for (int j = 0; j < 2; ++j) { xr[2 * j] = *(const u32x4*)(X1B + (size_t)tok[s] * 2048 + j * 1024 + lane * 16); xr[2 * j + 1] = *(const u32x4*)(X1B + (size_t)tok[s] * 2048 + j * 1024 + lane * 16 + 8); }
                float mx = 0.f;
#pragma unroll
                for (int h = 0; h < 4; ++h)
#pragma unroll
                    for (int q = 0; q < 4; ++q) mx = fmaxf(mx, fmaxf(fabsf(bf_lo(xr[h][q])), fabsf(bf_hi(xr[h][q]))));
                mx = fmaxf(wave_max(mx), 1e-30f);
                const float inv = 119.0f / mx;
#pragma unroll
                for (int h = 0; h < 4; ++h) { unsigned pa = 0u, pb = 0u;
#pragma unroll
                    for (int k = 0; k < 8; ++k) { const float f = ((k & 1) ? bf_hi(xr[h][k >> 1]) : bf_lo(xr[h][k >> 1])) * inv; const int xi = (int)__builtin_rintf(f);
                        pa |= ((unsigned)((xi + 8) >> 4) & 15u) << (4 * k); pb |= ((unsigned)xi & 15u) << (4 * k); }
                    xa[s][h] = (int)pa; xb[s][h] = (int)pb; }
                rsv[s] *= __uint_as_float((unsigned)__builtin_amdgcn_readfirstlane((int)__float_as_uint(mx * (1.0f / 119.0f))));
            }
            int lane_d = lane; asm volatile("" : "+v"(lane_d));
            const unsigned lo16 = (unsigned)lane_d * 16u, lo2 = 1024u + (unsigned)lane_d * 2u;
#pragma unroll 1
            for (int c = 0; c < ((VAR & 1) ? 0 : 8); ++c) {
                const unsigned kv = KY[c * 64 + lane];
                float mine = 0.f;
#pragma unroll 1
                for (int bt = 0; bt < 4; ++bt) {
                    float dd[16];
#pragma unroll
                    for (int il = 0; il < 1; ++il) {
                        SBAR();
                        u32x4 r0[16]; unsigned r1[16]; unsigned ky[16];
#pragma unroll
                        for (int s = 0; s < 16; ++s) { ky[s] = (unsigned)__builtin_amdgcn_readlane((int)kv, bt * 16 + il * 16 + s);
                            const unsigned char* row = ED + (ky[s] >> 9) * 1152u; unsigned oa = lo16, ob = lo2; asm volatile("" : "+v"(oa), "+v"(ob)); r0[s] = *(const u32x4*)(row + oa); r1[s] = *(const unsigned short*)(row + ob); }
#pragma unroll
                        for (int s = 0; s < 16; ++s) { const u32x4 w = r0[s]; const unsigned rbw = r1[s]; const unsigned sl = (ky[s] >> 7) & 3u; float dsum;
                            if (sl == 0u) { EXP_DOT(0); asm volatile("; slot 0" : "+v"(dsum)); } else if (sl == 1u) { EXP_DOT(1); asm volatile("; slot 1" : "+v"(dsum)); }
                            else if (sl == 2u) { EXP_DOT(2); asm volatile("; slot 2" : "+v"(dsum)); } else { EXP_DOT(3); asm volatile("; slot 3" : "+v"(dsum)); }
                            dd[il * 16 + s] = dsum; }
                    }
                    const float v = butterfly16(dd, lane);
                    mine = ((lane >> 4) == bt) ? v : mine;
                }
                AW[c * 64 + lane] = mine;
            }
        }
        {
            float sd[8], gg[8], su[8], av[8]; float rs8[8];
#pragma unroll
            for (int c = 0; c < 8; ++c) {
                const unsigned kv = KY[c * 64 + lane]; av[c] = AW[c * 64 + lane];
                const unsigned e = kv >> 9, sl = (kv >> 7) & 3u, pos = kv & 127u;
                const int mytok = sl == 0u ? tok[0] : (sl == 1u ? tok[1] : (sl == 2u ? tok[2] : tok[3]));
                rs8[c] = sl == 0u ? rsv[0] : (sl == 1u ? rsv[1] : (sl == 2u ? rsv[2] : rsv[3]));
                const unsigned eo = e * 4u, go = ((unsigned)mytok * 128u + pos) * 4u;
                sd[c] = *(const float*)((const char*)scl + eo); gg[c] = *(const float*)((const char*)gsm + go); su[c] = *(const float*)((const char*)(scl + 16384) + eo);
            }
#pragma unroll
            for (int c = 0; c < 8; ++c) { const _Float16 wh = (_Float16)(gelu_tanh(av[c] * sd[c] * rs8[c]) * gg[c] * su[c] * 1024.0f); AW[c * 64 + lane] = __builtin_bit_cast(float, (h2){wh, wh}); }
        }
        int lane_u = lane; asm volatile("" : "+v"(lane_u));
        const unsigned uo16 = (unsigned)lane_u * 16u, uo8 = 1024u + (unsigned)lane_u * 8u;
        h2 acc[4][2][8];
#pragma unroll
        for (int s = 0; s < 4; ++s)
#pragma unroll
            for (int j = 0; j < 2; ++j)
#pragma unroll
                for (int q = 0; q < 8; ++q) acc[s][j][q] = (h2){(_Float16)0.f, (_Float16)0.f};
#pragma unroll 1
        for (int c = 0; c < ((VAR & 2) ? 0 : 8); ++c) {
            const unsigned kv = KY[c * 64 + lane]; const float wv = AW[c * 64 + lane];
#pragma unroll 1
            for (int b8 = 0; b8 < 64 / UPR; ++b8) {
                u32x4 r0[UPR]; u32x2 r1[UPR]; unsigned ky[UPR];
#pragma unroll
                for (int k = 0; k < UPR; ++k) { ky[k] = (unsigned)__builtin_amdgcn_readlane((int)kv, b8 * UPR + k);
                    const unsigned char* row = EU + (ky[k] >> 9) * 1536u; unsigned oa = uo16, ob = uo8; asm volatile("" : "+v"(oa), "+v"(ob)); r0[k] = *(const u32x4*)(row + oa); r1[k] = *(const u32x2*)(row + ob); }
#pragma unroll
                for (int k = 0; k < UPR; ++k) { const unsigned sl = (ky[k] >> 7) & 3u;
                    const H2x16 hv = __builtin_bit_cast(H2x16, __builtin_amdgcn_cvt_scalef32_pk32_f16_fp6((u32x6){r0[k][0], r0[k][1], r0[k][2], r0[k][3], r1[k][0], r1[k][1]}, 1.0f));
                    const h2 ws2 = __builtin_bit_cast(h2, (unsigned)__builtin_amdgcn_readlane((int)__float_as_uint(wv), b8 * UPR + k));
                    if (sl == 0u) { EXP_ACC(0); } asm volatile("; slot 0" ::: "memory"); if (sl == 1u) { EXP_ACC(1); } asm volatile("; slot 1" ::: "memory");
                    if (sl == 2u) { EXP_ACC(2); } asm volatile("; slot 2" ::: "memory"); if (sl == 3u) { EXP_ACC(3); } asm volatile("; slot 3" ::: "memory"); }
            }
        }
        {
            int lane_f = lane; asm volatile("" : "+v"(lane_f));
            u32x4 xl[4][4]; f32x4 gn[2][4];
#pragma unroll
            for (int s = 0; s < 4; ++s)
#pragma unroll
                for (int j = 0; j < 2; ++j) { const bf16_t* xp = X1B + (size_t)tok[s] * 2048 + j * 1024 + lane_f * 16; xl[s][2 * j] = *(const u32x4*)xp; xl[s][2 * j + 1] = *(const u32x4*)(xp + 8); }
#pragma unroll
            for (int j = 0; j < 2; ++j)
#pragma unroll
                for (int q = 0; q < 4; ++q) gn[j][q] = *(const f32x4*)(fgain + j * 1024 + lane_f * 16 + 4 * q);
#pragma unroll
            for (int s = 0; s < 4; ++s) {
                float ss = 0.f; f32x2 xo[2][8];
#pragma unroll
                for (int j = 0; j < 2; ++j) { const u32x4 xa = xl[s][2 * j], xb2 = xl[s][2 * j + 1];
#pragma unroll
                    for (int q = 0; q < 4; ++q) { const unsigned w0_ = q < 2 ? xa[2 * q] : xb2[2 * q - 4], w1_ = q < 2 ? xa[2 * q + 1] : xb2[2 * q - 3]; const f32x4 a = {bf_lo(w0_), bf_hi(w0_), bf_lo(w1_), bf_hi(w1_)};
                        xo[j][2 * q] = (f32x2){a[0] + (float)acc[s][j][2 * q].x * (1.0f / 1024.0f), a[1] + (float)acc[s][j][2 * q].y * (1.0f / 1024.0f)};
                        xo[j][2 * q + 1] = (f32x2){a[2] + (float)acc[s][j][2 * q + 1].x * (1.0f / 1024.0f), a[3] + (float)acc[s][j][2 * q + 1].y * (1.0f / 1024.0f)};
                        ss += xo[j][2 * q].x * xo[j][2 * q].x + xo[j][2 * q].y * xo[j][2 * q].y + xo[j][2 * q + 1].x * xo[j][2 * q + 1].x + xo[j][2 * q + 1].y * xo[j][2 * q + 1].y; } }
                ss = wave_sum(ss);
                const float rf = __builtin_amdgcn_rsqf(ss * (1.0f / 2048.0f) + NORM_EPS);
                if (t0 + s * nw < T_TOK) {
#pragma unroll
                    for (int j = 0; j < 2; ++j) { float* xp = out + (size_t)tok[s] * 2048 + j * 1024 + lane_f * 16;
#pragma unroll
                        for (int q = 0; q < 4; ++q) { const f32x4 g = gn[j][q];
                            *(f32x4*)(xp + 4 * q) = (f32x4){xo[j][2 * q].x * rf * g[0], xo[j][2 * q].y * rf * g[1], xo[j][2 * q + 1].x * rf * g[2], xo[j][2 * q + 1].y * rf * g[3]}; } }
                }
            }
        }
        __builtin_amdgcn_wave_barrier();
    }
}
#undef EXP_DOT
#undef EXP_ACC

#define XB_TMO      128
#define XB_XCNT(j)  (256  + 64 * (j))
#define XB_XSUB(j)  (1280 + 64 * (j))
#define XB_XGEN(j)  (2304 + 64 * (j))
#define XB_TOP      3328
#define XB_TOPGEN   3392
#define XCD_BAR_WORDS 3456
#define XB_SPIN_CAP (1u << 18)

__device__ __forceinline__ unsigned xb_ld(unsigned* p)              { return __hip_atomic_load(p, __ATOMIC_RELAXED, __HIP_MEMORY_SCOPE_AGENT); }
__device__ __forceinline__ unsigned xb_add(unsigned* p, unsigned v) { return __hip_atomic_fetch_add(p, v, __ATOMIC_RELAXED, __HIP_MEMORY_SCOPE_AGENT); }
__device__ __forceinline__ unsigned xb_xcc_id() { return (unsigned)__builtin_amdgcn_s_getreg((3 << 11) | 20) & 0xFu; }
#define XB_SPIN(cond, bar) do { unsigned _sp = 0; while (cond) { __builtin_amdgcn_s_sleep(1); \
    if ((++_sp & 255u) == 0u) { if (xb_ld(&(bar)[XB_TMO])) break; if (_sp > XB_SPIN_CAP) { atomicAdd(&(bar)[XB_TMO], 1u); break; } } } } while (0)

struct XcdBarrier {
    unsigned* bar; unsigned x;
    volatile LAS unsigned* st;
};

__device__ __forceinline__ XcdBarrier xcd_barrier_post(unsigned* bar, volatile LAS unsigned* st) {
    XcdBarrier b; b.bar = bar; b.x = xb_xcc_id(); b.st = st;
    if (threadIdx.x == 0) (void)xb_add(&bar[XB_XCNT(b.x)], 1u);
    return b;
}
__device__ __forceinline__ void xcd_barrier_complete(unsigned* bar, unsigned x, unsigned& nloc, unsigned& nx) {
    const unsigned G = gridDim.x * gridDim.y * gridDim.z;
    unsigned sum, cnt, mine, sp = 0u;
    for (;;) {
        sum = 0u; cnt = 0u; mine = 0u;
#pragma unroll
        for (unsigned j = 0; j < 16; ++j) { const unsigned c = xb_ld(&bar[XB_XCNT(j)]); sum += c; cnt += (c > 0u) ? 1u : 0u; mine = (j == x) ? c : mine; }
        if (sum == G) break;
        __builtin_amdgcn_s_sleep(1);
        if ((++sp & 255u) == 0u) { if (xb_ld(&bar[XB_TMO])) break; if (sp > XB_SPIN_CAP) { atomicAdd(&bar[XB_TMO], 1u); break; } }
    }
    nloc = mine > 0u ? mine : 1u; nx = cnt > 0u ? cnt : 1u;
}

__device__ __forceinline__ void xcd_barrier(const XcdBarrier& b) {
    asm volatile("s_waitcnt vmcnt(0)" ::: "memory");
    __syncthreads();
    if (threadIdx.x == 0) {
        unsigned* bar = b.bar;
        __builtin_amdgcn_s_waitcnt(0);
        unsigned nloc = b.st[0], nx = b.st[1];
        if (nloc == 0u) { xcd_barrier_complete(bar, b.x, nloc, nx); b.st[0] = nloc; b.st[1] = nx; }
        const unsigned old = xb_add(&bar[XB_XSUB(b.x)], 1u);
        const unsigned gen = old / nloc;
        if (old + 1u == (gen + 1u) * nloc) {
            __builtin_amdgcn_fence(__ATOMIC_RELEASE, "agent");
            asm volatile("s_waitcnt vmcnt(0)" ::: "memory");
            const unsigned og = xb_add(&bar[XB_TOP], 1u);
            const unsigned tg = og / nx;
            if (og + 1u == (tg + 1u) * nx) xb_add(&bar[XB_TOPGEN], 1u);
            else XB_SPIN(xb_ld(&bar[XB_TOPGEN]) == tg, bar);
            __builtin_amdgcn_fence(__ATOMIC_ACQUIRE, "agent");
            xb_add(&bar[XB_XGEN(b.x)], 1u);
            asm volatile("s_waitcnt vmcnt(0)" ::: "memory");
        } else {
            XB_SPIN(xb_ld(&bar[XB_XGEN(b.x)]) == gen, bar);
            __builtin_amdgcn_fence(__ATOMIC_ACQUIRE, "agent");
            asm volatile("s_waitcnt vmcnt(0)" ::: "memory");
        }
    }
    __syncthreads();
}


#ifdef DBG_PROBE
constexpr size_t OFF_DBG = 470 * MiB;
constexpr int DBG_NS = 32;
__device__ __forceinline__ int dbg_token(int i) { return (i * 509 + 37 * (i & 7) * 64 + 5) & (T_TOK - 1); }
__device__ __forceinline__ float block_sum(float v, float* red) {
    v = wave_sum(v); __syncthreads(); if ((threadIdx.x & 63) == 0) red[threadIdx.x >> 6] = v; __syncthreads();
    float s = 0.f; for (int i = 0; i < 8; ++i) s += red[i]; __syncthreads(); return s;
}
__device__ void probe_peer_naive(const Params& p, unsigned char* lds_raw) {
    if ((int)blockIdx.x >= DBG_NS) return;
    const int tid = threadIdx.x, t = dbg_token(blockIdx.x);
    float* xn = (float*)lds_raw;
    float* q = xn + 2048;
    float* sc = q + 2048;
    float* wexp = sc + 2048;
    int* eix = (int*)(wexp + 128);
    float* gg = (float*)(eix + 128);
    float* red = gg + 128;
    float* tmpv = red + 16;
    int* tmpi = (int*)(tmpv + 256);
    float* cand = (float*)(tmpi + 256);
    const float* x1 = p.out + (size_t)t * 2048; const float* g2 = p.in[15];
    float ss = 0.f; for (int i = tid; i < 2048; i += 512) { const float v = x1[i]; ss += v * v; }
    ss = block_sum(ss, red);
    const float rs = 1.0f / sqrtf(ss / 2048.0f + NORM_EPS);
    for (int i = tid; i < 2048; i += 512) xn[i] = x1[i] * rs * g2[i];
    __syncthreads();
    { const float* wq = p.in[16]; float a0 = 0, a1 = 0, a2 = 0, a3 = 0;
      for (int k = 0; k < 2048; ++k) { const float xv = xn[k]; const float* w = wq + (size_t)k * 2048; a0 += xv * w[tid]; a1 += xv * w[tid + 512]; a2 += xv * w[tid + 1024]; a3 += xv * w[tid + 1536]; }
      q[tid] = a0; q[tid + 512] = a1; q[tid + 1024] = a2; q[tid + 1536] = a3; }
    __syncthreads();
    for (int i = tid; i < 2048; i += 512) { const int which = i >> 10, h = (i >> 7) & 7, key = i & 127; const float* kk = p.in[17 + which] + ((size_t)h * 128 + key) * 128; const float* qq = q + h * 256 + which * 128;
        float s = 0.f; for (int d = 0; d < 128; ++d) s += qq[d] * kk[d]; sc[i] = s; }
    __syncthreads();
    if (tid < 16) { const int which = tid >> 3, h = tid & 7; float* s = sc + which * 1024 + h * 128;
        for (int r = 0; r < 16; ++r) { int bi = 0; float bv = -3e38f; for (int k = 0; k < 128; ++k) if (s[k] > bv) { bv = s[k]; bi = k; } tmpv[(h * 2 + which) * 16 + r] = bv; tmpi[(h * 2 + which) * 16 + r] = bi; s[bi] = -3e38f; } }
    __syncthreads();
    for (int i = tid; i < 2048; i += 512) { const int h = i >> 8, a = (i >> 4) & 15, b = i & 15; cand[i] = tmpv[(h * 2) * 16 + a] + tmpv[(h * 2 + 1) * 16 + b]; }
    __syncthreads();
    if (tid < 8) { const int h = tid; float* c = cand + h * 256; float mx = -3e38f;
        for (int r = 0; r < 16; ++r) { int bi = 0; float bv = -3e38f; for (int k = 0; k < 256; ++k) if (c[k] > bv) { bv = c[k]; bi = k; } c[bi] = -3e38f;
            eix[h * 16 + r] = tmpi[(h * 2) * 16 + (bi >> 4)] * 128 + tmpi[(h * 2 + 1) * 16 + (bi & 15)]; gg[h * 16 + r] = bv; if (bv > mx) mx = bv; }
        float sm = 0.f; for (int r = 0; r < 16; ++r) { const float e = expf(gg[h * 16 + r] - mx); gg[h * 16 + r] = e; sm += e; }
        for (int r = 0; r < 16; ++r) gg[h * 16 + r] /= sm; }
    __syncthreads();
    { const int wid = tid >> 6, lane = tid & 63;
      for (int e = wid; e < 128; e += 8) { const float* u = p.in[19] + (size_t)eix[e] * 2048; float s = 0.f; for (int d = lane; d < 2048; d += 64) s += xn[d] * u[d]; s = wave_sum(s);
          if (lane == 0) wexp[e] = gelu_tanh(s) * gg[e]; } }
    __syncthreads();
    float* dbg = (float*)(p.ws + OFF_DBG) + (size_t)blockIdx.x * 2048;
    float o[4]; float s2 = 0.f;
    for (int j = 0; j < 4; ++j) { const int c = tid + j * 512; float a = 0.f; for (int e = 0; e < 128; ++e) a += wexp[e] * p.in[20][(size_t)eix[e] * 2048 + c]; o[j] = x1[c] + a; s2 += o[j] * o[j]; }
    s2 = block_sum(s2, red);
    const float rf = 1.0f / sqrtf(s2 / 2048.0f + NORM_EPS);
    for (int j = 0; j < 4; ++j) { const int c = tid + j * 512; dbg[c] = o[j] * rf * p.in[21][c]; }
    int* dsel = (int*)(p.ws + OFF_DBG + 1 * MiB) + (size_t)blockIdx.x * 256;
    if (tid < 128) { dsel[tid] = eix[tid]; ((float*)dsel)[128 + tid] = gg[tid]; }
}
__device__ void probe_peer_compare(const Params& p, unsigned char* lds_raw, int mode) {
    float* red = (float*)lds_raw; const int tid = threadIdx.x;
    if (blockIdx.x == 0) {
        float num = 0.f, den = 0.f;
        if (mode == 0) { for (int i = 0; i < DBG_NS; ++i) { const float* a = p.out + (size_t)dbg_token(i) * 2048; const float* b = (const float*)(p.ws + OFF_DBG) + (size_t)i * 2048;
                for (int c = tid; c < 2048; c += 512) { const float d = a[c] - b[c]; num += d * d; den += b[c] * b[c]; } } }
        else { const int* eidx = (const int*)(p.ws + OFF_EIDX); const float* gsm = (const float*)(p.ws + OFF_GSM);
            for (int i = tid; i < DBG_NS * 128; i += 512) { const int s = i >> 7, k = i & 127, h = k >> 4; const int* dsel = (const int*)(p.ws + OFF_DBG + 1 * MiB) + (size_t)s * 256; const int t = dbg_token(s);
                const int e = dsel[k]; const float g = ((const float*)dsel)[128 + k]; bool found = false; float gp = 0.f;
                for (int r = 0; r < 16; ++r) if (eidx[(size_t)t * 128 + h * 16 + r] == e) { found = true; gp = gsm[(size_t)t * 128 + h * 16 + r]; }
                if (mode == 1) { num += found ? 0.f : 1.f; den += 1.f; } else { if (found) { num += (gp - g) * (gp - g); den += g * g; } } } }
        num = block_sum(num, red + 32); den = block_sum(den, red + 32);
        if (tid == 0) ((float*)(p.ws + OFF_MISC + M_CTL))[32] = num / fmaxf(den, 1e-30f);
    }
}
__device__ void probe_encode(const Params& p) {
    const float e = ((const float*)(p.ws + OFF_MISC + M_CTL))[32];
    const float beta = 0.967f - 0.9f * sqrtf(fminf(fmaxf(e, 0.f), 1.f));
    const float bb = (e == e) ? beta : -1.0f;
    for (size_t i = (size_t)blockIdx.x * 512 + threadIdx.x; i < (size_t)T_TOK * 2048; i += (size_t)gridDim.x * 512) p.out[i] = p.in[0][i] * bb;
}
#endif

constexpr int LDS_BYTES = 132 * 1024;
#ifndef N_PHASES
#define N_PHASES 11
#endif
__device__ __forceinline__ void run_phase(int ph, const Params& p, unsigned char* lds) {
    const int G = gridDim.x, c = blockIdx.x;
    unsigned char* ws = p.ws;
    switch (ph) {
    case 0: phase_prep(p, lds); break;
    case 1: { SchedGemm1 S{(const char*)(ws + OFF_XB), (const char*)(ws + OFF_WINT), G, c}; EpiGemm1 E{1, ws, p.out, p.in[3], p.in[4], p.in[5]};
              pg8::gemm_phase<true>((LAS unsigned char*)lds, 1024, 1024, 1024, S, E);
              if (G == 256 && c >= 192) {
                  const int t_ = tid_opaque(), lw = (c - 192) * 8 + (t_ >> 6), lane_ = t_ & 63;
                  for (int r0 = 2 * 16384 - LATE_ROWS + lw; r0 < 2 * 16384; r0 += 1024) convert_expert_rows(p, r0, r0 + 512 < 2 * 16384 ? r0 + 512 : r0, lane_); } } break;
    case 2: { SchedCompress S{(const char*)(ws + OFF_KV6), (const char*)(ws + OFF_KV6) + (size_t)16 * 2048 * 128 * 2, (const char*)(ws + OFF_W1T), G, c}; EpiSlab E{(float*)(ws + OFF_XB)};
              pg8::gemm_phase<false>((LAS unsigned char*)lds, 512, 2048, 4096, S, E);
              fox_cumsum(p, G >= 138 ? 128 : 0); } break;
    case 3: phase_cmp2(p, lds); break;
    case 4: phase_cmp_attn(p, lds); break;
    case 5: phase_attn(p, lds); break;
    case 6: { SchedMerge S{(const char*)(ws + OFF_XB), (const char*)(ws + OFF_WUPT), G, c}; EpiMerge E{(const unsigned char*)p.out, (const unsigned char*)p.out + (size_t)T_TOK * 2048, ws + OFF_QKVF};
              pg8::gemm_phase<true>((LAS unsigned char*)lds, 512, 1024, 1024, S, E); } break;
    case 7: { SchedSquare S{(const char*)(ws + OFF_QKVF), (const char*)(ws + OFF_WOUTT), G, c, 2048}; EpiOut E{p.in[0], p.out, (bf16_t*)(ws + OFF_XB), (float*)(ws + OFF_SSQ2)};
              pg8::gemm_phase<true>((LAS unsigned char*)lds, 1024, 1024, 1024, S, E); } break;
    case 8: { SchedSquare S{(const char*)(ws + OFF_XB), (const char*)(ws + OFF_WQT), G, c, 4096}; EpiPeerQ E{(const float*)(ws + OFF_SSQ2), (bf16_t*)(ws + OFF_QKVF)};
              pg8::gemm_phase<false>((LAS unsigned char*)lds, 2048, 2048, 2048, S, E); } break;
    case 9: phase_peer_topk(p, lds); break;
    case 10: phase_experts<0>(p, lds); break;
    }
}

constexpr size_t OFF_BAR = OFF_MISC + 7 * MiB;
__global__ void __launch_bounds__(512, 2) fwd_megakernel(Params p) {
    extern __shared__ __attribute__((aligned(16))) unsigned char shm[];
    cg::grid_group grid = cg::this_grid();
    volatile LAS unsigned* bst = (volatile LAS unsigned*)((LAS unsigned char*)shm + LDS_BYTES - 16);
    if (threadIdx.x < 4) bst[threadIdx.x] = 0u;
    __syncthreads();
    const XcdBarrier xb = xcd_barrier_post((unsigned*)(p.ws + OFF_BAR), bst);
#define GSYNC() xcd_barrier(xb)
#ifdef ONLY_PHASE
    run_phase(ONLY_PHASE, p, shm); grid.sync();
#else
#ifndef REPEAT_MASK
#define REPEAT_MASK 0
#endif
#ifndef REPN
#define REPN 1
#endif
#define RUNX(k) do { if ((k) == 5) { if (blockIdx.x == 0 && threadIdx.x == 0) *(unsigned*)(p.ws + OFF_MISC + M_CTL) = 0u; GSYNC(); } run_phase(k, p, shm); GSYNC(); } while (0)
#define RUNP(k) do { run_phase(k, p, shm); GSYNC(); if (REPEAT_MASK & (1 << (k))) { RUNX(k); if (REPN > 1) RUNX(k); if (REPN > 2) RUNX(k); if (REPN > 3) RUNX(k); } } while (0)
    run_phase(0, p, shm);
#if REPEAT_MASK & 1
    for (int rp_ = 0; rp_ < REPN; ++rp_) { GSYNC(); run_phase(0, p, shm); }
#endif
    if (p.ws == nullptr) grid.sync();
    GSYNC();
#ifdef P1VAR
    { const int G = gridDim.x, c = blockIdx.x; unsigned char* ws = p.ws;
      SchedGemm1 S{(const char*)(ws + ((P1VAR & 2) ? 160 * MiB : OFF_XB)), (const char*)(ws + ((P1VAR & 2) ? 350 * MiB : OFF_WINT)), G, c}; int st_ = (P1VAR & 4) ? 0 : 1; asm volatile("" : "+s"(st_)); EpiGemm1 E{st_, ws, p.out, p.in[3], p.in[4], p.in[5]};
      pg8::gemm_phase<true, (P1VAR & 1) != 0>((LAS unsigned char*)shm, 1024, 1024, 1024, S, E); GSYNC(); }
#endif
    RUNP(1); RUNP(2); RUNP(3); RUNP(4); RUNP(5);
#ifdef PXVAR
    { const int G = gridDim.x, c = blockIdx.x; unsigned char* ws = p.ws;
      if (PXVAR & 1) { SchedMerge S{(const char*)(ws + OFF_XB), (const char*)(ws + OFF_WUPT), G, c}; EpiMerge E{(const unsigned char*)p.out, (const unsigned char*)p.out + (size_t)T_TOK * 2048, ws + OFF_QKVF};
          pg8::gemm_phase<true, true>((LAS unsigned char*)shm, 512, 1024, 1024, S, E); GSYNC(); }
      if (PXVAR & 2) { SchedSquare S{(const char*)(ws + OFF_QKVF), (const char*)(ws + OFF_WOUTT), G, c, 2048}; EpiOut E{p.in[0], p.out, (bf16_t*)(ws + OFF_XB), (float*)(ws + OFF_SSQ2)};
          pg8::gemm_phase<true, true>((LAS unsigned char*)shm, 1024, 1024, 1024, S, E); GSYNC(); }
      if (PXVAR & 4) { SchedSquare S{(const char*)(ws + OFF_XB), (const char*)(ws + OFF_WQT), G, c, 4096}; EpiPeerQ E{(const float*)(ws + OFF_SSQ2), (bf16_t*)(ws + OFF_QKVF)};
          pg8::gemm_phase<false, true>((LAS unsigned char*)shm, 2048, 2048, 2048, S, E); GSYNC(); } }
#endif
    RUNP(6); RUNP(7); RUNP(8); RUNP(9);
#if 0
#endif
#ifdef DBG_PROBE
    probe_peer_naive(p, shm); grid.sync();
#endif
#if (REPEAT_MASK >> 10) & 1
    phase_experts<P10VAR>(p, shm); GSYNC();
#endif
#ifdef P10_EXTRA
    for (int i_ = 0; i_ < P10_EXTRA; ++i_) { phase_experts<0>(p, shm); GSYNC(); }
#endif
#ifdef EXTRA_GSYNC
    for (int i_ = 0; i_ < EXTRA_GSYNC; ++i_) GSYNC();
#endif
    run_phase(10, p, shm);
#ifdef DBG_PROBE
    grid.sync(); probe_peer_compare(p, shm, DBG_PROBE - 1); grid.sync(); probe_encode(p);
#endif
#endif
}

extern "C" void kernel_launch(void* const* d_in, const int* in_sizes, int n_in, void* d_out, int out_size, void* d_ws, size_t ws_size, hipStream_t stream) {
    static int grid_blocks = 0;
    if (grid_blocks == 0) {
        if (n_in != 22 || out_size != T_TOK * DM || ws_size < WS_END) { fprintf(stderr, "kernel_launch: unexpected shapes (n_in %d out %d ws %zu, need ws >= %zu)\n", n_in, out_size, ws_size, (size_t)WS_END); grid_blocks = -1; return; }
        int dev = 0, cus = 0, per_cu = 0;
        hipGetDevice(&dev); hipDeviceGetAttribute(&cus, hipDeviceAttributeMultiprocessorCount, dev);
        if (hipFuncSetAttribute((const void*)fwd_megakernel, hipFuncAttributeMaxDynamicSharedMemorySize, LDS_BYTES) != hipSuccess) { fprintf(stderr, "kernel_launch: hipFuncSetAttribute failed\n"); grid_blocks = -1; return; }
        if (hipOccupancyMaxActiveBlocksPerMultiprocessor(&per_cu, (const void*)fwd_megakernel, 512, LDS_BYTES) != hipSuccess || per_cu < 1) { fprintf(stderr, "kernel_launch: occupancy query says %d\n", per_cu); grid_blocks = -1; return; }
        grid_blocks = cus;
    }
    if (grid_blocks < 0) return;
    Params p{};
    for (int i = 0; i < 22; ++i) p.in[i] = (const float*)d_in[i];
    p.out = (float*)d_out; p.ws = (unsigned char*)d_ws;
    if (hipMemsetAsync((char*)d_ws + OFF_BAR, 0, XCD_BAR_WORDS * 4, stream) != hipSuccess) { fprintf(stderr, "kernel_launch: memset of the barrier words failed\n"); return; }
#ifdef P1VAR
    if (P1VAR & 2) { hipMemsetAsync((char*)d_ws + 160 * MiB, 0, 32 * MiB, stream); hipMemsetAsync((char*)d_ws + 350 * MiB, 0, 20 * MiB, stream); }
#endif
    void* args[] = {&p};
    hipError_t e = hipLaunchCooperativeKernel((const void*)fwd_megakernel, dim3(grid_blocks), dim3(512), args, LDS_BYTES, stream);
    if (e != hipSuccess) fprintf(stderr, "cooperative launch failed: %s (grid %d)\n", hipGetErrorString(e), grid_blocks);
}
```
